# Optimizing an MI355X kernel written in HIP

```python
import math
import jax, jax.numpy as jnp
from jax import lax
import numpy as np

D_MODEL = 1024
BATCH = 4
SEQ = 8192
DEPTH = 1

GRID_W = 64
HY_WIDTH = 512
HY_ORDER = 2
SHORT_K = 3
FILTER_EMB = 33
FILTER_HIDDEN = 64
HY_QUICK_DECAY_PCT = 0.3
HY_GRADUAL_DECAY_PCT = 1.5
HY_DECAY_TARGET = 1e-2
N_HEADS = 8
N_KV_HEADS = 2
HEAD_DIM = 64
Q_BLOCK = 128
ROPE_THETA = 10000.0
N_EXPERTS = 16
EC_FACTOR = 2
D_FF_EXPERT = 2048
EPS = 1e-6
N_BRANCHES = 2
ATT_WIDTH = N_HEADS * HEAD_DIM
KV_WIDTH = N_KV_HEADS * HEAD_DIM
HY_IN = 3 * HY_WIDTH
IN_WIDTH = HY_IN + ATT_WIDTH + 2 * KV_WIDTH + N_BRANCHES * D_MODEL

kernel_name = "hybrid_hyena_gqa_ec_moe_block"

F32 = jnp.float32


def rms_norm(x, g):
    xf = x.astype(F32)
    y = xf * lax.rsqrt(jnp.mean(xf * xf, axis=-1, keepdims=True) + EPS)
    return (y * g.astype(F32)).astype(x.dtype)


def short_conv_centred(u, w, b):
    L = u.shape[1]
    pad = SHORT_K // 2
    up = jnp.pad(u, ((0, 0), (pad, pad), (0, 0)))
    y = b
    for j in range(SHORT_K):
        y = y + up[:, j:j + L] * w[j]
    return y


def hyena_filters(L, w1, b1, w2, b2, w3, b3, w4, freq):
    t01 = jnp.linspace(0.0, 1.0, L, dtype=F32)[:, None]
    bands = (FILTER_EMB - 1) // 2
    f = jnp.linspace(1e-4, bands - 1, bands, dtype=F32)[None, :]
    w = (2.0 * math.pi) * jnp.arange(L, dtype=F32)[:, None] / L
    z = jnp.concatenate([t01, jnp.cos(f * w), -jnp.sin(f * w)], axis=-1)
    fr = freq.astype(F32)
    hdn = jnp.sin(fr[0] * (z @ w1.astype(F32) + b1.astype(F32)))
    hdn = jnp.sin(fr[1] * (hdn @ w2.astype(F32) + b2.astype(F32)))
    hdn = jnp.sin(fr[2] * (hdn @ w3.astype(F32) + b3.astype(F32)))
    h = (hdn @ w4.astype(F32)).reshape(L, HY_ORDER, 2, HY_WIDTH)
    max_decay = math.log(HY_DECAY_TARGET) / HY_QUICK_DECAY_PCT
    min_decay = math.log(HY_DECAY_TARGET) / HY_GRADUAL_DECAY_PCT
    deltas = jnp.linspace(min_decay, max_decay, HY_WIDTH, dtype=F32)
    h = h * jnp.exp(-t01[:, :, None, None] * jnp.abs(deltas))
    h = h / (jnp.sum(jnp.abs(h), axis=0, keepdims=True) + EPS)
    return h


def bidir_fftconv(u, h_fwd, h_bwd):
    L = u.shape[1]
    n = 2 * L
    y_f = jnp.fft.irfft(jnp.fft.rfft(u, n=n, axis=1) * jnp.fft.rfft(h_fwd, n=n, axis=0)[None], n=n, axis=1)[:, :L]
    ur = u[:, ::-1]
    y_b = jnp.fft.irfft(jnp.fft.rfft(ur, n=n, axis=1) * jnp.fft.rfft(h_bwd, n=n, axis=0)[None], n=n, axis=1)[:, :L][:, ::-1]
    return y_f + y_b


def hyena_mixer(z, short_w, short_b, w1, b1, w2, b2, w3, b3, w4, freq, filt_bias):
    L = z.shape[1]
    zc = short_conv_centred(z, short_w, short_b).astype(F32)
    v, x1, x2 = jnp.split(zc, 3, axis=-1)
    h = hyena_filters(L, w1, b1, w2, b2, w3, b3, w4, freq)
    fb = filt_bias.astype(F32)
    gates = (x1, x2)
    y = v
    for o in range(HY_ORDER):
        y = gates[o] * (bidir_fftconv(y, h[:, o, 0], h[:, o, 1]) + fb[o] * y)
    return y.astype(z.dtype)


def axial_rope_tables(L):
    rows = L // GRID_W
    row = jnp.repeat(jnp.arange(rows), GRID_W).astype(F32)
    col = jnp.tile(jnp.arange(GRID_W), rows).astype(F32)
    half = HEAD_DIM // 2
    inv = ROPE_THETA ** (-jnp.arange(0, half, 2, dtype=F32) / half)
    ang = jnp.concatenate([row[:, None] * inv, col[:, None] * inv], axis=-1)
    return jnp.cos(ang), jnp.sin(ang)


def apply_axial_rope(x, cos, sin):
    half = HEAD_DIM // 2
    quarter = half // 2

    def rot(u, c, s):
        u1, u2 = u[..., :quarter], u[..., quarter:]
        return jnp.concatenate([u1 * c - u2 * s, u1 * s + u2 * c], axis=-1)

    return jnp.concatenate([rot(x[..., :half], cos[:, :quarter], sin[:, :quarter]),
                            rot(x[..., half:], cos[:, quarter:], sin[:, quarter:])], axis=-1)


def gqa_attention(q, k, v, q_gain, k_gain):
    B, L, _ = q.shape
    G = N_HEADS // N_KV_HEADS
    q = q.reshape(B, L, N_KV_HEADS, G, HEAD_DIM).transpose(0, 2, 3, 1, 4)
    k = k.reshape(B, L, N_KV_HEADS, HEAD_DIM).transpose(0, 2, 1, 3)
    v = v.reshape(B, L, N_KV_HEADS, HEAD_DIM).transpose(0, 2, 1, 3)
    cos, sin = axial_rope_tables(L)
    q = (apply_axial_rope(rms_norm(q, q_gain).astype(F32), cos, sin) * (HEAD_DIM ** -0.5)).astype(v.dtype)
    k = apply_axial_rope(rms_norm(k, k_gain).astype(F32), cos, sin).astype(v.dtype)
    nb = L // Q_BLOCK
    qb = q.reshape(B, N_KV_HEADS, G, nb, Q_BLOCK, HEAD_DIM).transpose(3, 0, 1, 2, 4, 5)

    def block(qblk):
        s = jnp.einsum('bkgqd,bksd->bkgqs', qblk, k).astype(F32)
        p = jax.nn.softmax(s, axis=-1).astype(v.dtype)
        return jnp.einsum('bkgqs,bksd->bkgqd', p, v)

    o = lax.map(block, qb)
    return o.transpose(1, 0, 4, 2, 3, 5).reshape(B, L, ATT_WIDTH)


def expert_choice_ffn(h, w_router, w_gate, w_up, w_down):
    B, L, D = h.shape
    cap = EC_FACTOR * L // N_EXPERTS
    aff = jax.nn.softmax((h @ w_router).astype(F32), axis=-1)
    top_w, top_i = lax.top_k(jnp.swapaxes(aff, 1, 2), cap)
    xe = jax.vmap(lambda hb, ib: hb[ib])(h, top_i)
    a = jnp.einsum('becd,edf->becf', xe, w_gate)
    u = jnp.einsum('becd,edf->becf', xe, w_up)
    ye = jnp.einsum('becf,efd->becd', jax.nn.silu(a) * u, w_down)
    ye = ye * top_w[..., None].astype(ye.dtype)
    return jax.vmap(lambda ib, yb: jnp.zeros((L, D), yb.dtype).at[ib.reshape(-1)].add(yb.reshape(-1, D)))(top_i, ye)


def setup_inputs(seed: int = 0) -> dict:
    key = jax.random.key(seed)
    ks = jax.random.split(key, 32)
    D = D_MODEL

    def nrm(k, shape, scale):
        return jax.random.normal(k, shape, F32) * scale

    return {
        "x": nrm(ks[0], (BATCH, SEQ, D), 1.0),
        "c": nrm(ks[1], (BATCH, D), 1.0),
        "w_ada": nrm(ks[2], (DEPTH, D, 6 * D), 0.5 * D ** -0.5),
        "b_ada": nrm(ks[3], (DEPTH, 6 * D), 0.02),
        "g_mix": 1.0 + nrm(ks[4], (DEPTH, D), 0.02),
        "g_ffn": 1.0 + nrm(ks[5], (DEPTH, D), 0.02),
        "w_in": nrm(ks[6], (DEPTH, D, IN_WIDTH), D ** -0.5),
        "b_in": nrm(ks[7], (DEPTH, IN_WIDTH), 0.02),
        "short_w": nrm(ks[8], (DEPTH, SHORT_K, HY_IN), SHORT_K ** -0.5),
        "short_b": nrm(ks[9], (DEPTH, HY_IN), 0.02),
        "hy_w1": nrm(ks[10], (DEPTH, FILTER_EMB, FILTER_HIDDEN), FILTER_EMB ** -0.5),
        "hy_b1": nrm(ks[11], (DEPTH, FILTER_HIDDEN), 0.02),
        "hy_w2": nrm(ks[12], (DEPTH, FILTER_HIDDEN, FILTER_HIDDEN), FILTER_HIDDEN ** -0.5),
        "hy_b2": nrm(ks[13], (DEPTH, FILTER_HIDDEN), 0.02),
        "hy_w3": nrm(ks[14], (DEPTH, FILTER_HIDDEN, FILTER_HIDDEN), FILTER_HIDDEN ** -0.5),
        "hy_b3": nrm(ks[15], (DEPTH, FILTER_HIDDEN), 0.02),
        "hy_w4": nrm(ks[16], (DEPTH, FILTER_HIDDEN, HY_ORDER * 2 * HY_WIDTH), FILTER_HIDDEN ** -0.5),
        "hy_freq": 1.0 + nrm(ks[17], (DEPTH, 3, FILTER_HIDDEN), 0.02),
        "hy_bias": nrm(ks[18], (DEPTH, HY_ORDER, HY_WIDTH), 0.1),
        "q_gain": 1.0 + nrm(ks[19], (DEPTH, HEAD_DIM), 0.02),
        "k_gain": 1.0 + nrm(ks[20], (DEPTH, HEAD_DIM), 0.02),
        "w_hy_out": nrm(ks[21], (DEPTH, HY_WIDTH, D), HY_WIDTH ** -0.5),
        "w_att_out": nrm(ks[22], (DEPTH, ATT_WIDTH, D), ATT_WIDTH ** -0.5),
        "w_out": nrm(ks[23], (DEPTH, D, D), D ** -0.5),
        "w_router": nrm(ks[24], (DEPTH, D, N_EXPERTS), D ** -0.5),
        "w_gate": nrm(ks[25], (DEPTH, N_EXPERTS, D, D_FF_EXPERT), D ** -0.5),
        "w_up": nrm(ks[26], (DEPTH, N_EXPERTS, D, D_FF_EXPERT), D ** -0.5),
        "w_down": nrm(ks[27], (DEPTH, N_EXPERTS, D_FF_EXPERT, D), D_FF_EXPERT ** -0.5),
    }


def reference(x, c, w_ada, b_ada, g_mix, g_ffn, w_in, b_in, short_w, short_b,
              hy_w1, hy_b1, hy_w2, hy_b2, hy_w3, hy_b3, hy_w4, hy_freq, hy_bias,
              q_gain, k_gain, w_hy_out, w_att_out, w_out,
              w_router, w_gate, w_up, w_down):
    split_at = [HY_IN, HY_IN + ATT_WIDTH, HY_IN + ATT_WIDTH + KV_WIDTH, HY_IN + ATT_WIDTH + 2 * KV_WIDTH]
    for l in range(DEPTH):
        mod = (jax.nn.silu(c) @ w_ada[l] + b_ada[l])[:, None, :]
        sh1, sc1, gt1, sh2, sc2, gt2 = jnp.split(mod, 6, axis=-1)

        h = rms_norm(x, g_mix[l]) * (1.0 + sc1) + sh1
        z = h @ w_in[l] + b_in[l]
        z_hy, q, k, v, z_g = jnp.split(z, split_at, axis=-1)
        y_hy = hyena_mixer(z_hy, short_w[l], short_b[l], hy_w1[l], hy_b1[l], hy_w2[l], hy_b2[l],
                           hy_w3[l], hy_b3[l], hy_w4[l], hy_freq[l], hy_bias[l]) @ w_hy_out[l]
        y_at = gqa_attention(q, k, v, q_gain[l], k_gain[l]) @ w_att_out[l]
        g_hy, g_at = jnp.split(jax.nn.sigmoid(z_g), N_BRANCHES, axis=-1)
        x = x + gt1 * ((g_hy * y_hy + g_at * y_at) @ w_out[l])

        h2 = rms_norm(x, g_ffn[l]) * (1.0 + sc2) + sh2
        x = x + gt2 * expert_choice_ffn(h2, w_router[l], w_gate[l], w_up[l], w_down[l])
    return x
```

```cpp
#include <hip/hip_runtime.h>
#include <hip/hip_bf16.h>
#include <cstdio>
#include <cstdint>
#include <cmath>

#ifndef MK_N_LAUNCHES
#define MK_N_LAUNCHES 1
#endif
constexpr int N_PHASES = 11;
constexpr int NWAVES = 8;

constexpr int DM = 1024, BATCH = 4, SEQ = 8192, MTOK = BATCH * SEQ;
constexpr int HYW = 512, HYIN = 1536, ATTW = 512, KVW = 128, INW = 4352, NHEAD = 8, NKV = 2, HD = 64;
constexpr int NEXP = 16, CAP = 1024, DFF = 2048;
constexpr float EPSV = 1e-6f;

constexpr size_t MiB = 1u << 20;
constexpr size_t WS_CTL = 0, CTL_ZERO_BYTES = 1 * MiB;
constexpr size_t WS_MOD = 1 * MiB;
constexpr size_t WS_ROPE = 1 * MiB + 128 * 1024;
constexpr size_t WS_BPERM = 1 * MiB + 256 * 1024;
constexpr size_t WS_ROWSQ = 2 * MiB;
constexpr size_t WS_AFF = 4 * MiB;
constexpr size_t WS_SLOT = 6 * MiB;
constexpr size_t WS_TOPI = 8 * MiB;
constexpr size_t WS_TOPW = 8 * MiB + 256 * 1024;
constexpr size_t WS_WIN = 10 * MiB;
constexpr size_t WS_WHY = 19 * MiB;
constexpr size_t WS_WAT = 20 * MiB;
constexpr size_t WS_WO = 21 * MiB;
constexpr size_t WS_HN = 24 * MiB;
constexpr size_t WS_HRAW = 88 * MiB;
constexpr size_t WS_ZHY = 152 * MiB;
constexpr size_t WS_Q = 248 * MiB;
constexpr size_t WS_K = 280 * MiB;
constexpr size_t WS_V = 288 * MiB;
constexpr size_t WS_GATE = 296 * MiB;
constexpr size_t WS_YHY = 424 * MiB;
constexpr size_t WS_M = 456 * MiB;
constexpr size_t WS_Y1S = 520 * MiB;
constexpr size_t WS_WGU = 10 * MiB;
constexpr size_t WS_WD = 138 * MiB;
constexpr size_t WS_H2 = 202 * MiB;
constexpr size_t WS_ACT = 266 * MiB;
constexpr size_t WS_YE = 10 * MiB;
constexpr size_t WS_END = 536 * MiB;
constexpr int CW_BAR = 4096;

constexpr int LDS_SCRATCH = 147456;
constexpr int LDSCTL_OFF = LDS_SCRATCH, MISC_OFF = LDSCTL_OFF + 320;
constexpr int LDS_BYTES = 151552;

#define GAS __attribute__((address_space(1)))
#define LAS __attribute__((address_space(3)))
typedef unsigned short bf16;
typedef unsigned v4u __attribute__((ext_vector_type(4)));
typedef unsigned v2u __attribute__((ext_vector_type(2)));
typedef float f32x4 __attribute__((ext_vector_type(4)));
typedef float f32x2 __attribute__((ext_vector_type(2)));
typedef short bf16x8 __attribute__((ext_vector_type(8)));
typedef GAS unsigned gu32;
#define RLX_AGENT __ATOMIC_RELAXED, __HIP_MEMORY_SCOPE_AGENT
#define LDS_WAIT() asm volatile("s_waitcnt lgkmcnt(0)" ::: "memory")
#define VM_WAIT() asm volatile("s_waitcnt vmcnt(0)" ::: "memory")

__device__ __forceinline__ unsigned f2bf(float f) { unsigned u = __builtin_bit_cast(unsigned, f); return (u + 0x7fffu + ((u >> 16) & 1u)) >> 16; }
__device__ __forceinline__ unsigned pk2(float lo, float hi) { return f2bf(lo) | (f2bf(hi) << 16); }
__device__ __forceinline__ float bf2f(unsigned short h) { return __builtin_bit_cast(float, (unsigned)h << 16); }
__device__ __forceinline__ float bflo(unsigned w) { return __builtin_bit_cast(float, w << 16); }
__device__ __forceinline__ float bfhi(unsigned w) { return __builtin_bit_cast(float, w & 0xffff0000u); }
__device__ __forceinline__ float wave_sum(float v) {
#pragma unroll
    for (int o = 1; o < 64; o <<= 1) v += __shfl_xor(v, o);
    return v;
}
__device__ __forceinline__ int pinv32(int j) { return 16 * ((j >> 2) & 1) + 4 * (j >> 3) + (j & 3); }

struct Args { const float* in[28]; float* out; unsigned char* ws; int ph_lo, ph_hi, li, pad; };

namespace pg8 {
constexpr int BM = 256, BK = 64, HALF = 128, HTB = HALF * BK * 2, STAGE_BYTES = 8 * HTB, NXCD = 8, WGM = 8;
__host__ __device__ __forceinline__ int lds_byte(int r, int c) { const int st = (r >> 4) * 2 + (c >> 5), rr = r & 15, cc = c & 31, ob = rr * 64 + cc * 2; return st * 1024 + (ob ^ (((ob >> 9) & 1) << 5)); }
__host__ __device__ __forceinline__ void stage_rc(int b, int& R, int& C) { const int st = b / 1024, sb = b % 1024, swz = sb ^ (((sb >> 9) & 1) << 5); R = (st >> 1) * 16 + swz / 64; C = (st & 1) * 32 + (swz % 64) / 2; }

struct Unit { int pm, pn, aux; const char* A; const char* B; };

struct StaticOrder {
    int nM, nN, nwg, G, c, lda, K; const char* Ab; const char* Bb;
    __device__ void init(const void* A, const void* Bt, int M, int N, int K_, int lda_, int G_, int c_) { nM = M / BM; nN = N / BM; nwg = nM * nN; G = G_; c = c_; lda = lda_; K = K_; Ab = (const char*)A; Bb = (const char*)Bt; }
    __device__ bool next(int i, Unit& u) const {
        const long L = (long)i * G + c; if (L >= nwg) return false;
        int wgid = (int)L; { const int q = nwg / NXCD, r = nwg % NXCD, xcd = wgid % NXCD, off = wgid / NXCD; wgid = (xcd < r ? xcd * (q + 1) : r * (q + 1) + (xcd - r) * q) + off; }
        const int nig = WGM * nN, gid = wgid / nig, fm = gid * WGM, gsz = (nM - fm) < WGM ? (nM - fm) : WGM;
        u.pm = fm + ((wgid % nig) % gsz); u.pn = (wgid % nig) / gsz; u.aux = i;
        u.A = Ab + (size_t)u.pm * BM * lda * 2; u.B = Bb + (size_t)u.pn * BM * K * 2; return true;
    }
    __device__ __forceinline__ void voff(const Unit&, const int (&R)[2], const int (&C)[2], unsigned (&v)[2][2]) const {
#pragma unroll
        for (int h = 0; h < 2; ++h)
#pragma unroll
            for (int i = 0; i < 2; ++i) v[h][i] = (unsigned)((h * HALF + R[i]) * lda + C[i]) * 2u;
    }
};

template <class Epi, class Sched>
__device__ __forceinline__ void gemm_phase(LAS unsigned char* lds, const int K, const Sched& S, const Epi& E) {
    const int tid = threadIdx.x, wid = __builtin_amdgcn_readfirstlane(tid >> 6), lane = tid & 63, wr = wid >> 2, wc = wid & 3, fr = lane & 15, fq = lane >> 4;
    const int nt = K / BK;
    int Rr[2], Cc[2]; unsigned voffB[2];
#pragma unroll
    for (int i = 0; i < 2; ++i) { int R, C; stage_rc(tid * 16 + i * 8192, R, C); Rr[i] = R; Cc[i] = C; voffB[i] = (unsigned)(R * K + C) * 2u; }
    const size_t kstep = (size_t)(BK * 2);
    const size_t hstep = (size_t)HALF * K * 2;
    const unsigned ldsw = (unsigned)wid * 1024u;
    const int aoff = lds_byte(wr * 64 + fr, fq * 8), boff = lds_byte(wc * 32 + fr, fq * 8);
#define PG8_SA(b, h) (((b) * 2 + (h)) * HTB)
#define PG8_SB(b, h) ((4 + (b) * 2 + (h)) * HTB)
#define PG8_STAGE(bufoff, gbase, voff) do { _Pragma("unroll") for (int _i = 0; _i < 2; ++_i) \
        __builtin_amdgcn_global_load_lds((const unsigned*)((const char*)(gbase) + (voff)[_i]), (LAS unsigned*)(lds + (bufoff) + ldsw + _i * 8192), 16, 0, 0); } while (0)
#define PG8_LDA(dst, b, h) do { _Pragma("unroll") for (int m = 0; m < 4; ++m) _Pragma("unroll") for (int k = 0; k < 2; ++k) dst[m][k] = *(const LAS bf16x8*)(lds + PG8_SA(b, h) + aoff + m * 2048 + k * 1024); } while (0)
#define PG8_LDB(dst, b, h) do { _Pragma("unroll") for (int n = 0; n < 2; ++n) _Pragma("unroll") for (int k = 0; k < 2; ++k) dst[n][k] = *(const LAS bf16x8*)(lds + PG8_SB(b, h) + boff + n * 2048 + k * 1024); } while (0)
#define PG8_MMA(ai, bj, At, Bt) do { __builtin_amdgcn_s_setprio(1); _Pragma("unroll") for (int m = 0; m < 4; ++m) _Pragma("unroll") for (int n = 0; n < 2; ++n) _Pragma("unroll") for (int k = 0; k < 2; ++k) \
        acc[ai][bj][m][n] = __builtin_amdgcn_mfma_f32_16x16x32_bf16(Bt[n][k], At[m][k], acc[ai][bj][m][n], 0, 0, 0); __builtin_amdgcn_s_setprio(0); } while (0)
#define PG8_WAIT_V(n) asm volatile("s_waitcnt vmcnt(" #n ")" ::: "memory")
#define PG8_WAIT_L(n) asm volatile("s_waitcnt lgkmcnt(" #n ")" ::: "memory")
#define PG8_BAR __builtin_amdgcn_s_barrier()
#define PG8_SCHED __builtin_amdgcn_sched_barrier(0)
    Unit cur, nxt; int ui = 0;
    if (!S.next(0, cur)) return;
    unsigned vc[2][2], vn[2][2];
    S.voff(cur, Rr, Cc, vc);
    f32x4 acc[2][2][4][2];
#pragma unroll
    for (int a = 0; a < 2; ++a)
#pragma unroll
        for (int b = 0; b < 2; ++b)
#pragma unroll
            for (int m = 0; m < 4; ++m)
#pragma unroll
                for (int n = 0; n < 2; ++n) acc[a][b][m][n] = (f32x4){0.f, 0.f, 0.f, 0.f};
    bf16x8 At[4][2], B0[2][2], B1[2][2];
    const char* cA = cur.A; const char* cB = cur.B;
    PG8_STAGE(PG8_SB(0, 0), cB, voffB); PG8_STAGE(PG8_SB(0, 1), cB + hstep, voffB); PG8_STAGE(PG8_SA(0, 0), cA, vc[0]); PG8_STAGE(PG8_SA(0, 1), cA, vc[1]);
    if (wr == 1) PG8_BAR;
    PG8_WAIT_V(2); PG8_BAR;
    PG8_STAGE(PG8_SB(1, 0), cB + kstep, voffB); PG8_STAGE(PG8_SA(1, 0), cA + kstep, vc[0]); PG8_STAGE(PG8_SB(1, 1), cB + hstep + kstep, voffB);
    PG8_WAIT_V(6); PG8_BAR;
    for (;;) {
        const bool has_next = S.next(ui + 1, nxt);
        if (has_next) S.voff(nxt, Rr, Cc, vn);
        else {
#pragma unroll
            for (int h = 0; h < 2; ++h)
#pragma unroll
                for (int i = 0; i < 2; ++i) vn[h][i] = vc[h][i];
        }
        const char* nA = has_next ? nxt.A : cA; const char* nB = has_next ? nxt.B : cB;
        for (int t = 0; t < nt; t += 2) {
            const bool last = (t == nt - 2);
            const char* a1 = cA + (size_t)(t + 1) * kstep;
            const char* a2 = last ? nA : cA + (size_t)(t + 2) * kstep; const char* b2 = last ? nB : cB + (size_t)(t + 2) * kstep;
            const char* a3 = a2 + kstep; const char* b3 = b2 + kstep;
            unsigned s0[2], s1[2];
            s0[0] = last ? vn[0][0] : vc[0][0]; s0[1] = last ? vn[0][1] : vc[0][1]; s1[0] = last ? vn[1][0] : vc[1][0]; s1[1] = last ? vn[1][1] : vc[1][1];
            PG8_LDB(B0, 0, 0); PG8_LDB(B1, 0, 1); PG8_SCHED; PG8_LDA(At, 0, 0); PG8_STAGE(PG8_SA(1, 1), a1, vc[1]);
            PG8_WAIT_V(8); PG8_WAIT_L(0); PG8_BAR; PG8_MMA(0, 0, At, B0); PG8_MMA(0, 1, At, B1); PG8_BAR; PG8_SCHED;
            PG8_LDA(At, 0, 1); PG8_STAGE(PG8_SB(0, 0), b2, voffB); PG8_STAGE(PG8_SB(0, 1), b2 + hstep, voffB); PG8_STAGE(PG8_SA(0, 0), a2, s0);
            PG8_WAIT_V(8); PG8_WAIT_L(0); PG8_BAR; PG8_MMA(1, 0, At, B0); PG8_MMA(1, 1, At, B1); PG8_BAR; PG8_SCHED;
            PG8_LDB(B0, 1, 0); PG8_LDB(B1, 1, 1); PG8_SCHED; PG8_LDA(At, 1, 0); PG8_STAGE(PG8_SA(0, 1), a2, s1);
            PG8_WAIT_V(8); PG8_WAIT_L(0); PG8_BAR; PG8_MMA(0, 0, At, B0); PG8_MMA(0, 1, At, B1); PG8_BAR; PG8_SCHED;
            PG8_LDA(At, 1, 1); PG8_STAGE(PG8_SB(1, 0), b3, voffB); PG8_STAGE(PG8_SB(1, 1), b3 + hstep, voffB); PG8_STAGE(PG8_SA(1, 0), a3, s0);
            PG8_WAIT_V(8); PG8_WAIT_L(0); PG8_BAR; PG8_MMA(1, 0, At, B0); PG8_MMA(1, 1, At, B1); PG8_BAR; PG8_SCHED;
        }
        if (wr == 0) PG8_BAR;
        E(acc, cur, wr, wc, fr, fq);
        if (!has_next) break;
#pragma unroll
        for (int a = 0; a < 2; ++a)
#pragma unroll
            for (int b = 0; b < 2; ++b)
#pragma unroll
                for (int m = 0; m < 4; ++m)
#pragma unroll
                    for (int n = 0; n < 2; ++n) acc[a][b][m][n] = (f32x4){0.f, 0.f, 0.f, 0.f};
        cur = nxt; cA = nA; cB = nB; ++ui;
#pragma unroll
        for (int h = 0; h < 2; ++h)
#pragma unroll
            for (int i = 0; i < 2; ++i) vc[h][i] = vn[h][i];
        if (wr == 1) PG8_BAR;
    }
    PG8_WAIT_V(0);
    PG8_BAR;
#undef PG8_SA
#undef PG8_SB
#undef PG8_STAGE
#undef PG8_LDA
#undef PG8_LDB
#undef PG8_MMA
#undef PG8_WAIT_V
#undef PG8_WAIT_L
#undef PG8_BAR
#undef PG8_SCHED
}
}

constexpr float C2Q = 0.125f * 1.4426950408889634f;

struct EpiIn {
    bf16* zhy; bf16* q; bf16* k; bf16* v; bf16* gate; const float* bperm; const float* qgain; const float* kgain; const float* cs;
    __device__ __forceinline__ void operator()(const f32x4 (&acc)[2][2][4][2], const pg8::Unit& u, int wr, int wc, int fr, int fq) const {
        const int pn = u.pn; const int row0 = u.pm * 256 + wr * 64 + fr;
        f32x4 bv[2][2];
#pragma unroll
        for (int bj = 0; bj < 2; ++bj)
#pragma unroll
            for (int n = 0; n < 2; ++n) bv[bj][n] = *(const f32x4*)(bperm + pn * 256 + bj * 128 + wc * 32 + n * 16 + 4 * fq);
        if (pn < 6) {
            const int b = row0 >> 13;
#pragma unroll
            for (int ai = 0; ai < 2; ++ai)
#pragma unroll
                for (int m = 0; m < 4; ++m) { const int t = (row0 + ai * 128 + m * 16) & (SEQ - 1);
#pragma unroll
                    for (int bj = 0; bj < 2; ++bj)
#pragma unroll
                        for (int n = 0; n < 2; ++n) { const f32x4 x = acc[ai][bj][m][n] + bv[bj][n]; const int ch = pn * 256 + bj * 128 + wc * 32 + n * 16 + 4 * fq;
                            bf16* o = zhy + ((size_t)(b * HYIN + ch)) * SEQ + t;
                            o[0] = (bf16)f2bf(x[0]); o[SEQ] = (bf16)f2bf(x[1]); o[2 * SEQ] = (bf16)f2bf(x[2]); o[3 * SEQ] = (bf16)f2bf(x[3]); } }
        } else if (pn < 9) {
            const bool isq = pn < 8; const bool isv = (!isq) && (wc >= 2);
            const float* gain = isq ? qgain : kgain;
            f32x4 gv[2][2];
#pragma unroll
            for (int bj = 0; bj < 2; ++bj)
#pragma unroll
                for (int n = 0; n < 2; ++n) gv[bj][n] = *(const f32x4*)(gain + bj * 32 + n * 16 + 4 * fq);
            bf16* obase; int pitch, hcol;
            if (isq) { obase = q; pitch = ATTW; hcol = ((pn - 6) * 4 + wc) * 64; }
            else if (!isv) { obase = k; pitch = KVW; hcol = wc * 64; }
            else { obase = v; pitch = KVW; hcol = (wc - 2) * 64; }
            const float osc = isq ? C2Q : 1.0f;
#pragma unroll
            for (int ai = 0; ai < 2; ++ai)
#pragma unroll
                for (int m = 0; m < 4; ++m) { const int row = row0 + ai * 128 + m * 16; const int t = row & (SEQ - 1);
                    f32x4 y[2][2]; float ss = 0.f;
#pragma unroll
                    for (int bj = 0; bj < 2; ++bj)
#pragma unroll
                        for (int n = 0; n < 2; ++n) { y[bj][n] = acc[ai][bj][m][n] + bv[bj][n]; ss += (y[bj][n][0] * y[bj][n][0] + y[bj][n][1] * y[bj][n][1]) + (y[bj][n][2] * y[bj][n][2] + y[bj][n][3] * y[bj][n][3]); }
                    bf16* orow = obase + (size_t)row * pitch + hcol + 4 * fq;
                    if (!isv) {
                        ss += __shfl_xor(ss, 16); ss += __shfl_xor(ss, 32);
                        const float rstd = 1.0f / sqrtf(ss * (1.0f / 64.0f) + EPSV);
#pragma unroll
                        for (int bj = 0; bj < 2; ++bj) { const int pos = bj == 0 ? (t >> 6) : (t & 63);
                            const f32x4 cc = *(const f32x4*)(cs + pos * 32 + 4 * fq), sn = *(const f32x4*)(cs + pos * 32 + 16 + 4 * fq);
                            const f32x4 u1 = y[bj][0] * rstd * gv[bj][0], u2 = y[bj][1] * rstd * gv[bj][1];
                            y[bj][0] = (u1 * cc - u2 * sn) * osc; y[bj][1] = (u1 * sn + u2 * cc) * osc; }
                    }
#pragma unroll
                    for (int bj = 0; bj < 2; ++bj)
#pragma unroll
                        for (int n = 0; n < 2; ++n) { v2u w; w.x = pk2(y[bj][n][0], y[bj][n][1]); w.y = pk2(y[bj][n][2], y[bj][n][3]); *(v2u*)(orow + bj * 32 + n * 16) = w; } }
        } else {
            const int colt = (pn - 9) * 256 + wc * 32 + 8 * fq;
#pragma unroll
            for (int ai = 0; ai < 2; ++ai)
#pragma unroll
                for (int m = 0; m < 4; ++m) { bf16* rowp = gate + (size_t)(row0 + ai * 128 + m * 16) * 2048 + colt;
#pragma unroll
                    for (int bj = 0; bj < 2; ++bj) { f32x4 v0 = acc[ai][bj][m][0] + bv[bj][0], v1 = acc[ai][bj][m][1] + bv[bj][1];
#pragma unroll
                        for (int e = 0; e < 4; ++e) { v0[e] = 1.0f / (1.0f + __expf(-v0[e])); v1[e] = 1.0f / (1.0f + __expf(-v1[e])); }
                        v4u w; w.x = pk2(v0[0], v0[1]); w.y = pk2(v0[2], v0[3]); w.z = pk2(v1[0], v1[1]); w.w = pk2(v1[2], v1[3]);
                        *(v4u*)(rowp + bj * 128) = w; } }
        }
    }
};

template <int MODE> struct EpiMerge {
    bf16* mbuf; const bf16* gate; int gcol0;
    __device__ __forceinline__ void operator()(const f32x4 (&acc)[2][2][4][2], const pg8::Unit& u, int wr, int wc, int fr, int fq) const {
        const int row0 = u.pm * 256 + wr * 64 + fr; const int col0 = u.pn * 256 + wc * 32 + 8 * fq;
#pragma unroll
        for (int ai = 0; ai < 2; ++ai)
#pragma unroll
            for (int m = 0; m < 4; ++m) { const size_t row = (size_t)(row0 + ai * 128 + m * 16);
#pragma unroll
                for (int bj = 0; bj < 2; ++bj) { const v4u g = *(const v4u*)(gate + row * 2048 + gcol0 + col0 + bj * 128);
                    bf16* mp = mbuf + row * DM + col0 + bj * 128;
                    f32x4 v0 = acc[ai][bj][m][0], v1 = acc[ai][bj][m][1];
                    v0[0] *= bflo(g.x); v0[1] *= bfhi(g.x); v0[2] *= bflo(g.y); v0[3] *= bfhi(g.y); v1[0] *= bflo(g.z); v1[1] *= bfhi(g.z); v1[2] *= bflo(g.w); v1[3] *= bfhi(g.w);
                    if (MODE == 1) { const v4u p = *(const v4u*)mp; v0[0] += bflo(p.x); v0[1] += bfhi(p.x); v0[2] += bflo(p.y); v0[3] += bfhi(p.y); v1[0] += bflo(p.z); v1[1] += bfhi(p.z); v1[2] += bflo(p.w); v1[3] += bfhi(p.w); }
                    v4u w; w.x = pk2(v0[0], v0[1]); w.y = pk2(v0[2], v0[3]); w.z = pk2(v1[0], v1[1]); w.w = pk2(v1[2], v1[3]);
                    *(v4u*)mp = w; } }
    }
};

struct EpiOut {
    const float* x; float* out; const float* mod; float* rowsq;
    __device__ __forceinline__ void operator()(const f32x4 (&acc)[2][2][4][2], const pg8::Unit& u, int wr, int wc, int fr, int fq) const {
        const int row0 = u.pm * 256 + wr * 64 + fr; const int col0 = u.pn * 256 + wc * 32 + 4 * fq; const int b = row0 >> 13;
        f32x4 gt[2][2];
#pragma unroll
        for (int bj = 0; bj < 2; ++bj)
#pragma unroll
            for (int n = 0; n < 2; ++n) gt[bj][n] = *(const f32x4*)(mod + b * 6144 + 2048 + col0 + bj * 128 + n * 16);
#pragma unroll
        for (int ai = 0; ai < 2; ++ai)
#pragma unroll
            for (int m = 0; m < 4; ++m) { const size_t row = (size_t)(row0 + ai * 128 + m * 16); float ss = 0.f;
#pragma unroll
                for (int bj = 0; bj < 2; ++bj)
#pragma unroll
                    for (int n = 0; n < 2; ++n) { const size_t off = row * DM + col0 + bj * 128 + n * 16; const f32x4 xv = *(const f32x4*)(x + off);
                        const f32x4 o = xv + gt[bj][n] * acc[ai][bj][m][n]; ss += (o[0] * o[0] + o[1] * o[1]) + (o[2] * o[2] + o[3] * o[3]); *(f32x4*)(out + off) = o; }
                ss += __shfl_xor(ss, 16); ss += __shfl_xor(ss, 32);
                if (fq == 0) rowsq[row * 16 + u.pn * 4 + wc] = ss; }
    }
};

struct EpiSwiglu {
    bf16* act;
    __device__ __forceinline__ void operator()(const f32x4 (&acc)[2][2][4][2], const pg8::Unit& u, int wr, int wc, int fr, int fq) const {
        const int row0 = u.pm * 256 + wr * 64 + fr; const int col0 = u.pn * 128 + wc * 32 + 8 * fq;
#pragma unroll
        for (int ai = 0; ai < 2; ++ai)
#pragma unroll
            for (int m = 0; m < 4; ++m) { f32x4 a0 = acc[ai][0][m][0], a1 = acc[ai][0][m][1]; const f32x4 u0 = acc[ai][1][m][0], u1 = acc[ai][1][m][1];
#pragma unroll
                for (int e = 0; e < 4; ++e) { a0[e] = a0[e] / (1.0f + __expf(-a0[e])) * u0[e]; a1[e] = a1[e] / (1.0f + __expf(-a1[e])) * u1[e]; }
                v4u w; w.x = pk2(a0[0], a0[1]); w.y = pk2(a0[2], a0[3]); w.z = pk2(a1[0], a1[1]); w.w = pk2(a1[2], a1[3]);
                *(v4u*)(act + (size_t)(row0 + ai * 128 + m * 16) * DFF + col0) = w; }
    }
};

struct EpiDown {
    bf16* ye; const float* topw;
    __device__ __forceinline__ void operator()(const f32x4 (&acc)[2][2][4][2], const pg8::Unit& u, int wr, int wc, int fr, int fq) const {
        const int row0 = u.pm * 256 + wr * 64 + fr; const int col0 = u.pn * 256 + wc * 32 + 8 * fq;
#pragma unroll
        for (int ai = 0; ai < 2; ++ai)
#pragma unroll
            for (int m = 0; m < 4; ++m) { const int row = row0 + ai * 128 + m * 16; const float w8 = topw[row];
#pragma unroll
                for (int bj = 0; bj < 2; ++bj) { const f32x4 v0 = acc[ai][bj][m][0] * w8, v1 = acc[ai][bj][m][1] * w8;
                    v4u w; w.x = pk2(v0[0], v0[1]); w.y = pk2(v0[2], v0[3]); w.z = pk2(v1[0], v1[1]); w.w = pk2(v1[2], v1[3]);
                    *(v4u*)(ye + (size_t)row * DM + col0 + bj * 128) = w; } }
    }
};

struct MoeUpOrder {
    int G, c; const char* h2; const char* wgu; const LAS int* idx;
    __device__ bool decode(long L, int& e, int& b, int& mblk, int& pn) const {
        if (L >= 4096) return false; e = (int)(L >> 8); const int w = (int)(L & 255), x = w & 7, j = w >> 3; pn = 2 * x + (j & 1); const int m16 = j >> 1; b = m16 >> 2; mblk = m16 & 3; return true; }
    __device__ bool next(int i, pg8::Unit& u) const {
        int e, b, mblk, pn; if (!decode((long)i * G + c, e, b, mblk, pn)) return false;
        u.pm = (b * NEXP + e) * 4 + mblk; u.pn = pn; u.aux = i; u.A = h2 + (size_t)b * SEQ * DM * 2; u.B = wgu + (size_t)(e * 16 + pn) * 256 * DM * 2; return true; }
    __device__ __forceinline__ void voff(const pg8::Unit& u, const int (&R)[2], const int (&C)[2], unsigned (&v)[2][2]) const {
#pragma unroll
        for (int h = 0; h < 2; ++h)
#pragma unroll
            for (int i = 0; i < 2; ++i) { const int tok = idx[(u.aux & 15) * 256 + h * 128 + R[i]]; v[h][i] = (unsigned)(tok * DM + C[i]) * 2u; }
    }
};
struct MoeDownOrder {
    int G, c; const char* act; const char* wd;
    __device__ bool next(int i, pg8::Unit& u) const {
        const long L = (long)i * G + c; if (L >= 1024) return false;
        const int r = (int)(L >> 8), w = (int)(L & 255), x = w & 7, j = w >> 3; const int e = 4 * r + (x >> 1), pn = 2 * (x & 1) + (j & 1), m16 = j >> 1, b = m16 >> 2, mblk = m16 & 3;
        u.pm = (b * NEXP + e) * 4 + mblk; u.pn = pn; u.aux = i; u.A = act + (size_t)u.pm * 256 * DFF * 2; u.B = wd + (size_t)(e * 4 + pn) * 256 * DFF * 2; return true; }
    __device__ __forceinline__ void voff(const pg8::Unit&, const int (&R)[2], const int (&C)[2], unsigned (&v)[2][2]) const {
#pragma unroll
        for (int h = 0; h < 2; ++h)
#pragma unroll
            for (int i = 0; i < 2; ++i) v[h][i] = (unsigned)((h * 128 + R[i]) * DFF + C[i]) * 2u;
    }
};

namespace attn_body {
using bf16h = __hip_bfloat16;
using s16x4 = __attribute__((ext_vector_type(4))) short;
using f32x16 = __attribute__((ext_vector_type(16))) float;
using u32x4 = __attribute__((ext_vector_type(4))) unsigned;
constexpr int D = 64, QP = ATTW, KP = KVW;
constexpr int NW = 8, QBLK = 32, QB = QBLK * NW, KVBLK = 64;
__device__ __forceinline__ int crow(int r, int hi) { return (r & 3) + 8 * (r >> 2) + 4 * hi; }
#define SBAR() __builtin_amdgcn_sched_barrier(0)
constexpr int NSLOT = 3, SLOTB = 8192;
constexpr int LDS_K = 0, LDS_V = NSLOT * SLOTB, LDS_WS = 2 * NSLOT * SLOTB, LDS_OST = LDS_WS + NW * 64 * 4, LDS_ATT_BYTES = LDS_OST + NW * 4096;
__device__ __forceinline__ void glds16(const void* gsrc, unsigned lds_dst) { unsigned keep;
  asm volatile("s_mov_b32 %0, m0\n\ts_mov_b32 m0, %2\n\ts_nop 0\n\tglobal_load_lds_dwordx4 %1, off\n\ts_mov_b32 m0, %0" : "=&s"(keep) : "v"(gsrc), "s"(lds_dst) : "memory"); }
__device__ __forceinline__ float max3f(float a, float b, float c) { float r; asm("v_max3_f32 %0, %1, %2, %3" : "=v"(r) : "v"(a), "v"(b), "v"(c)); return r; }
__device__ __forceinline__ float max2f(float a, float b) { float r; asm("v_max_f32_e32 %0, %1, %2" : "=v"(r) : "v"(a), "v"(b)); return r; }
__device__ __forceinline__ float fadd_s(float a, float b) { float r; asm("v_add_f32_e32 %0, %1, %2" : "=v"(r) : "v"(a), "v"(b)); return r; }
__device__ __forceinline__ float fsub_s(float a, float b) { float r; asm("v_sub_f32_e32 %0, %1, %2" : "=v"(r) : "v"(a), "v"(b)); return r; }
typedef float f32x2_t __attribute__((ext_vector_type(2))); typedef __bf16 bf16x2_t __attribute__((ext_vector_type(2)));
__device__ __forceinline__ unsigned cvtpk_s(float lo, float hi) { f32x2_t v = {lo, hi}; bf16x2_t b = __builtin_convertvector(v, bf16x2_t); return __builtin_bit_cast(unsigned, b); }
#define WAIT_BAR(N) asm volatile("s_waitcnt vmcnt(" #N ") lgkmcnt(0)\n\ts_barrier" ::: "memory")
__device__ __forceinline__ void qkt(f32x16& p0, f32x16& p1, const char* Kslot, const bf16x8* qr, const f32x16& negm, int r32, int hi) {
  const char* kb = Kslot + hi * 1024 + r32 * 16;
  #pragma unroll
  for (int d0 = 0; d0 < 4; ++d0) {
    const bf16x8 b0 = *reinterpret_cast<const bf16x8*>(kb + d0 * 2048);
    const bf16x8 b1 = *reinterpret_cast<const bf16x8*>(kb + d0 * 2048 + 512);
    if (d0 == 0) { p0 = __builtin_amdgcn_mfma_f32_32x32x16_bf16(b0, qr[0], negm, 0, 0, 0); p1 = __builtin_amdgcn_mfma_f32_32x32x16_bf16(b1, qr[0], negm, 0, 0, 0); }
    else { p0 = __builtin_amdgcn_mfma_f32_32x32x16_bf16(b0, qr[d0], p0, 0, 0, 0); p1 = __builtin_amdgcn_mfma_f32_32x32x16_bf16(b1, qr[d0], p1, 0, 0, 0); } }
}
typedef __attribute__((address_space(3))) const char* lds_cptr;
typedef short v4i16_t __attribute__((ext_vector_type(4)));
__device__ __forceinline__ void kload8(bf16x8* kf, lds_cptr kp) {
  kf[0] = *(const __attribute__((address_space(3))) bf16x8*)(kp);        kf[1] = *(const __attribute__((address_space(3))) bf16x8*)(kp + 512);
  kf[2] = *(const __attribute__((address_space(3))) bf16x8*)(kp + 2048); kf[3] = *(const __attribute__((address_space(3))) bf16x8*)(kp + 2560);
  kf[4] = *(const __attribute__((address_space(3))) bf16x8*)(kp + 4096); kf[5] = *(const __attribute__((address_space(3))) bf16x8*)(kp + 4608);
  kf[6] = *(const __attribute__((address_space(3))) bf16x8*)(kp + 6144); kf[7] = *(const __attribute__((address_space(3))) bf16x8*)(kp + 6656);
}
__device__ __forceinline__ void kload2(bf16x8* kf, lds_cptr kp, int j) { kf[2 * j] = *(const __attribute__((address_space(3))) bf16x8*)(kp + j * 2048); kf[2 * j + 1] = *(const __attribute__((address_space(3))) bf16x8*)(kp + j * 2048 + 512); }
__device__ __forceinline__ s16x4 vtr(lds_cptr p) { return __builtin_bit_cast(s16x4, __builtin_amdgcn_ds_read_tr16_b64_v4i16((__attribute__((address_space(3))) v4i16_t*)p)); }
__device__ __forceinline__ float rowmax(const f32x16& p0, const f32x16& p1) {
  float a = max3f(p0[0], p0[1], p1[0]), b = max3f(p0[2], p0[3], p1[1]); a = max3f(a, p1[2], p1[3]);
  #pragma unroll
  for (int r = 4; r < 16; r += 4) { a = max3f(a, p0[r], p0[r + 1]); b = max3f(b, p0[r + 2], p0[r + 3]); a = max3f(a, p1[r], p1[r + 1]); b = max3f(b, p1[r + 2], p1[r + 3]); }
  const float m = max2f(a, b);
  auto rr = __builtin_amdgcn_permlane32_swap(__float_as_uint(m), __float_as_uint(m), false, false);
  return max2f(__uint_as_float(rr[0]), __uint_as_float(rr[1]));
}
__device__ __forceinline__ void pv(f32x16* o, int vb, bf16x8 pa0, bf16x8 pa1, bf16x8 pa2, bf16x8 pa3) {
  #pragma unroll
  for (int d0 = 0; d0 < 2; ++d0) { s16x4 lo[4], hi[4];
    #pragma unroll
    for (int ks = 0; ks < 4; ++ks) {
      asm volatile("ds_read_b64_tr_b16 %0,%1 offset:%c2" : "=&v"(lo[ks]) : "v"(vb), "i"(d0 * 4096 + ks * 1024) : "memory");
      asm volatile("ds_read_b64_tr_b16 %0,%1 offset:%c2" : "=&v"(hi[ks]) : "v"(vb), "i"(d0 * 4096 + ks * 1024 + 512) : "memory"); }
    asm volatile("s_waitcnt lgkmcnt(0)" ::: "memory"); SBAR();
    #define PK(k) (bf16x8){lo[k][0], lo[k][1], lo[k][2], lo[k][3], hi[k][0], hi[k][1], hi[k][2], hi[k][3]}
    o[d0] = __builtin_amdgcn_mfma_f32_32x32x16_bf16(pa0, PK(0), o[d0], 0, 0, 0);
    o[d0] = __builtin_amdgcn_mfma_f32_32x32x16_bf16(pa1, PK(1), o[d0], 0, 0, 0);
    o[d0] = __builtin_amdgcn_mfma_f32_32x32x16_bf16(pa2, PK(2), o[d0], 0, 0, 0);
    o[d0] = __builtin_amdgcn_mfma_f32_32x32x16_bf16(pa3, PK(3), o[d0], 0, 0, 0);
    #undef PK
  }
}
template <int THRL> __device__ __forceinline__ void attn_unit(int b, int h, int qb, const bf16h* Q, const bf16h* __restrict__ K, const bf16h* __restrict__ V, bf16h* O, char* shm) {
  const int tid = threadIdx.x, lane = tid & 63, r32 = lane & 31, hi = lane >> 5; const int wid = __builtin_amdgcn_readfirstlane(tid >> 6);
  const long rowbase = (long)b * SEQ; const int q0 = qb * QB; const int kvh = h >> 2;
  const bf16h* Qw = Q + (rowbase + q0 + wid * QBLK) * QP + h * D;
  const bf16h* Kh = K + rowbase * KP + kvh * D, *Vh = V + rowbase * KP + kvh * D;
  const unsigned lds0 = (unsigned)(uintptr_t)shm;
  float* wsf = (float*)(shm + LDS_WS) + wid * 64;
  const bf16h* ksrc = Kh + (long)lane * KP + wid * 8;
  const bf16h* vsrc = Vh + (long)(16 * (wid & 3) + (lane >> 2)) * KP + (wid >> 2) * 32 + (lane & 3) * 8;
  const unsigned kdst = lds0 + LDS_K + wid * 1024, vdst = lds0 + LDS_V + wid * 1024;
  #define DMA_K(t, slot) glds16(ksrc + (long)(t) * KVBLK * KP, (unsigned)__builtin_amdgcn_readfirstlane(kdst + (slot)))
  #define DMA_V(t, slot) glds16(vsrc + (long)(t) * KVBLK * KP, (unsigned)__builtin_amdgcn_readfirstlane(vdst + (slot)))
  const int vb0 = (int)(lds0 + LDS_V) + ((lane >> 4) & 1) * 32 + (lane & 3) * 8 + (4 * hi + ((lane & 15) >> 2)) * 64;
  const char* Kbase = shm + LDS_K; bf16x8 kf[8];
  const lds_cptr shm3 = (lds_cptr)shm; const lds_cptr kp0 = shm3 + LDS_K + hi * 1024 + r32 * 16; const lds_cptr vp0 = shm3 + LDS_V + ((lane >> 4) & 1) * 32 + (lane & 3) * 8 + (4 * hi + ((lane & 15) >> 2)) * 64;
  constexpr int NT = SEQ / KVBLK;
  DMA_K(0, 0); DMA_V(0, 0); DMA_K(1, SLOTB);
  bf16x8 qr[4];
  #pragma unroll
  for (int d0 = 0; d0 < 4; ++d0) qr[d0] = *reinterpret_cast<const bf16x8*>(&Qw[(long)r32 * QP + d0 * 16 + hi * 8]);
  float mhat = 0.f, l_reg = 0.f; f32x16 o[2]; o[0] = f32x16{}; o[1] = f32x16{}; f32x16 negm = f32x16{}; asm volatile("" : "+v"(negm));
  bool resc = false;
  #define START(P0, P1) do { const float rm = rowmax(P0, P1); resc = false; \
    { const float dl = rm; mhat = fadd_s(mhat, dl); \
      _Pragma("unroll") for (int r = 0; r < 16; ++r) { P0[r] = fsub_s(P0[r], dl); P1[r] = fsub_s(P1[r], dl); } \
      _Pragma("unroll") for (int r = 0; r < 16; ++r) negm[r] = -mhat; asm volatile("" : "+v"(negm)); } \
    _Pragma("unroll") for (int r = 0; r < 16; ++r) P0[r] = __builtin_amdgcn_exp2f(P0[r]); } while (0)
  #define RESC() do { if (resc) { asm volatile("s_waitcnt lgkmcnt(0)" ::: "memory"); \
      _Pragma("unroll") for (int d_ = 0; d_ < 2; ++d_) _Pragma("unroll") for (int r = 0; r < 16; ++r) o[d_][r] *= wsf[crow(r, hi)]; } } while (0)
  f32x16 pA0, pA1, pB0, pB1;
  int sl_prev = 0, sl_cur = 0, sl_next = SLOTB;
  #define ROT() do { sl_prev = sl_cur; sl_cur = sl_next; sl_next = (sl_next == (NSLOT - 1) * SLOTB) ? 0 : sl_next + SLOTB; } while (0)
  DMA_K(2, 2 * SLOTB);
  WAIT_BAR(3);
  qkt(pA0, pA1, Kbase, qr, negm, r32, hi); asm volatile("s_nop 15\n\ts_nop 7" : "+v"(pA0), "+v"(pA1));
  START(pA0, pA1);
  _Pragma("unroll") for (int r = 0; r < 16; ++r) pA1[r] = __builtin_amdgcn_exp2f(pA1[r]);
  WAIT_BAR(0);
  DMA_K(3, 0); DMA_V(1, SLOTB);
  ROT();
  kload8(kf, kp0 + sl_cur);
  WAIT_BAR(2);
  s16x4 vlo[8], vhi[8]; u32x4 pw0, pw1, pw2, pw3;
  #define PKW(P, B) cvtpk_s(P[B], P[B + 1])
  #define PAF(k) __builtin_bit_cast(bf16x8, pw##k)
  #define VFR(i) (bf16x8){vlo[i][0], vlo[i][1], vlo[i][2], vlo[i][3], vhi[i][0], vhi[i][1], vhi[i][2], vhi[i][3]}
  #define PIN(x) asm volatile("" : "+v"(x))
  #define MX3(a, b, c) __builtin_fmaxf(__builtin_fmaxf((a), (b)), (c))
  #define GAPA(MF, A0, A1, A2, A3, W0, W1, PW) do { MF; sacc += A0; sacc += A1; sacc += A2; sacc += A3; PIN(sacc); W0; W1; PIN(PW); SBAR(); } while (0)
  #define EX(v) __builtin_amdgcn_exp2f(v)
  #define GAPB(MF, X, B) do { MF; X[B] = EX(X[B]); X[B + 1] = EX(X[B + 1]); X[B + 2] = EX(X[B + 2]); X[B + 3] = EX(X[B + 3]); PIN(X); SBAR(); } while (0)
  #define VRD(i) do { vlo[i] = vtr(vp_ + (((i) >> 2) * 4096 + ((i) & 3) * 1024)); vhi[i] = vtr(vp_ + (((i) >> 2) * 4096 + ((i) & 3) * 1024 + 512)); } while (0)
  #define KRD(G, j) do { if (G) { kload2(kf, kp0 + sl_next, j); SBAR(); } } while (0)
  #define STEP(C0, C1, P0, P1, t, GK, GV, GL) do { SBAR(); \
    const lds_cptr vp_ = vp0 + sl_prev; \
    VRD(0); SBAR(); float sacc = (P0[0] + P0[1]); \
    GAPA(C0 = __builtin_amdgcn_mfma_f32_32x32x16_bf16(kf[0], qr[0], negm, 0, 0, 0), P0[2], P0[3], P0[4], P0[5],     pw0[0] = PKW(P0, 0), pw0[1] = PKW(P0, 2), pw0); \
    VRD(4); SBAR(); GAPA(C1 = __builtin_amdgcn_mfma_f32_32x32x16_bf16(kf[1], qr[0], negm, 0, 0, 0), P0[6], P0[7], P0[8], P0[9],     pw0[2] = PKW(P0, 4), pw0[3] = PKW(P0, 6), pw0); \
    VRD(1); SBAR(); GAPA(C0 = __builtin_amdgcn_mfma_f32_32x32x16_bf16(kf[2], qr[1], C0, 0, 0, 0),   P0[10], P0[11], P0[12], P0[13], pw1[0] = PKW(P0, 8), pw1[1] = PKW(P0, 10), pw1); \
    VRD(5); SBAR(); GAPA(C1 = __builtin_amdgcn_mfma_f32_32x32x16_bf16(kf[3], qr[1], C1, 0, 0, 0),   P0[14], P0[15], P1[0], P1[1],   pw1[2] = PKW(P0, 12), pw1[3] = PKW(P0, 14), pw1); \
    VRD(2); SBAR(); GAPA(C0 = __builtin_amdgcn_mfma_f32_32x32x16_bf16(kf[4], qr[2], C0, 0, 0, 0),   P1[2], P1[3], P1[4], P1[5],     pw2[0] = PKW(P1, 0), pw2[1] = PKW(P1, 2), pw2); \
    VRD(6); SBAR(); GAPA(C1 = __builtin_amdgcn_mfma_f32_32x32x16_bf16(kf[5], qr[2], C1, 0, 0, 0),   P1[6], P1[7], P1[8], P1[9],     pw2[2] = PKW(P1, 4), pw2[3] = PKW(P1, 6), pw2); \
    VRD(3); SBAR(); GAPA(C0 = __builtin_amdgcn_mfma_f32_32x32x16_bf16(kf[6], qr[3], C0, 0, 0, 0),   P1[10], P1[11], P1[12], P1[13], pw3[0] = PKW(P1, 8), pw3[1] = PKW(P1, 10), pw3); \
    VRD(7); SBAR(); GAPA(C1 = __builtin_amdgcn_mfma_f32_32x32x16_bf16(kf[7], qr[3], C1, 0, 0, 0),   P1[14], P1[15], 0.f, 0.f,       pw3[2] = PKW(P1, 12), pw3[3] = PKW(P1, 14), pw3); \
    l_reg += sacc; \
    if (GK) { DMA_K((t) + 3, sl_cur); } if (GV) { DMA_V((t) + 1, sl_next); } \
    { float a = MX3(C0[0], C0[1], C1[0]), b = MX3(C0[2], C0[3], C1[1]); a = MX3(a, C1[2], C1[3]); \
      _Pragma("unroll") for (int r = 4; r < 16; r += 4) { a = MX3(a, C0[r], C0[r + 1]); b = MX3(b, C0[r + 2], C0[r + 3]); a = MX3(a, C1[r], C1[r + 1]); b = MX3(b, C1[r + 2], C1[r + 3]); } \
      float rm = __builtin_fmaxf(a, b); { auto rr = __builtin_amdgcn_permlane32_swap(__float_as_uint(rm), __float_as_uint(rm), false, false); rm = __builtin_fmaxf(__uint_as_float(rr[0]), __uint_as_float(rr[1])); } \
      resc = false; \
      if (__builtin_expect(__any(rm > (float)THRL), 0)) { const float dl = __builtin_fmaxf(rm, 0.f); mhat += dl; \
        _Pragma("unroll") for (int r = 0; r < 16; ++r) { C0[r] -= dl; C1[r] -= dl; } \
        _Pragma("unroll") for (int r = 0; r < 16; ++r) negm[r] = -mhat; asm volatile("" : "+v"(negm)); \
        const float f = __builtin_amdgcn_exp2f(-dl); l_reg *= f; if (hi == 0) wsf[r32] = f; resc = true; } } \
    SBAR(); \
    GAPB(o[0] = __builtin_amdgcn_mfma_f32_32x32x16_bf16(PAF(0), VFR(0), o[0], 0, 0, 0), C0, 0); \
    GAPB(o[1] = __builtin_amdgcn_mfma_f32_32x32x16_bf16(PAF(0), VFR(4), o[1], 0, 0, 0), C0, 4); \
    KRD(GL, 0); GAPB(o[0] = __builtin_amdgcn_mfma_f32_32x32x16_bf16(PAF(1), VFR(1), o[0], 0, 0, 0), C0, 8); \
    KRD(GL, 1); GAPB(o[1] = __builtin_amdgcn_mfma_f32_32x32x16_bf16(PAF(1), VFR(5), o[1], 0, 0, 0), C0, 12); \
    KRD(GL, 2); GAPB(o[0] = __builtin_amdgcn_mfma_f32_32x32x16_bf16(PAF(2), VFR(2), o[0], 0, 0, 0), C1, 0); \
    KRD(GL, 3); GAPB(o[1] = __builtin_amdgcn_mfma_f32_32x32x16_bf16(PAF(2), VFR(6), o[1], 0, 0, 0), C1, 4); \
    GAPB(o[0] = __builtin_amdgcn_mfma_f32_32x32x16_bf16(PAF(3), VFR(3), o[0], 0, 0, 0), C1, 8); \
    GAPB(o[1] = __builtin_amdgcn_mfma_f32_32x32x16_bf16(PAF(3), VFR(7), o[1], 0, 0, 0), C1, 12); \
    } while (0)
  int t = 1;
  for (; t + 5 < NT; t += 2) {
    STEP(pB0, pB1, pA0, pA1, t, true, true, true);     WAIT_BAR(2); RESC(); ROT();
    STEP(pA0, pA1, pB0, pB1, t + 1, true, true, true); WAIT_BAR(2); RESC(); ROT();
  }
  #define ENDW(tt) do { if ((tt) + 3 < NT) { WAIT_BAR(2); } else if ((tt) + 2 < NT) { WAIT_BAR(1); } else { WAIT_BAR(0); } } while (0)
  for (; t + 1 < NT; t += 2) {
    STEP(pB0, pB1, pA0, pA1, t, (t + 3 < NT), (t + 1 < NT), (t + 1 < NT));         ENDW(t);     RESC(); ROT();
    STEP(pA0, pA1, pB0, pB1, t + 1, (t + 4 < NT), (t + 2 < NT), (t + 2 < NT));     ENDW(t + 1); RESC(); ROT();
  }
  STEP(pB0, pB1, pA0, pA1, NT - 1, false, false, false); RESC();
  { float sacc = pB0[0] + pB0[1]; _Pragma("unroll") for (int r = 2; r < 16; ++r) sacc += pB0[r]; _Pragma("unroll") for (int r = 0; r < 16; ++r) sacc += pB1[r]; l_reg += sacc;
    pw0 = (u32x4){PKW(pB0, 0), PKW(pB0, 2), PKW(pB0, 4), PKW(pB0, 6)}; pw1 = (u32x4){PKW(pB0, 8), PKW(pB0, 10), PKW(pB0, 12), PKW(pB0, 14)}; pw2 = (u32x4){PKW(pB1, 0), PKW(pB1, 2), PKW(pB1, 4), PKW(pB1, 6)}; pw3 = (u32x4){PKW(pB1, 8), PKW(pB1, 10), PKW(pB1, 12), PKW(pB1, 14)};
    SBAR(); pv(o, vb0 + sl_cur, PAF(0), PAF(1), PAF(2), PAF(3)); }
  #undef PKW
  #undef PAF
  #undef VFR
  #undef PIN
  #undef MX3
  #undef GAPA
  #undef GAPB
  #undef EX
  #undef VRD
  #undef KRD
  #undef STEP
  #undef ENDW
  { auto rr = __builtin_amdgcn_permlane32_swap(__float_as_uint(l_reg), __float_as_uint(l_reg), false, false); l_reg = __uint_as_float(rr[0]) + __uint_as_float(rr[1]); }
  if (hi == 0) wsf[32 + r32] = l_reg; asm volatile("s_waitcnt lgkmcnt(0)" ::: "memory");
  float rli[16];
  #pragma unroll
  for (int r = 0; r < 16; ++r) rli[r] = __builtin_amdgcn_rcpf(wsf[32 + crow(r, hi)]);
  bf16h* Ow = O + (rowbase + q0 + wid * QBLK) * QP + h * D;
  { bf16h* stg = (bf16h*)(shm + LDS_OST) + wid * 2048;
    #pragma unroll
    for (int r = 0; r < 16; ++r) { const int orow = crow(r, hi);
      #pragma unroll
      for (int d0 = 0; d0 < 2; ++d0) stg[orow * 64 + d0 * 32 + r32] = __float2bfloat16(o[d0][r] * rli[r]); }
    asm volatile("s_waitcnt lgkmcnt(0)" ::: "memory");
    #pragma unroll
    for (int i = 0; i < 4; ++i) { const int row = i * 8 + (lane >> 3), ch = lane & 7; const u32x4 v = *(const u32x4*)(stg + row * 64 + ch * 8); *(u32x4*)(Ow + (long)row * QP + ch * 8) = v; } }
  asm volatile("s_waitcnt lgkmcnt(0)\n\ts_barrier" ::: "memory");
  #undef DMA_K
  #undef DMA_V
  #undef START
  #undef RESC
  #undef ROT
}
#undef SBAR
#undef WAIT_BAR
}

#define XB_TMO      128
#define XB_XCNT(j)  (256  + 64 * (j))
#define XB_XSUB(j)  (1280 + 64 * (j))
#define XB_XGEN(j)  (2304 + 64 * (j))
#define XB_TOP      3328
#define XB_TOPGEN   3392
#define XCD_BAR_WORDS 3456
#define XB_SPIN_CAP (1u << 18)
__device__ __forceinline__ unsigned xb_ld(unsigned* p)              { return __hip_atomic_load(p, __ATOMIC_RELAXED, __HIP_MEMORY_SCOPE_AGENT); }
__device__ __forceinline__ unsigned xb_add(unsigned* p, unsigned v) { return __hip_atomic_fetch_add(p, v, __ATOMIC_RELAXED, __HIP_MEMORY_SCOPE_AGENT); }
__device__ __forceinline__ unsigned xb_xcc_id() { return (unsigned)__builtin_amdgcn_s_getreg((3 << 11) | 20) & 0xFu; }
#define XB_SPIN(cond, bar) do { unsigned _sp = 0; while (cond) { __builtin_amdgcn_s_sleep(1); \
    if ((++_sp & 255u) == 0u) { if (xb_ld(&(bar)[XB_TMO])) break; if (_sp > XB_SPIN_CAP) { atomicAdd(&(bar)[XB_TMO], 1u); break; } } } } while (0)
struct XcdBarrier { unsigned* bar; unsigned x; volatile LAS unsigned* st; };
__device__ __forceinline__ XcdBarrier xcd_barrier_post(unsigned* bar, volatile LAS unsigned* st) {
    XcdBarrier b; b.bar = bar; b.x = xb_xcc_id(); b.st = st;
    if (threadIdx.x == 0) (void)xb_add(&bar[XB_XCNT(b.x)], 1u);
    return b;
}
__device__ __forceinline__ void xcd_barrier_complete(unsigned* bar, unsigned x, unsigned& nloc, unsigned& nx) {
    const unsigned G = gridDim.x * gridDim.y * gridDim.z;
    unsigned sum, cnt, mine, sp = 0u;
    for (;;) {
        sum = 0u; cnt = 0u; mine = 0u;
#pragma unroll
        for (unsigned j = 0; j < 16; ++j) { const unsigned c = xb_ld(&bar[XB_XCNT(j)]); sum += c; cnt += (c > 0u) ? 1u : 0u; mine = (j == x) ? c : mine; }
        if (sum == G) break;
        __builtin_amdgcn_s_sleep(1);
        if ((++sp & 255u) == 0u) { if (xb_ld(&bar[XB_TMO])) break; if (sp > XB_SPIN_CAP) { atomicAdd(&bar[XB_TMO], 1u); break; } }
    }
    nloc = mine > 0u ? mine : 1u; nx = cnt > 0u ? cnt : 1u;
}
__device__ __forceinline__ void xcd_barrier(const XcdBarrier& b) {
    asm volatile("s_waitcnt vmcnt(0)" ::: "memory");
    __syncthreads();
    if (threadIdx.x == 0) {
        unsigned* bar = b.bar;
        __builtin_amdgcn_s_waitcnt(0);
        unsigned nloc = b.st[0], nx = b.st[1];
        if (nloc == 0u) { xcd_barrier_complete(bar, b.x, nloc, nx); b.st[0] = nloc; b.st[1] = nx; }
        const unsigned old = xb_add(&bar[XB_XSUB(b.x)], 1u);
        const unsigned gen = old / nloc;
        if (old + 1u == (gen + 1u) * nloc) {
            __builtin_amdgcn_fence(__ATOMIC_RELEASE, "agent");
            asm volatile("s_waitcnt vmcnt(0)" ::: "memory");
            const unsigned og = xb_add(&bar[XB_TOP], 1u);
            const unsigned tg = og / nx;
            if (og + 1u == (tg + 1u) * nx) xb_add(&bar[XB_TOPGEN], 1u);
            else XB_SPIN(xb_ld(&bar[XB_TOPGEN]) == tg, bar);
            __builtin_amdgcn_fence(__ATOMIC_ACQUIRE, "agent");
            xb_add(&bar[XB_XGEN(b.x)], 1u);
            asm volatile("s_waitcnt vmcnt(0)" ::: "memory");
        } else {
            XB_SPIN(xb_ld(&bar[XB_XGEN(b.x)]) == gen, bar);
            __builtin_amdgcn_fence(__ATOMIC_ACQUIRE, "agent");
            asm volatile("s_waitcnt vmcnt(0)" ::: "memory");
        }
    }
    __syncthreads();
}

struct cf { float x, y; };
__device__ __forceinline__ cf cmul(cf a, cf b) { return cf{a.x * b.x - a.y * b.y, a.x * b.y + a.y * b.x}; }
#define FIDX(i) ((i) + ((i) >> 4))
constexpr int FFT_LDS_BYTES = (16384 + 1024) * 8;
__device__ __forceinline__ void dft4(cf& a, cf& b, cf& c, cf& d) {
    const cf s0{a.x + c.x, a.y + c.y}, s1{a.x - c.x, a.y - c.y}, s2{b.x + d.x, b.y + d.y}, s3{b.x - d.x, b.y - d.y};
    a = cf{s0.x + s2.x, s0.y + s2.y}; c = cf{s0.x - s2.x, s0.y - s2.y};
    b = cf{s1.x + s3.y, s1.y - s3.x}; d = cf{s1.x - s3.y, s1.y + s3.x};
}
__device__ __forceinline__ void dft16(cf (&x)[16]) {
#pragma unroll
    for (int m2 = 0; m2 < 4; ++m2) dft4(x[m2], x[4 + m2], x[8 + m2], x[12 + m2]);
    const cf W1{0.92387953251f, -0.38268343236f}, W2{0.70710678118f, -0.70710678118f}, W3{0.38268343236f, -0.92387953251f}, W6{-0.70710678118f, -0.70710678118f}, W9{-0.92387953251f, 0.38268343236f};
    x[5] = cmul(x[5], W1); x[6] = cmul(x[6], W2); x[7] = cmul(x[7], W3);
    x[9] = cmul(x[9], W2); x[10] = cf{x[10].y, -x[10].x}; x[11] = cmul(x[11], W6);
    x[13] = cmul(x[13], W3); x[14] = cmul(x[14], W6); x[15] = cmul(x[15], W9);
#pragma unroll
    for (int q1 = 0; q1 < 4; ++q1) dft4(x[4 * q1], x[4 * q1 + 1], x[4 * q1 + 2], x[4 * q1 + 3]);
}
#define QREG(q) (4 * ((q) & 3) + ((q) >> 2))
__device__ __forceinline__ cf twid(int j, int lognb) { const float fr = (float)j * (1.0f / (float)(1 << lognb)); return cf{__builtin_amdgcn_cosf(fr), -__builtin_amdgcn_sinf(fr)}; }
__device__ __forceinline__ void twiddle_fwd(cf (&x)[16], cf w) {
    cf wq = w;
#pragma unroll
    for (int q = 1; q < 16; ++q) { x[QREG(q)] = cmul(x[QREG(q)], wq); if (q < 15) wq = cmul(wq, w); }
}
__device__ __forceinline__ void twiddle_inv(cf (&x)[16], cf w) {
    cf wq = w; x[0].y = -x[0].y;
#pragma unroll
    for (int q = 1; q < 16; ++q) { x[q] = cmul(cf{x[q].x, -x[q].y}, wq); if (q < 15) wq = cmul(wq, w); }
}
template <int LS> __device__ __forceinline__ void fft_fwd16(LAS f32x2* X, int tid) {
    constexpr int S = 1 << LS; asm volatile("" : "+v"(tid));
    _Pragma("unroll 1") for (int k = 0; k < 2; ++k) { const int u = tid + 512 * k, j = u & (S - 1), base = ((u >> LS) << (LS + 4)) + j;
        cf x[16];
#pragma unroll
        for (int m = 0; m < 16; ++m) { const f32x2 v = X[FIDX(base + (m << LS))]; x[m] = cf{v.x, v.y}; }
        dft16(x);
        twiddle_fwd(x, twid(j, LS + 4));
#pragma unroll
        for (int q = 0; q < 16; ++q) X[FIDX(base + (q << LS))] = (f32x2){x[QREG(q)].x, x[QREG(q)].y}; }
}
template <int LS> __device__ __forceinline__ void fft_inv16(LAS f32x2* X, int tid) {
    constexpr int S = 1 << LS; asm volatile("" : "+v"(tid));
    _Pragma("unroll 1") for (int k = 0; k < 2; ++k) { const int u = tid + 512 * k, j = u & (S - 1), base = ((u >> LS) << (LS + 4)) + j;
        cf x[16];
#pragma unroll
        for (int q = 0; q < 16; ++q) { const f32x2 v = X[FIDX(base + (q << LS))]; x[q] = cf{v.x, v.y}; }
        twiddle_inv(x, twid(j, LS + 4));
        dft16(x);
#pragma unroll
        for (int m = 0; m < 16; ++m) X[FIDX(base + (m << LS))] = (f32x2){x[QREG(m)].x, -x[QREG(m)].y}; }
}
__device__ __forceinline__ void fft_mid(LAS f32x2* X, const float* H, int tid) {
    asm volatile("" : "+v"(tid));
    _Pragma("unroll 1") for (int k = 0; k < 8; ++k) { const int u = tid + 512 * k; const int p = 4 * u + (u >> 2);
        const f32x2 v0 = X[p], v1 = X[p + 1], v2 = X[p + 2], v3 = X[p + 3];
        const f32x4 h01 = *(const f32x4*)(H + 8 * u), h23 = *(const f32x4*)(H + 8 * u + 4);
        cf a{v0.x, v0.y}, b{v1.x, v1.y}, c{v2.x, v2.y}, d{v3.x, v3.y};
        dft4(a, b, c, d);
        a = cmul(a, cf{h01[0], h01[1]}); b = cmul(b, cf{h01[2], h01[3]}); c = cmul(c, cf{h23[0], h23[1]}); d = cmul(d, cf{h23[2], h23[3]});
        a.y = -a.y; b.y = -b.y; c.y = -c.y; d.y = -d.y;
        dft4(a, b, c, d);
        X[p] = (f32x2){a.x, -a.y}; X[p + 1] = (f32x2){b.x, -b.y}; X[p + 2] = (f32x2){c.x, -c.y}; X[p + 3] = (f32x2){d.x, -d.y}; }
}
__device__ __forceinline__ void fft_last_store(LAS f32x2* X, float* H, int tid) {
    asm volatile("" : "+v"(tid));
    const float sc = 1.0f / 16384.0f;
    _Pragma("unroll 1") for (int k = 0; k < 8; ++k) { const int u = tid + 512 * k; const int p = 4 * u + (u >> 2);
        const f32x2 v0 = X[p], v1 = X[p + 1], v2 = X[p + 2], v3 = X[p + 3];
        cf a{v0.x, v0.y}, b{v1.x, v1.y}, c{v2.x, v2.y}, d{v3.x, v3.y};
        dft4(a, b, c, d);
        *(f32x4*)(H + 8 * u) = (f32x4){a.x * sc, a.y * sc, b.x * sc, b.y * sc}; *(f32x4*)(H + 8 * u + 4) = (f32x4){c.x * sc, c.y * sc, d.x * sc, d.y * sc}; }
}

__device__ __forceinline__ void block_sum2(float& a, float& b, LAS float* red, int tid) {
    a = wave_sum(a); b = wave_sum(b);
    __syncthreads();
    if ((tid & 63) == 0) { red[(tid >> 6) * 2] = a; red[(tid >> 6) * 2 + 1] = b; }
    __syncthreads();
    float sa = 0.f, sb = 0.f;
#pragma unroll
    for (int w = 0; w < 8; ++w) { sa += red[2 * w]; sb += red[2 * w + 1]; }
    a = sa; b = sb;
}

__device__ __forceinline__ void hfft_item(const float* hraw, float* Hout, int o, int c, LAS unsigned char* lds, int tid) {
    asm volatile("" : "+v"(tid));
    LAS f32x2* X = (LAS f32x2*)lds; LAS float* red = (LAS float*)(lds + FFT_LDS_BYTES);
    const float* hf = hraw + (size_t)((o * 2 + 0) * HYW + c) * SEQ; const float* hb = hraw + (size_t)((o * 2 + 1) * HYW + c) * SEQ;
    const float mind = 4.605170185988091f / 1.5f, maxd = 4.605170185988091f / 0.3f;
    const float ad = mind + (float)c * ((maxd - mind) / 511.0f);
    float vf[16], vb[16]; float sf = 0.f, sb = 0.f;
#pragma unroll
    for (int i = 0; i < 16; ++i) { const int t = tid + 512 * i; const float dec = expf(-((float)t * (1.0f / 8191.0f)) * ad); vf[i] = hf[t] * dec; vb[i] = hb[t] * dec; sf += fabsf(vf[i]); sb += fabsf(vb[i]); }
    block_sum2(sf, sb, red, tid);
    const float nf = 1.0f / (sf + EPSV), nb = 1.0f / (sb + EPSV);
#pragma unroll
    for (int i = 0; i < 16; ++i) { const int t = tid + 512 * i; const float a = vf[i] * nf, b = vb[i] * nb;
        if (t == 0) { X[FIDX(0)] = (f32x2){a + b, 0.f}; X[FIDX(8192)] = (f32x2){0.f, 0.f}; }
        else { X[FIDX(t)] = (f32x2){a, 0.f}; X[FIDX(16384 - t)] = (f32x2){b, 0.f}; } }
    __syncthreads();
    fft_fwd16<10>(X, tid); __syncthreads();
    fft_fwd16<6>(X, tid); __syncthreads();
    fft_fwd16<2>(X, tid); __syncthreads();
    fft_last_store(X, Hout + (size_t)(o * HYW + c) * 32768, tid);
    __syncthreads();
}

__device__ __forceinline__ cf sconv(const bf16* za, const bf16* zb, int t, float w0, float w1, float w2, float bias) {
    const int tm = t > 0 ? t - 1 : 0, tp = t < SEQ - 1 ? t + 1 : SEQ - 1;
    float a0 = bf2f(za[tm]), a1 = bf2f(za[t]), a2 = bf2f(za[tp]);
    float b0 = bf2f(zb[tm]), b1 = bf2f(zb[t]), b2 = bf2f(zb[tp]);
    if (t == 0) { a0 = 0.f; b0 = 0.f; }
    if (t == SEQ - 1) { a2 = 0.f; b2 = 0.f; }
    return cf{bias + w0 * a0 + w1 * a1 + w2 * a2, bias + w0 * b0 + w1 * b1 + w2 * b2};
}
__device__ __forceinline__ void hyena_item(const Args& P, int c, int p, f32x2* y1s, LAS unsigned char* lds, int tid) {
    asm volatile("" : "+v"(tid));
    LAS f32x2* X = (LAS f32x2*)lds;
    const bf16* zhy = (const bf16*)(P.ws + WS_ZHY); const float* Hs = (const float*)P.out; bf16* yhy = (bf16*)(P.ws + WS_YHY);
    const float* sw = P.in[8]; const float* sb = P.in[9]; const float* fbp = P.in[18];
    const float fb0 = fbp[c], fb1 = fbp[HYW + c];
    const int ba = 2 * p, bb = 2 * p + 1;
    const float wv0 = sw[c], wv1 = sw[HYIN + c], wv2 = sw[2 * HYIN + c], bsv = sb[c];
    const bf16* zva = zhy + (size_t)(ba * HYIN + c) * SEQ; const bf16* zvb = zhy + (size_t)(bb * HYIN + c) * SEQ;
#pragma unroll 1
    for (int k = 0; k < 2; ++k) { const int j = tid + 512 * k; cf x[16];
#pragma unroll
        for (int m = 0; m < 8; ++m) { x[m] = sconv(zva, zvb, j + 1024 * m, wv0, wv1, wv2, bsv); x[8 + m] = cf{0.f, 0.f}; }
        dft16(x); twiddle_fwd(x, twid(j, 14));
#pragma unroll
        for (int q = 0; q < 16; ++q) X[FIDX(j + 1024 * q)] = (f32x2){x[QREG(q)].x, x[QREG(q)].y}; }
    __syncthreads();
    fft_fwd16<6>(X, tid); __syncthreads();
    fft_fwd16<2>(X, tid); __syncthreads();
    fft_mid(X, Hs + (size_t)(0 * HYW + c) * 32768, tid); __syncthreads();
    fft_inv16<2>(X, tid); __syncthreads();
    fft_inv16<6>(X, tid); __syncthreads();
    { const float w0 = sw[HYW + c], w1 = sw[HYIN + HYW + c], w2 = sw[2 * HYIN + HYW + c], bs = sb[HYW + c];
      const bf16* za = zhy + (size_t)(ba * HYIN + HYW + c) * SEQ; const bf16* zb = zhy + (size_t)(bb * HYIN + HYW + c) * SEQ;
      asm volatile("" : "+v"(tid));
#pragma unroll 1
      for (int k = 0; k < 2; ++k) { const int j = tid + 512 * k; cf x[16];
#pragma unroll
        for (int q = 0; q < 16; ++q) { const f32x2 v = X[FIDX(j + 1024 * q)]; x[q] = cf{v.x, v.y}; }
        twiddle_inv(x, twid(j, 14)); dft16(x);
        cf y1[8];
#pragma unroll
        for (int m = 0; m < 8; ++m) { const int t = j + 1024 * m; const cf r{x[QREG(m)].x, -x[QREG(m)].y}; const cf g = sconv(za, zb, t, w0, w1, w2, bs); const cf vc = sconv(zva, zvb, t, wv0, wv1, wv2, bsv);
            y1[m] = cf{g.x * (r.x + fb0 * vc.x), g.y * (r.y + fb0 * vc.y)}; y1s[t] = (f32x2){y1[m].x, y1[m].y}; }
#pragma unroll
        for (int m = 0; m < 8; ++m) { x[m] = y1[m]; x[8 + m] = cf{0.f, 0.f}; }
        dft16(x); twiddle_fwd(x, twid(j, 14));
#pragma unroll
        for (int q = 0; q < 16; ++q) X[FIDX(j + 1024 * q)] = (f32x2){x[QREG(q)].x, x[QREG(q)].y}; } }
    __syncthreads();
    fft_fwd16<6>(X, tid); __syncthreads();
    fft_fwd16<2>(X, tid); __syncthreads();
    fft_mid(X, Hs + (size_t)(1 * HYW + c) * 32768, tid); __syncthreads();
    fft_inv16<2>(X, tid); __syncthreads();
    fft_inv16<6>(X, tid); __syncthreads();
    { const float w0 = sw[2 * HYW + c], w1 = sw[HYIN + 2 * HYW + c], w2 = sw[2 * HYIN + 2 * HYW + c], bs = sb[2 * HYW + c];
      const bf16* za = zhy + (size_t)(ba * HYIN + 2 * HYW + c) * SEQ; const bf16* zb = zhy + (size_t)(bb * HYIN + 2 * HYW + c) * SEQ;
      asm volatile("" : "+v"(tid));
#pragma unroll 1
      for (int k = 0; k < 2; ++k) { const int j = tid + 512 * k; cf x[16];
#pragma unroll
        for (int q = 0; q < 16; ++q) { const f32x2 v = X[FIDX(j + 1024 * q)]; x[q] = cf{v.x, v.y}; }
        twiddle_inv(x, twid(j, 14)); dft16(x);
#pragma unroll
        for (int m = 0; m < 8; ++m) { const int t = j + 1024 * m; const cf r{x[QREG(m)].x, -x[QREG(m)].y}; const cf g = sconv(za, zb, t, w0, w1, w2, bs); const f32x2 yy = y1s[t];
            yhy[((size_t)ba * SEQ + t) * HYW + c] = (bf16)f2bf(g.x * (r.x + fb1 * yy.x));
            yhy[((size_t)bb * SEQ + t) * HYW + c] = (bf16)f2bf(g.y * (r.y + fb1 * yy.y)); } } }
    __syncthreads();
}

template <class MapT>
__device__ __forceinline__ void transpose_item(const float* W, int K, int N, bf16* WT, const MapT& map, LAS float* scr, int item, int lane) {
    const int nblk = N / 32, kb = item / nblk, nb = item % nblk, k0 = 64 * kb, n0 = 32 * nb;
#pragma unroll 8
    for (int i = 0; i < 32; ++i) { const int kk = 2 * i + (lane >> 5); scr[kk * 33 + (lane & 31)] = W[(size_t)(k0 + kk) * N + n0 + (lane & 31)]; }
    LDS_WAIT(); asm volatile("" ::: "memory");
    const int c = lane & 7;
#pragma unroll
    for (int j = 0; j < 4; ++j) { const int n = (lane >> 3) + 8 * j; const LAS float* s = scr + (8 * c) * 33 + n;
        v4u o; o.x = pk2(s[0 * 33], s[1 * 33]); o.y = pk2(s[2 * 33], s[3 * 33]); o.z = pk2(s[4 * 33], s[5 * 33]); o.w = pk2(s[6 * 33], s[7 * 33]);
        *(v4u*)(WT + (size_t)map(n0 + n) * K + k0 + 8 * c) = o; }
    LDS_WAIT(); asm volatile("" ::: "memory");
}
struct MapWin { __device__ __forceinline__ int operator()(int n) const {
    if (n < 1536) return n;
    if (n < 2304) { const int t0 = 1536 + ((n - 1536) & ~255), cc = (n - 1536) & 255, hp = cc >> 6, d = cc & 63; return t0 + 128 * (d >> 5) + 32 * hp + (d & 31); }
    return (n & ~31) | pinv32(n & 31); } };
struct MapPerm { int off; __device__ __forceinline__ int operator()(int n) const { return off + ((n & ~31) | pinv32(n & 31)); } };
struct MapNat { __device__ __forceinline__ int operator()(int n) const { return n; } };
struct MapGU { int off; __device__ __forceinline__ int operator()(int f) const { return off + (f >> 7) * 256 + (((f & 127) & ~31) | pinv32(f & 31)); } };

__device__ __forceinline__ void phase_mod(const Args& P, LAS unsigned char* lds, int G) {
    LAS float* sc = (LAS float*)lds; LAS float* red = sc + 4096;
    const int tid = threadIdx.x;
    const float* c = P.in[1]; const float* w_ada = P.in[2]; const float* b_ada = P.in[3];
    for (int i = tid; i < 4096; i += 512) { const float v = c[i]; sc[i] = v / (1.0f + expf(-v)); }
    __syncthreads();
    float* mod = (float*)(P.ws + WS_MOD);
    for (int cb = blockIdx.x; cb < 256; cb += G) {
        const int col0 = cb * 24, ks = tid / 24, col = tid % 24;
        float a0 = 0.f, a1 = 0.f, a2 = 0.f, a3 = 0.f;
        if (tid < 504) { for (int k = ks; k < 1024; k += 21) { const float w = w_ada[(size_t)k * 6144 + col0 + col]; a0 += sc[k] * w; a1 += sc[1024 + k] * w; a2 += sc[2048 + k] * w; a3 += sc[3072 + k] * w; }
            red[(ks * 24 + col) * 4 + 0] = a0; red[(ks * 24 + col) * 4 + 1] = a1; red[(ks * 24 + col) * 4 + 2] = a2; red[(ks * 24 + col) * 4 + 3] = a3; }
        __syncthreads();
        if (tid < 96) { const int b = tid / 24, cc = tid % 24; float s = 0.f; for (int q = 0; q < 21; ++q) s += red[(q * 24 + cc) * 4 + b]; mod[b * 6144 + col0 + cc] = s + b_ada[col0 + cc]; }
        __syncthreads();
    }
}

__device__ __forceinline__ void hraw_item(const Args& P, int item, LAS unsigned char* lds, int tid) {
    LAS float* ha = (LAS float*)lds;
    LAS float* hb = ha + 64 * 65;
    const int tb = item >> 1, half = item & 1, t0 = tb * 64;
    const float* w1 = P.in[10]; const float* b1 = P.in[11]; const float* w2 = P.in[12]; const float* b2 = P.in[13]; const float* w3 = P.in[14]; const float* b3 = P.in[15]; const float* w4 = P.in[16]; const float* fq = P.in[17];
    const int r = tid >> 3, js = tid & 7;
    {
        const int t = t0 + r;
        if (js == 0) hb[r * 65] = (float)t * (1.0f / 8191.0f);
        const float wv = 6.283185307179586f * (float)t * (1.0f / 8192.0f);
#pragma unroll
        for (int q = 0; q < 2; ++q) { const int kk = js * 2 + q; const float f = 1e-4f + (float)kk * ((15.0f - 1e-4f) / 15.0f); const float a = f * wv; hb[r * 65 + 1 + kk] = cosf(a); hb[r * 65 + 17 + kk] = -sinf(a); }
    }
    __syncthreads();
#define MLP_LAYER(SRC, DST, W, BI, FO, NIN) do { float s_[8]; \
        _Pragma("unroll") for (int q = 0; q < 8; ++q) s_[q] = (BI)[js * 8 + q]; \
        _Pragma("unroll 2") for (int i = 0; i < (NIN); ++i) { const float hv = (SRC)[r * 65 + i]; const f32x4 wa = *(const f32x4*)((W) + i * 64 + js * 8), wb = *(const f32x4*)((W) + i * 64 + js * 8 + 4); \
            s_[0] += hv * wa.x; s_[1] += hv * wa.y; s_[2] += hv * wa.z; s_[3] += hv * wa.w; s_[4] += hv * wb.x; s_[5] += hv * wb.y; s_[6] += hv * wb.z; s_[7] += hv * wb.w; } \
        _Pragma("unroll") for (int q = 0; q < 8; ++q) (DST)[r * 65 + js * 8 + q] = sinf((FO)[js * 8 + q] * s_[q]); } while (0)
    MLP_LAYER(hb, ha, w1, b1, fq, 33);
    __syncthreads();
    MLP_LAYER(ha, hb, w2, b2, fq + 64, 64);
    __syncthreads();
    MLP_LAYER(hb, ha, w3, b3, fq + 128, 64);
    __syncthreads();
#undef MLP_LAYER
    float* hraw = (float*)(P.ws + WS_HRAW);
    for (int q = 0; q < 2; ++q) { const int idx = half * 1024 + q * 512 + tid;
        for (int tg = 0; tg < 4; ++tg) { float acc[16];
#pragma unroll
            for (int i = 0; i < 16; ++i) acc[i] = 0.f;
#pragma unroll 2
            for (int j = 0; j < 64; ++j) { const float w = w4[j * 2048 + idx];
#pragma unroll
                for (int i = 0; i < 16; ++i) acc[i] += ha[(tg * 16 + i) * 65 + j] * w; }
            float* o = hraw + (size_t)idx * SEQ + t0 + tg * 16;
#pragma unroll
            for (int i = 0; i < 16; i += 4) *(f32x4*)(o + i) = (f32x4){acc[i], acc[i + 1], acc[i + 2], acc[i + 3]}; } }
    __syncthreads();
}

__device__ __forceinline__ void phase_prep(const Args& P, LAS unsigned char* lds, int vcu, int G) {
    const int tid = threadIdx.x, lane = tid & 63, wave = __builtin_amdgcn_readfirstlane(tid >> 6);
    const int gw = vcu * NWAVES + wave, NGW = G * NWAVES;
    for (int it = vcu; it < 256; it += G) hraw_item(P, it, lds, tid);
    LAS float* scr = (LAS float*)(lds + wave * 16384);
    constexpr int I_IN = 16 * 136, I_HY = 8 * 32, I_AT = 8 * 32, I_O = 16 * 32;
    for (int it = gw; it < I_IN + I_HY + I_AT + I_O; it += NGW) {
        int r = it;
        if (r < I_IN) { transpose_item(P.in[6], DM, INW, (bf16*)(P.ws + WS_WIN), MapWin{}, scr, r, lane); continue; } r -= I_IN;
        if (r < I_HY) { transpose_item(P.in[21], HYW, DM, (bf16*)(P.ws + WS_WHY), MapPerm{0}, scr, r, lane); continue; } r -= I_HY;
        if (r < I_AT) { transpose_item(P.in[22], ATTW, DM, (bf16*)(P.ws + WS_WAT), MapPerm{0}, scr, r, lane); continue; } r -= I_AT;
        transpose_item(P.in[23], DM, DM, (bf16*)(P.ws + WS_WO), MapNat{}, scr, r, lane);
    }
    if (vcu == 0) { float* cs = (float*)(P.ws + WS_ROPE);
        for (int i = tid; i < 128 * 16; i += 512) { const int pos = i >> 4, k = i & 15; const float inv = powf(10000.0f, -(float)k * (1.0f / 16.0f)); const float a = (float)pos * inv; cs[pos * 32 + k] = cosf(a); cs[pos * 32 + 16 + k] = sinf(a); } }
    if (vcu == (G > 1 ? 1 : 0)) { float* bp = (float*)(P.ws + WS_BPERM); const float* b_in = P.in[7]; MapWin mw; for (int n = tid; n < INW; n += 512) bp[mw(n)] = b_in[n]; }
    const float* x = P.in[0]; const float* gmix = P.in[4]; const float* mod = (const float*)(P.ws + WS_MOD); bf16* hn = (bf16*)(P.ws + WS_HN);
    for (int m = gw; m < MTOK; m += NGW) { const int b = m >> 13;
        const f32x4* xr = (const f32x4*)(x + (size_t)m * DM) + lane; f32x4 v[4]; float s = 0.f;
#pragma unroll
        for (int j = 0; j < 4; ++j) { v[j] = xr[64 * j]; s += (v[j].x * v[j].x + v[j].y * v[j].y) + (v[j].z * v[j].z + v[j].w * v[j].w); }
        const float rstd = 1.0f / sqrtf(wave_sum(s) * (1.0f / DM) + EPSV);
        v2u* o8 = (v2u*)(hn + (size_t)m * DM) + lane;
#pragma unroll
        for (int j = 0; j < 4; ++j) { const int col = 4 * lane + 256 * j; const f32x4 g = *(const f32x4*)(gmix + col), sc = *(const f32x4*)(mod + b * 6144 + 1024 + col), sh = *(const f32x4*)(mod + b * 6144 + col);
            const f32x4 h = v[j] * rstd * g * (sc + 1.0f) + sh; v2u w; w.x = pk2(h.x, h.y); w.y = pk2(h.z, h.w); o8[64 * j] = w; } }
}

__device__ __forceinline__ void phase_norm2(const Args& P, LAS unsigned char* lds, int vcu, int G) {
    const int tid = threadIdx.x, lane = tid & 63, wave = __builtin_amdgcn_readfirstlane(tid >> 6);
    const int gw = vcu * NWAVES + wave, NGW = G * NWAVES;
    { LAS float* scr = (LAS float*)(lds + wave * 16384);
      constexpr int I_G = 16 * 64, I_D = 32 * 32;
      constexpr int PER_E = 2 * I_G + I_D;
      for (int it = gw; it < NEXP * PER_E; it += NGW) { const int e = it / PER_E; int r = it % PER_E;
          if (r < I_G) { transpose_item(P.in[25] + (size_t)e * DM * DFF, DM, DFF, (bf16*)(P.ws + WS_WGU), MapGU{e * 4096}, scr, r, lane); continue; } r -= I_G;
          if (r < I_G) { transpose_item(P.in[26] + (size_t)e * DM * DFF, DM, DFF, (bf16*)(P.ws + WS_WGU), MapGU{e * 4096 + 128}, scr, r, lane); continue; } r -= I_G;
          transpose_item(P.in[27] + (size_t)e * DFF * DM, DFF, DM, (bf16*)(P.ws + WS_WD), MapPerm{e * 1024}, scr, r, lane); } }
    __syncthreads();
    LAS float* wrt = (LAS float*)lds;
    const float* w_router = P.in[24];
    for (int i = tid; i < DM * NEXP; i += 512) { const int k = i >> 4, e = i & 15; wrt[e * DM + k] = w_router[i]; }
    __syncthreads();
    const float* x1 = P.out; const float* gffn = P.in[5]; const float* mod = (const float*)(P.ws + WS_MOD); const float* rowsq = (const float*)(P.ws + WS_ROWSQ);
    bf16* h2 = (bf16*)(P.ws + WS_H2); float* aff = (float*)(P.ws + WS_AFF);
    for (int m = gw; m < MTOK; m += NGW) { const int b = m >> 13, t = m & (SEQ - 1);
        const f32x4* xr = (const f32x4*)(x1 + (size_t)m * DM) + lane; f32x4 v[4];
#pragma unroll
        for (int j = 0; j < 4; ++j) v[j] = xr[64 * j];
        float s = lane < 16 ? rowsq[(size_t)m * 16 + lane] : 0.f; s = wave_sum(s);
        const float rstd = 1.0f / sqrtf(s * (1.0f / DM) + EPSV);
        v2u* o8 = (v2u*)(h2 + (size_t)m * DM) + lane;
#pragma unroll
        for (int j = 0; j < 4; ++j) { const int col = 4 * lane + 256 * j; const f32x4 g = *(const f32x4*)(gffn + col), sc = *(const f32x4*)(mod + b * 6144 + 4096 + col), sh = *(const f32x4*)(mod + b * 6144 + 3072 + col);
            v[j] = v[j] * rstd * g * (sc + 1.0f) + sh; v2u w; w.x = pk2(v[j].x, v[j].y); w.y = pk2(v[j].z, v[j].w); o8[64 * j] = w; }
        float mylg = 0.f;
#pragma unroll 1
        for (int e = 0; e < 16; ++e) { float a = 0.f;
#pragma unroll
            for (int j = 0; j < 4; ++j) { const f32x4 w = *(const LAS f32x4*)(wrt + e * DM + 4 * lane + 256 * j); a += (v[j].x * w.x + v[j].y * w.y) + (v[j].z * w.z + v[j].w * w.w); }
            a = wave_sum(a); if (lane == e) mylg = a; }
        float mx = mylg;
#pragma unroll
        for (int o = 1; o < 16; o <<= 1) mx = fmaxf(mx, __shfl_xor(mx, o));
        const float mine = expf(mylg - mx); float den = mine;
#pragma unroll
        for (int o = 1; o < 16; o <<= 1) den += __shfl_xor(den, o);
        if (lane < 16) aff[((size_t)(b * NEXP + lane)) * SEQ + t] = mine / den; }
}

__device__ __forceinline__ void topk_item(const Args& P, int be, LAS unsigned char* lds, int tid) {
    LAS float* vals = (LAS float*)lds; LAS unsigned* hist = (LAS unsigned*)(lds + 32768); LAS unsigned* sel = hist + 256; LAS unsigned* scan = hist + 512;
    const float* aff = (const float*)(P.ws + WS_AFF) + (size_t)be * SEQ;
    for (int i = tid; i < SEQ; i += 512) vals[i] = aff[i];
    unsigned prefix = 0u, mask = 0u; unsigned need = CAP;
    for (int pass = 0; pass < 4; ++pass) { const int shift = 24 - 8 * pass;
        if (tid < 256) hist[tid] = 0u;
        __syncthreads();
        for (int i = tid; i < SEQ; i += 512) { const unsigned bits = __float_as_uint(vals[i]); if ((bits & mask) == prefix) __hip_atomic_fetch_add(&hist[(bits >> shift) & 255u], 1u, __ATOMIC_RELAXED, __HIP_MEMORY_SCOPE_WORKGROUP); }
        __syncthreads();
        if (tid < 256) { unsigned s = 0u; for (int k2 = tid + 1; k2 < 256; ++k2) s += hist[k2]; const unsigned h = hist[tid]; if (s < need && need <= s + h) { sel[0] = (unsigned)tid; sel[1] = need - s; } }
        __syncthreads();
        prefix |= sel[0] << shift; mask |= 0xFFu << shift; need = sel[1];
        __syncthreads();
    }
    unsigned cg = 0u, ce = 0u; float v[16];
#pragma unroll
    for (int i = 0; i < 16; ++i) { v[i] = vals[16 * tid + i]; const unsigned bits = __float_as_uint(v[i]); cg += bits > prefix ? 1u : 0u; ce += bits == prefix ? 1u : 0u; }
    scan[tid] = cg; scan[512 + tid] = ce;
    __syncthreads();
    for (int off = 1; off < 512; off <<= 1) { unsigned a = 0u, b = 0u; if (tid >= off) { a = scan[tid - off]; b = scan[512 + tid - off]; } __syncthreads(); scan[tid] += a; scan[512 + tid] += b; __syncthreads(); }
    unsigned pg = scan[tid] - cg, pe = scan[512 + tid] - ce;
    int* slot_of = (int*)(P.ws + WS_SLOT) + (size_t)be * SEQ; int* topi = (int*)(P.ws + WS_TOPI) + be * CAP; float* topw = (float*)(P.ws + WS_TOPW) + be * CAP;
#pragma unroll
    for (int i = 0; i < 16; ++i) { const unsigned bits = __float_as_uint(v[i]); int slot = -1;
        if (bits > prefix) { slot = (int)(pg + (pe < need ? pe : need)); ++pg; }
        else if (bits == prefix) { if (pe < need) slot = (int)(pg + pe); ++pe; }
        slot_of[16 * tid + i] = slot;
        if (slot >= 0) { topi[slot] = 16 * tid + i; topw[slot] = v[i]; } }
    __syncthreads();
}

__device__ __forceinline__ void phase_combine(const Args& P, int vcu, int G) {
    const int tid = threadIdx.x, lane = tid & 63, wave = __builtin_amdgcn_readfirstlane(tid >> 6);
    const int gw = vcu * NWAVES + wave, NGW = G * NWAVES;
    float* out = P.out; const float* mod = (const float*)(P.ws + WS_MOD); const int* slot_of = (const int*)(P.ws + WS_SLOT); const bf16* ye = (const bf16*)(P.ws + WS_YE);
    for (int m = gw; m < MTOK; m += NGW) { const int b = m >> 13, t = m & (SEQ - 1);
        f32x4* xr = (f32x4*)(out + (size_t)m * DM) + lane; f32x4 v[4], a[4];
#pragma unroll
        for (int j = 0; j < 4; ++j) { v[j] = xr[64 * j]; a[j] = (f32x4){0.f, 0.f, 0.f, 0.f}; }
        const int myslot = lane < 16 ? slot_of[((size_t)(b * NEXP + lane)) * SEQ + t] : -1;
        for (int e = 0; e < 16; ++e) { const int sl = __builtin_amdgcn_readlane(myslot, e);
            if (sl >= 0) { const v2u* yr = (const v2u*)(ye + ((size_t)(b * NEXP + e) * CAP + sl) * DM) + lane;
#pragma unroll
                for (int j = 0; j < 4; ++j) { const v2u w = yr[64 * j]; a[j].x += bflo(w.x); a[j].y += bfhi(w.x); a[j].z += bflo(w.y); a[j].w += bfhi(w.y); } } }
#pragma unroll
        for (int j = 0; j < 4; ++j) { const f32x4 gt = *(const f32x4*)(mod + b * 6144 + 5120 + 4 * lane + 256 * j); xr[64 * j] = v[j] + gt * a[j]; } }
}

__global__ void __launch_bounds__(NWAVES * 64, 2) mk_fwd(Args P) {
    extern __shared__ __attribute__((aligned(16))) unsigned char lds_raw[];
    LAS unsigned char* lds = (LAS unsigned char*)lds_raw;
    volatile LAS unsigned* MISC = (volatile LAS unsigned*)(lds + MISC_OFF);
    const int tid = threadIdx.x;
    const int G = gridDim.x; const int bx = blockIdx.x; const int vcu = (G % 8 == 0) ? (bx % 8) * (G / 8) + bx / 8 : bx;
    for (int u = tid; u < (LDS_BYTES - LDSCTL_OFF) / 4; u += NWAVES * 64) ((LAS unsigned*)(lds + LDSCTL_OFF))[u] = 0u;
    __syncthreads();
    gu32* ctl = (gu32*)(P.ws + WS_CTL);
    XcdBarrier bar; bar.bar = (unsigned*)(ctl + CW_BAR) + P.li * XCD_BAR_WORDS; bar.x = 0; bar.st = nullptr;
    if (MK_N_LAUNCHES != N_PHASES) bar = xcd_barrier_post((unsigned*)(ctl + CW_BAR) + P.li * XCD_BAR_WORDS, MISC + 8);
    const int lo = P.ph_lo, hi = P.ph_hi;
#ifndef PHASE_MASK
#define PHASE_MASK 0x7ff
#endif
#define IN(k) ((((PHASE_MASK) >> (k)) & 1) && lo <= (k) && (k) < hi)
#define SEAM(k) do { if (IN(k) && IN((k) + 1)) xcd_barrier(bar); } while (0)

    if (IN(0)) { phase_mod(P, lds, G); SEAM(0); }
    if (IN(1)) { phase_prep(P, lds, vcu, G); SEAM(1); }
    if (IN(2)) {
        pg8::StaticOrder S; S.init(P.ws + WS_HN, P.ws + WS_WIN, MTOK, INW, DM, DM, G, bx);
        EpiIn E{(bf16*)(P.ws + WS_ZHY), (bf16*)(P.ws + WS_Q), (bf16*)(P.ws + WS_K), (bf16*)(P.ws + WS_V), (bf16*)(P.ws + WS_GATE), (const float*)(P.ws + WS_BPERM), P.in[19], P.in[20], (const float*)(P.ws + WS_ROPE)};
#ifndef SKIP_GEMM2
        pg8::gemm_phase(lds, DM, S, E);
#endif
#ifndef SKIP_HFFT
        for (int it = vcu; it < 2 * HYW; it += G) hfft_item((const float*)(P.ws + WS_HRAW), P.out, it >> 9, it & 511, lds, tid);
#endif
        SEAM(2);
    }
    if (IN(3)) {
#ifndef SKIP_ATTN
        { const int grp = vcu >> 5, j = vcu & 31;
          if (G == 256) { for (int i = 0; i < 4; ++i) attn_body::attn_unit<8>(grp >> 1, (grp & 1) * 4 + i, j, (const attn_body::bf16h*)(P.ws + WS_Q), (const attn_body::bf16h*)(P.ws + WS_K), (const attn_body::bf16h*)(P.ws + WS_V), (attn_body::bf16h*)(P.ws + WS_Q), (char*)lds_raw); }
          else { for (int uu = vcu; uu < 1024; uu += G) { const int g2 = uu >> 7, r = uu & 127; attn_body::attn_unit<8>(g2 >> 1, (g2 & 1) * 4 + (r >> 5), r & 31, (const attn_body::bf16h*)(P.ws + WS_Q), (const attn_body::bf16h*)(P.ws + WS_K), (const attn_body::bf16h*)(P.ws + WS_V), (attn_body::bf16h*)(P.ws + WS_Q), (char*)lds_raw); } } }
#endif
        __syncthreads();
#ifndef SKIP_HYENA
        {
          for (int it = vcu; it < 1024; it += G) { const int x = (it >> 5) & 7, k = it >> 8, j = it & 31; const int id = 4 * x + k; hyena_item(P, 32 * (id >> 1) + j, id & 1, (f32x2*)(P.ws + WS_Y1S) + (size_t)bx * SEQ, lds, tid); } }
#endif
        SEAM(3);
    }
    if (IN(4)) {
        { pg8::StaticOrder S; S.init(P.ws + WS_YHY, P.ws + WS_WHY, MTOK, DM, HYW, HYW, G, bx);
          EpiMerge<0> E{(bf16*)(P.ws + WS_M), (const bf16*)(P.ws + WS_GATE), 0}; pg8::gemm_phase(lds, HYW, S, E); }
        { pg8::StaticOrder S; S.init(P.ws + WS_Q, P.ws + WS_WAT, MTOK, DM, ATTW, ATTW, G, bx);
          EpiMerge<1> E{(bf16*)(P.ws + WS_M), (const bf16*)(P.ws + WS_GATE), 1024}; pg8::gemm_phase(lds, ATTW, S, E); }
        SEAM(4);
    }
    if (IN(5)) {
        pg8::StaticOrder S; S.init(P.ws + WS_M, P.ws + WS_WO, MTOK, DM, DM, DM, G, bx);
        EpiOut E{P.in[0], P.out, (const float*)(P.ws + WS_MOD), (float*)(P.ws + WS_ROWSQ)}; pg8::gemm_phase(lds, DM, S, E);
        SEAM(5);
    }
    if (IN(6)) { phase_norm2(P, lds, vcu, G); SEAM(6); }
    if (IN(7)) { for (int be = vcu; be < BATCH * NEXP; be += G) topk_item(P, be, lds, tid); SEAM(7); }
    if (IN(8)) {
        LAS int* idx = (LAS int*)(lds + pg8::STAGE_BYTES);
        MoeUpOrder S{G, bx, (const char*)(P.ws + WS_H2), (const char*)(P.ws + WS_WGU), idx};
        { const int* topi = (const int*)(P.ws + WS_TOPI);
          for (int i = 0; i < 16; ++i) { int e, b, mblk, pn; if (!S.decode((long)i * G + bx, e, b, mblk, pn)) break;
              if (tid < 256) idx[i * 256 + tid] = topi[(b * NEXP + e) * CAP + mblk * 256 + tid]; } }
        __syncthreads();
        EpiSwiglu E{(bf16*)(P.ws + WS_ACT)}; pg8::gemm_phase(lds, DM, S, E);
        SEAM(8);
    }
    if (IN(9)) {
        MoeDownOrder S{G, bx, (const char*)(P.ws + WS_ACT), (const char*)(P.ws + WS_WD)};
        EpiDown E{(bf16*)(P.ws + WS_YE), (const float*)(P.ws + WS_TOPW)}; pg8::gemm_phase(lds, DFF, S, E);
        SEAM(9);
    }
    if (IN(10)) { phase_combine(P, vcu, G); }
#undef IN
#undef SEAM
}

extern "C" void kernel_launch(void* const* d_in, const int* in_sizes, int n_in, void* d_out, int out_size, void* d_ws, size_t ws_size, hipStream_t stream) {
    static int grid = 0;
    if (grid == 0) {
        if (n_in != 28 || in_sizes[0] != MTOK * DM || out_size != MTOK * DM || ws_size < WS_END) { fprintf(stderr, "kernel_launch: unexpected shapes (n_in %d, in0 %d, out %d, ws %zu)\n", n_in, n_in > 0 ? in_sizes[0] : -1, out_size, ws_size); grid = -1; return; }
        int dev = 0, cus = 0;
        if (hipGetDevice(&dev) != hipSuccess || hipDeviceGetAttribute(&cus, hipDeviceAttributeMultiprocessorCount, dev) != hipSuccess) { grid = -1; return; }
        if (hipFuncSetAttribute((const void*)mk_fwd, hipFuncAttributeMaxDynamicSharedMemorySize, LDS_BYTES) != hipSuccess) { fprintf(stderr, "kernel_launch: hipFuncSetAttribute failed\n"); grid = -1; return; }
        (void)hipGetLastError();
        grid = cus;
    }
    if (grid < 0) return;
    if (hipMemsetAsync((char*)d_ws + WS_CTL, 0, CTL_ZERO_BYTES, stream) != hipSuccess) return;
    Args a{};
    for (int i = 0; i < 28; ++i) a.in[i] = (const float*)d_in[i];
    a.out = (float*)d_out; a.ws = (unsigned char*)d_ws;
    for (int li = 0; li < MK_N_LAUNCHES; ++li) {
        if (MK_N_LAUNCHES == 1) { a.ph_lo = 0; a.ph_hi = N_PHASES; }
        else { a.ph_lo = li * N_PHASES / MK_N_LAUNCHES; a.ph_hi = (li + 1) * N_PHASES / MK_N_LAUNCHES; }
        a.li = (MK_N_LAUNCHES == N_PHASES) ? 0 : li;
        hipLaunchKernelGGL(mk_fwd, dim3(grid), dim3(NWAVES * 64), LDS_BYTES, stream, a);
    }
}
```

```cpp
#include <hip/hip_runtime.h>
#include <hip/hip_bf16.h>
#include <cstdio>
#include <cstdint>
#include <cmath>

#ifndef PROBE_CATS
#define PROBE_CATS 0x1ff
#endif
#ifndef MK_N_LAUNCHES
#define MK_N_LAUNCHES 1
#define P7_TOPK_TILES 0
#define P6_TILES 2048
#endif
constexpr int N_PHASES = 11;
constexpr int NWAVES = 8;

constexpr int DM = 1024, BATCH = 4, SEQ = 8192, MTOK = BATCH * SEQ;
constexpr int HYW = 512, HYIN = 1536, ATTW = 512, KVW = 128, INW = 4352, NHEAD = 8, NKV = 2, HD = 64;
constexpr int NEXP = 16, CAP = 1024, DFF = 2048;
constexpr float EPSV = 1e-6f;

constexpr size_t MiB = 1u << 20;
constexpr size_t WS_CTL = 0, CTL_ZERO_BYTES = 1 * MiB;
constexpr size_t WS_MOD = 1 * MiB;
constexpr size_t WS_ROPE = 1 * MiB + 128 * 1024;
constexpr size_t WS_BPERM = 1 * MiB + 256 * 1024;
constexpr size_t WS_ROWSQ = 2 * MiB;
constexpr size_t WS_AFF = 4 * MiB;
constexpr size_t WS_SLOT = 6 * MiB;
constexpr size_t WS_TOPI = 8 * MiB;
constexpr size_t WS_TOPW = 8 * MiB + 256 * 1024;
constexpr size_t WS_WIN = 10 * MiB;
constexpr size_t WS_WHY = 19 * MiB;
constexpr size_t WS_WAT = 20 * MiB;
constexpr size_t WS_WO = 21 * MiB;
constexpr size_t WS_HN = 24 * MiB;
constexpr size_t WS_YAT = 24 * MiB;
constexpr size_t WS_HRAW = 88 * MiB;
constexpr size_t WS_ZC = 56 * MiB;
constexpr size_t WS_ZHY = 152 * MiB;
constexpr size_t WS_Q = 248 * MiB;
constexpr size_t WS_K = 280 * MiB;
constexpr size_t WS_V = 288 * MiB;
constexpr size_t WS_GATE = 296 * MiB;
constexpr size_t WS_YHY = 424 * MiB;
constexpr size_t WS_M = 456 * MiB;
constexpr size_t WS_Y1S = 520 * MiB;
constexpr size_t WS_WGU = 10 * MiB;
constexpr size_t WS_WD = 74 * MiB;
constexpr size_t WS_H2 = 106 * MiB;
constexpr size_t WS_ACT = 138 * MiB;
constexpr size_t WS_YE = 266 * MiB;
constexpr size_t WS_PROBE = 536 * MiB;
constexpr size_t WS_END = 540 * MiB;
constexpr int CW_BAR = 4096;

constexpr int LDS_SCRATCH = 147456;
constexpr int LDSCTL_OFF = LDS_SCRATCH, MISC_OFF = LDSCTL_OFF + 320;
constexpr int LDS_BYTES = 151552;

#define GAS __attribute__((address_space(1)))
#define LAS __attribute__((address_space(3)))
typedef unsigned short bf16;
typedef unsigned v4u __attribute__((ext_vector_type(4)));
typedef unsigned v2u __attribute__((ext_vector_type(2)));
typedef float f32x4 __attribute__((ext_vector_type(4)));
typedef float f32x2 __attribute__((ext_vector_type(2)));
typedef short bf16x8 __attribute__((ext_vector_type(8)));
typedef GAS unsigned gu32;
#define RLX_AGENT __ATOMIC_RELAXED, __HIP_MEMORY_SCOPE_AGENT
#define LDS_WAIT() asm volatile("s_waitcnt lgkmcnt(0)" ::: "memory")
#define VM_WAIT() asm volatile("s_waitcnt vmcnt(0)" ::: "memory")

__device__ __forceinline__ unsigned f2bf(float f) { unsigned u = __builtin_bit_cast(unsigned, f); return (u + 0x7fffu + ((u >> 16) & 1u)) >> 16; }
__device__ __forceinline__ unsigned pk2(float lo, float hi) { return f2bf(lo) | (f2bf(hi) << 16); }
__device__ __forceinline__ unsigned pk4_fp8(float a, float b, float c, float d) { int r = 0; r = __builtin_amdgcn_cvt_pk_fp8_f32(a, b, r, false); r = __builtin_amdgcn_cvt_pk_fp8_f32(c, d, r, true); return (unsigned)r; }
__device__ __forceinline__ float sat8(float a) { return __builtin_amdgcn_fmed3f(a, -448.0f, 448.0f); }
__device__ __forceinline__ unsigned char f2fp8(float a) { return (unsigned char)(__builtin_amdgcn_cvt_pk_fp8_f32(sat8(a), 0.f, 0, false) & 0xff); }
__device__ __forceinline__ float fp82f(unsigned char h) { return __builtin_amdgcn_cvt_f32_fp8((int)h, 0); }
__device__ __forceinline__ float bf2f(unsigned short h) { return __builtin_bit_cast(float, (unsigned)h << 16); }
__device__ __forceinline__ float bflo(unsigned w) { return __builtin_bit_cast(float, w << 16); }
__device__ __forceinline__ float bfhi(unsigned w) { return __builtin_bit_cast(float, w & 0xffff0000u); }
#define DPP_ADD(v, CTRL) (v) += __builtin_bit_cast(float, __builtin_amdgcn_update_dpp(0, __builtin_bit_cast(int, (v)), (CTRL), 0xF, 0xF, true))
__device__ __forceinline__ float row16_sum(float v) {
    DPP_ADD(v, 0xB1); DPP_ADD(v, 0x4E); DPP_ADD(v, 0x141); DPP_ADD(v, 0x140);
    return v;
}
__device__ __forceinline__ float row16_max(float v) {
#define DPP_MAX(CTRL) v = fmaxf(v, __builtin_bit_cast(float, __builtin_amdgcn_update_dpp(0, __builtin_bit_cast(int, v), (CTRL), 0xF, 0xF, true)))
    DPP_MAX(0xB1); DPP_MAX(0x4E); DPP_MAX(0x141); DPP_MAX(0x140);
#undef DPP_MAX
    return v;
}
__device__ __forceinline__ float wave_sum(float v) {
    v = row16_sum(v);
    const int b = __builtin_bit_cast(int, v);
    const float r0 = __builtin_bit_cast(float, __builtin_amdgcn_readlane(b, 0)), r1 = __builtin_bit_cast(float, __builtin_amdgcn_readlane(b, 16)), r2 = __builtin_bit_cast(float, __builtin_amdgcn_readlane(b, 32)), r3 = __builtin_bit_cast(float, __builtin_amdgcn_readlane(b, 48));
    return (r0 + r1) + (r2 + r3);
}
__device__ __forceinline__ int pinv32(int j) { return 16 * ((j >> 2) & 1) + 4 * (j >> 3) + (j & 3); }

__device__ __forceinline__ int my_tid(int wid_s) { int l; asm volatile("v_mbcnt_lo_u32_b32 %0, -1, 0\n\tv_mbcnt_hi_u32_b32 %0, -1, %0" : "=v"(l)); return wid_s * 64 + l; }
struct Args { const float* in[28]; float* out; unsigned char* ws; int ph_lo, ph_hi, li, pad; };

namespace pg8 {
constexpr int BM = 256, BK = 64, HALF = 128, HTB = HALF * BK * 2, STAGE_BYTES = 8 * HTB, NXCD = 8, WGM = 8;
__host__ __device__ __forceinline__ int lds_byte(int r, int c) { const int st = (r >> 4) * 2 + (c >> 5), rr = r & 15, cc = c & 31, ob = rr * 64 + cc * 2; return st * 1024 + (ob ^ (((ob >> 9) & 1) << 5)); }
__host__ __device__ __forceinline__ void stage_rc(int b, int& R, int& C) { const int st = b / 1024, sb = b % 1024, swz = sb ^ (((sb >> 9) & 1) << 5); R = (st >> 1) * 16 + swz / 64; C = (st & 1) * 32 + (swz % 64) / 2; }

struct Unit { int pm, pn, aux; const char* A; const char* B; };

struct StaticOrder {
    int nM, nN, nwg, G, c, lda, K; const char* Ab; const char* Bb;
    __device__ __forceinline__ void init(const void* A, const void* Bt, int M, int N, int K_, int lda_, int G_, int c_) { nM = M / BM; nN = N / BM; nwg = nM * nN; G = G_; c = c_; lda = lda_; K = K_; Ab = (const char*)A; Bb = (const char*)Bt; }
    __device__ __forceinline__ bool next(int i, Unit& u) const {
        const long L = (long)i * G + c; if (L >= nwg) return false;
        int wgid = (int)L; { const int q = nwg / NXCD, r = nwg % NXCD, xcd = wgid % NXCD, off = wgid / NXCD; wgid = (xcd < r ? xcd * (q + 1) : r * (q + 1) + (xcd - r) * q) + off; }
        const int nig = WGM * nN, gid = wgid / nig, fm = gid * WGM, gsz = (nM - fm) < WGM ? (nM - fm) : WGM;
        u.pm = fm + ((wgid % nig) % gsz); u.pn = (wgid % nig) / gsz; u.aux = i;
        u.A = Ab + (size_t)u.pm * BM * lda * 2; u.B = Bb + (size_t)u.pn * BM * K * 2; return true;
    }
    __device__ __forceinline__ void voff(const Unit&, int tid, unsigned (&v)[2][2]) const {
#pragma unroll
        for (int i = 0; i < 2; ++i) { int R, C; stage_rc(tid * 16 + i * 8192, R, C);
#pragma unroll
            for (int h = 0; h < 2; ++h) v[h][i] = (unsigned)((h * HALF + R) * lda + C) * 2u; }
    }
};

template <class Epi, class Sched, bool FP8 = false>
__device__ __forceinline__ void gemm_phase(LAS unsigned char* lds, const int K, const Sched& S, const Epi& E, int tid, const int wscale = 0x7F7F7F7F, const int ascale = 0x7F7F7F7F) {
    typedef int v4i_t __attribute__((ext_vector_type(4))); typedef int v8i_t __attribute__((ext_vector_type(8)));
    asm volatile("" : "+v"(tid) :: "memory");
    const int wid = __builtin_amdgcn_readfirstlane(tid >> 6), lane = tid & 63, wr = wid >> 2, wc = wid & 3, fr = lane & 15, fq = lane >> 4;
    const int nt = K / BK;
    unsigned voffB[2];
#pragma unroll
    for (int i = 0; i < 2; ++i) { int R, C; stage_rc(tid * 16 + i * 8192, R, C); voffB[i] = (unsigned)(R * K + C) * 2u; }
    const size_t kstep = (size_t)(BK * 2);
    const size_t hstep = (size_t)HALF * K * 2;
    const unsigned ldsw = (unsigned)wid * 1024u;
    const int aoff = lds_byte(wr * 64 + fr, fq * 8), boff = lds_byte(wc * 32 + fr, fq * 8);
#define PG8_SA(b, h) (((b) * 2 + (h)) * HTB)
#define PG8_SB(b, h) ((4 + (b) * 2 + (h)) * HTB)
#define PG8_STAGE(bufoff, gbase, voff) do { _Pragma("unroll") for (int _i = 0; _i < 2; ++_i) \
        __builtin_amdgcn_global_load_lds((const unsigned*)((const char*)(gbase) + (voff)[_i]), (LAS unsigned*)(lds + (bufoff) + ldsw + _i * 8192), 16, 0, 0); } while (0)
#define PG8_LDA(dst, b, h) do { if constexpr (FP8) { _Pragma("unroll") for (int m = 0; m < 4; ++m) { const v4i_t lo_ = *(const LAS v4i_t*)(lds + PG8_SA(b, h) + aoff + m * 2048), hi_ = *(const LAS v4i_t*)(lds + PG8_SA(b, h) + aoff + m * 2048 + 1024); dst##8[m] = __builtin_shufflevector(lo_, hi_, 0, 1, 2, 3, 4, 5, 6, 7); } } \
        else { _Pragma("unroll") for (int m = 0; m < 4; ++m) _Pragma("unroll") for (int k = 0; k < 2; ++k) dst[m][k] = *(const LAS bf16x8*)(lds + PG8_SA(b, h) + aoff + m * 2048 + k * 1024); } } while (0)
#define PG8_LDB(dst, b, h) do { if constexpr (FP8) { _Pragma("unroll") for (int n = 0; n < 2; ++n) { const v4i_t lo_ = *(const LAS v4i_t*)(lds + PG8_SB(b, h) + boff + n * 2048), hi_ = *(const LAS v4i_t*)(lds + PG8_SB(b, h) + boff + n * 2048 + 1024); dst##8[n] = __builtin_shufflevector(lo_, hi_, 0, 1, 2, 3, 4, 5, 6, 7); } } \
        else { _Pragma("unroll") for (int n = 0; n < 2; ++n) _Pragma("unroll") for (int k = 0; k < 2; ++k) dst[n][k] = *(const LAS bf16x8*)(lds + PG8_SB(b, h) + boff + n * 2048 + k * 1024); } } while (0)
#define PG8_MMA(ai, bj, At, Bt) do { __builtin_amdgcn_s_setprio(1); \
        if constexpr (FP8) { _Pragma("unroll") for (int m = 0; m < 4; ++m) _Pragma("unroll") for (int n = 0; n < 2; ++n) \
            asm volatile("s_nop 1\n\tv_mfma_scale_f32_16x16x128_f8f6f4 %0, %1, %2, %0, %3, %4 op_sel_hi:[0,0,0]" : "+v"(acc[ai][bj][m][n]) : "v"(Bt##8[n]), "v"(At##8[m]), "v"(wsc_), "v"(asc_)); } \
        else { _Pragma("unroll") for (int m = 0; m < 4; ++m) _Pragma("unroll") for (int n = 0; n < 2; ++n) _Pragma("unroll") for (int k = 0; k < 2; ++k) \
            acc[ai][bj][m][n] = __builtin_amdgcn_mfma_f32_16x16x32_bf16(Bt[n][k], At[m][k], acc[ai][bj][m][n], 0, 0, 0); } \
        __builtin_amdgcn_s_setprio(0); } while (0)
#define PG8_WAIT_V(n) asm volatile("s_waitcnt vmcnt(" #n ")" ::: "memory")
#define PG8_WAIT_L(n) asm volatile("s_waitcnt lgkmcnt(" #n ")" ::: "memory")
#define PG8_BAR __builtin_amdgcn_s_barrier()
#define PG8_SCHED __builtin_amdgcn_sched_barrier(0)
    Unit cur, nxt; int ui = 0;
    if (!S.next(0, cur)) return;
    unsigned vc[2][2], vn[2][2];
    S.voff(cur, tid, vc);
    f32x4 acc[2][2][4][2];
#pragma unroll
    for (int a = 0; a < 2; ++a)
#pragma unroll
        for (int b = 0; b < 2; ++b)
#pragma unroll
            for (int m = 0; m < 4; ++m)
#pragma unroll
                for (int n = 0; n < 2; ++n) acc[a][b][m][n] = (f32x4){0.f, 0.f, 0.f, 0.f};
    bf16x8 At[4][2], B0[2][2], B1[2][2]; v8i_t At8[4], B08[2], B18[2]; const int wsc_ = wscale, asc_ = ascale;
    const char* cA = cur.A; const char* cB = cur.B;
    PG8_STAGE(PG8_SB(0, 0), cB, voffB); PG8_STAGE(PG8_SB(0, 1), cB + hstep, voffB); PG8_STAGE(PG8_SA(0, 0), cA, vc[0]); PG8_STAGE(PG8_SA(0, 1), cA, vc[1]);
    if (wr == 1) PG8_BAR;
    PG8_WAIT_V(2); PG8_BAR;
    PG8_STAGE(PG8_SB(1, 0), cB + kstep, voffB); PG8_STAGE(PG8_SA(1, 0), cA + kstep, vc[0]); PG8_STAGE(PG8_SB(1, 1), cB + hstep + kstep, voffB);
    PG8_WAIT_V(6); PG8_BAR;
    for (;;) {
        const bool has_next = S.next(ui + 1, nxt);
        const char* nA = has_next ? nxt.A : cA; const char* nB = has_next ? nxt.B : cB;
#pragma unroll 1
        for (int t = 0; t < nt; t += 2) {
            const bool last = (t == nt - 2);
            if (last) { if (has_next) S.voff(nxt, tid, vn); else {
#pragma unroll
                for (int h = 0; h < 2; ++h)
#pragma unroll
                    for (int i = 0; i < 2; ++i) vn[h][i] = vc[h][i]; } }
            const char* a1 = cA + (size_t)(t + 1) * kstep;
            const char* a2 = last ? nA : cA + (size_t)(t + 2) * kstep; const char* b2 = last ? nB : cB + (size_t)(t + 2) * kstep;
            const char* a3 = a2 + kstep; const char* b3 = b2 + kstep;
            unsigned s0[2], s1[2];
            s0[0] = last ? vn[0][0] : vc[0][0]; s0[1] = last ? vn[0][1] : vc[0][1]; s1[0] = last ? vn[1][0] : vc[1][0]; s1[1] = last ? vn[1][1] : vc[1][1];
            PG8_LDB(B0, 0, 0); PG8_LDB(B1, 0, 1); PG8_SCHED; PG8_LDA(At, 0, 0); PG8_STAGE(PG8_SA(1, 1), a1, vc[1]);
            PG8_WAIT_V(8); PG8_WAIT_L(0); PG8_BAR; PG8_MMA(0, 0, At, B0); PG8_MMA(0, 1, At, B1); PG8_BAR; PG8_SCHED;
            PG8_LDA(At, 0, 1); PG8_STAGE(PG8_SB(0, 0), b2, voffB); PG8_STAGE(PG8_SB(0, 1), b2 + hstep, voffB); PG8_STAGE(PG8_SA(0, 0), a2, s0);
            PG8_WAIT_V(8); PG8_WAIT_L(0); PG8_BAR; PG8_MMA(1, 0, At, B0); PG8_MMA(1, 1, At, B1); PG8_BAR; PG8_SCHED;
            PG8_LDB(B0, 1, 0); PG8_LDB(B1, 1, 1); PG8_SCHED; PG8_LDA(At, 1, 0); PG8_STAGE(PG8_SA(0, 1), a2, s1);
            PG8_WAIT_V(8); PG8_WAIT_L(0); PG8_BAR; PG8_MMA(0, 0, At, B0); PG8_MMA(0, 1, At, B1); PG8_BAR; PG8_SCHED;
            PG8_LDA(At, 1, 1); PG8_STAGE(PG8_SB(1, 0), b3, voffB); PG8_STAGE(PG8_SB(1, 1), b3 + hstep, voffB); PG8_STAGE(PG8_SA(1, 0), a3, s0);
            PG8_WAIT_V(8); PG8_WAIT_L(0); PG8_BAR; PG8_MMA(1, 0, At, B0); PG8_MMA(1, 1, At, B1); PG8_BAR; PG8_SCHED;
        }
        if (wr == 0) PG8_BAR;
        if constexpr (FP8) asm volatile("s_nop 15\n\ts_nop 15" ::: "memory");
        { int fr_ = fr, fq_ = fq; asm volatile("" : "+v"(fr_), "+v"(fq_) : "s"(ui));
          E(acc, cur, wr, wc, fr_, fq_); }
        if (!has_next) break;
        if (!(Epi::CARRY && (cur.aux & 1) == 0)) {
#pragma unroll
        for (int a = 0; a < 2; ++a)
#pragma unroll
            for (int b = 0; b < 2; ++b)
#pragma unroll
                for (int m = 0; m < 4; ++m)
#pragma unroll
                    for (int n = 0; n < 2; ++n) acc[a][b][m][n] = (f32x4){0.f, 0.f, 0.f, 0.f}; }
        cur = nxt; cA = nA; cB = nB; ++ui;
#pragma unroll
        for (int h = 0; h < 2; ++h)
#pragma unroll
            for (int i = 0; i < 2; ++i) vc[h][i] = vn[h][i];
        if (wr == 1) PG8_BAR;
    }
    PG8_WAIT_V(0);
    PG8_BAR;
#undef PG8_SA
#undef PG8_SB
#undef PG8_STAGE
#undef PG8_LDA
#undef PG8_LDB
#undef PG8_MMA
#undef PG8_WAIT_V
#undef PG8_WAIT_L
#undef PG8_BAR
#undef PG8_SCHED
}
}

constexpr float C2Q = 0.125f * 1.4426950408889634f;

struct EpiIn {
    static constexpr bool CARRY = false;
    bf16* zhy; bf16* q; bf16* k; bf16* v; bf16* gate; const float* bperm; const float* qgain; const float* kgain; const float* cs;
    __device__ __forceinline__ void operator()(const f32x4 (&acc)[2][2][4][2], const pg8::Unit& u, int wr, int wc, int fr, int fq) const {
        const int pn = u.pn; const int row0 = u.pm * 256 + wr * 64 + fr;
        f32x4 bv[2][2];
#pragma unroll
        for (int bj = 0; bj < 2; ++bj)
#pragma unroll
            for (int n = 0; n < 2; ++n) bv[bj][n] = *(const f32x4*)(bperm + pn * 256 + bj * 128 + wc * 32 + n * 16 + 4 * fq);
        if (pn < 6) {
            const int colt = pn * 256 + wc * 32 + 8 * fq;
#pragma unroll
            for (int ai = 0; ai < 2; ++ai)
#pragma unroll
                for (int m = 0; m < 4; ++m) { bf16* rowp = zhy + (size_t)(row0 + ai * 128 + m * 16) * HYIN + colt;
#pragma unroll
                    for (int bj = 0; bj < 2; ++bj) { const f32x4 v0 = acc[ai][bj][m][0] + bv[bj][0], v1 = acc[ai][bj][m][1] + bv[bj][1];
                        v4u w; w.x = pk2(v0[0], v0[1]); w.y = pk2(v0[2], v0[3]); w.z = pk2(v1[0], v1[1]); w.w = pk2(v1[2], v1[3]);
                        *(v4u*)(rowp + bj * 128) = w; } }
        } else if (pn < 9) {
            const bool isq = pn < 8; const bool isv = (!isq) && (wc >= 2);
            const float* gain = isq ? qgain : kgain;
            f32x4 gv[2][2];
#pragma unroll
            for (int bj = 0; bj < 2; ++bj)
#pragma unroll
                for (int n = 0; n < 2; ++n) gv[bj][n] = *(const f32x4*)(gain + bj * 32 + n * 16 + 4 * fq);
            bf16* obase; int pitch, hcol;
            if (isq) { obase = q; pitch = ATTW; hcol = ((pn - 6) * 4 + wc) * 64; }
            else if (!isv) { obase = k; pitch = KVW; hcol = wc * 64; }
            else { obase = v; pitch = KVW; hcol = (wc - 2) * 64; }
            const float osc = isq ? C2Q : 1.0f;
#pragma unroll
            for (int ai = 0; ai < 2; ++ai)
#pragma unroll
                for (int m = 0; m < 4; ++m) { const int row = row0 + ai * 128 + m * 16; const int t = row & (SEQ - 1);
                    f32x4 y[2][2]; float ss = 0.f;
#pragma unroll
                    for (int bj = 0; bj < 2; ++bj)
#pragma unroll
                        for (int n = 0; n < 2; ++n) { y[bj][n] = acc[ai][bj][m][n] + bv[bj][n]; ss += (y[bj][n][0] * y[bj][n][0] + y[bj][n][1] * y[bj][n][1]) + (y[bj][n][2] * y[bj][n][2] + y[bj][n][3] * y[bj][n][3]); }
                    bf16* orow = obase + (size_t)row * pitch + hcol + 4 * fq;
                    if (!isv) {
                        ss += __shfl_xor(ss, 16); ss += __shfl_xor(ss, 32);
                        const float rstd = 1.0f / sqrtf(ss * (1.0f / 64.0f) + EPSV);
#pragma unroll
                        for (int bj = 0; bj < 2; ++bj) { const int pos = bj == 0 ? (t >> 6) : (t & 63);
                            const f32x4 cc = *(const f32x4*)(cs + pos * 32 + 4 * fq), sn = *(const f32x4*)(cs + pos * 32 + 16 + 4 * fq);
                            const f32x4 u1 = y[bj][0] * rstd * gv[bj][0], u2 = y[bj][1] * rstd * gv[bj][1];
                            y[bj][0] = (u1 * cc - u2 * sn) * osc; y[bj][1] = (u1 * sn + u2 * cc) * osc; }
                    }
#pragma unroll
                    for (int bj = 0; bj < 2; ++bj)
#pragma unroll
                        for (int n = 0; n < 2; ++n) { v2u w; w.x = pk2(y[bj][n][0], y[bj][n][1]); w.y = pk2(y[bj][n][2], y[bj][n][3]); *(v2u*)(orow + bj * 32 + n * 16) = w; } }
        } else {
            const int colt = (pn - 9) * 256 + wc * 32 + 8 * fq;
#pragma unroll
            for (int ai = 0; ai < 2; ++ai)
#pragma unroll
                for (int m = 0; m < 4; ++m) { bf16* rowp = gate + (size_t)(row0 + ai * 128 + m * 16) * 2048 + colt;
#pragma unroll
                    for (int bj = 0; bj < 2; ++bj) { f32x4 v0 = acc[ai][bj][m][0] + bv[bj][0], v1 = acc[ai][bj][m][1] + bv[bj][1];
#pragma unroll
                        for (int e = 0; e < 4; ++e) { v0[e] = 1.0f / (1.0f + __expf(-v0[e])); v1[e] = 1.0f / (1.0f + __expf(-v1[e])); }
                        v4u w; w.x = pk2(v0[0], v0[1]); w.y = pk2(v0[2], v0[3]); w.z = pk2(v1[0], v1[1]); w.w = pk2(v1[2], v1[3]);
                        *(v4u*)(rowp + bj * 128) = w; } }
        }
    }
};

template <int MODE> struct EpiMerge {
    static constexpr bool CARRY = false;
    bf16* mbuf; const bf16* gate; int gcol0;
    __device__ __forceinline__ void operator()(const f32x4 (&acc)[2][2][4][2], const pg8::Unit& u, int wr, int wc, int fr, int fq) const {
        const int row0 = u.pm * 256 + wr * 64 + fr; const int col0 = u.pn * 256 + wc * 32 + 8 * fq;
#pragma unroll
        for (int ai = 0; ai < 2; ++ai) {
            v4u g[4][2], p[4][2];
#pragma unroll
            for (int m = 0; m < 4; ++m) { const size_t row = (size_t)(row0 + ai * 128 + m * 16);
#pragma unroll
                for (int bj = 0; bj < 2; ++bj) { g[m][bj] = *(const v4u*)(gate + row * 2048 + gcol0 + col0 + bj * 128); if (MODE == 1) p[m][bj] = *(const v4u*)(mbuf + row * DM + col0 + bj * 128); } }
#pragma unroll
            for (int m = 0; m < 4; ++m) { const size_t row = (size_t)(row0 + ai * 128 + m * 16);
#pragma unroll
                for (int bj = 0; bj < 2; ++bj) { const v4u gv = g[m][bj];
                    f32x4 v0 = acc[ai][bj][m][0], v1 = acc[ai][bj][m][1];
                    v0[0] *= bflo(gv.x); v0[1] *= bfhi(gv.x); v0[2] *= bflo(gv.y); v0[3] *= bfhi(gv.y); v1[0] *= bflo(gv.z); v1[1] *= bfhi(gv.z); v1[2] *= bflo(gv.w); v1[3] *= bfhi(gv.w);
                    if (MODE == 1) { const v4u pv = p[m][bj]; v0[0] += bflo(pv.x); v0[1] += bfhi(pv.x); v0[2] += bflo(pv.y); v0[3] += bfhi(pv.y); v1[0] += bflo(pv.z); v1[1] += bfhi(pv.z); v1[2] += bflo(pv.w); v1[3] += bfhi(pv.w); }
                    v4u w; w.x = pk2(v0[0], v0[1]); w.y = pk2(v0[2], v0[3]); w.z = pk2(v1[0], v1[1]); w.w = pk2(v1[2], v1[3]);
                    *(v4u*)(mbuf + row * DM + col0 + bj * 128) = w; } } }
    }
};


struct EpiMergeR {
    static constexpr bool CARRY = true;
    unsigned char* mbuf; const bf16* gate;
    __device__ __forceinline__ void operator()(f32x4 (&acc)[2][2][4][2], const pg8::Unit& u, int wr, int wc, int fr, int fq) const {
        const int row0 = u.pm * 256 + wr * 64 + fr; const int col0 = u.pn * 256 + wc * 32 + 8 * fq; const bool first = (u.aux & 1) == 0;
#pragma unroll
        for (int ai = 0; ai < 2; ++ai) {
            v4u ga[4][2], gh[4][2];
#pragma unroll
            for (int m = 0; m < 4; ++m) { const size_t row = (size_t)(row0 + ai * 128 + m * 16);
#pragma unroll
                for (int bj = 0; bj < 2; ++bj) { ga[m][bj] = *(const v4u*)(gate + row * 2048 + 1024 + col0 + bj * 128); if (first) gh[m][bj] = *(const v4u*)(gate + row * 2048 + col0 + bj * 128); } }
#pragma unroll
            for (int m = 0; m < 4; ++m) { const size_t row = (size_t)(row0 + ai * 128 + m * 16);
#pragma unroll
                for (int bj = 0; bj < 2; ++bj) { const v4u a = ga[m][bj];
                    float g8[8] = {bflo(a.x), bfhi(a.x), bflo(a.y), bfhi(a.y), bflo(a.z), bfhi(a.z), bflo(a.w), bfhi(a.w)};
                    if (first) { const v4u h = gh[m][bj]; const float h8[8] = {bflo(h.x), bfhi(h.x), bflo(h.y), bfhi(h.y), bflo(h.z), bfhi(h.z), bflo(h.w), bfhi(h.w)};
#pragma unroll
                        for (int e = 0; e < 4; ++e) { acc[ai][bj][m][0][e] *= h8[e] * __builtin_amdgcn_rcpf(fmaxf(g8[e], 1e-30f)); acc[ai][bj][m][1][e] *= h8[4 + e] * __builtin_amdgcn_rcpf(fmaxf(g8[4 + e], 1e-30f)); } }
                    else { const f32x4 v0 = acc[ai][bj][m][0], v1 = acc[ai][bj][m][1];
                        v2u w; w.x = pk4_fp8(sat8(v0[0] * g8[0] * 64.0f), sat8(v0[1] * g8[1] * 64.0f), sat8(v0[2] * g8[2] * 64.0f), sat8(v0[3] * g8[3] * 64.0f)); w.y = pk4_fp8(sat8(v1[0] * g8[4] * 64.0f), sat8(v1[1] * g8[5] * 64.0f), sat8(v1[2] * g8[6] * 64.0f), sat8(v1[3] * g8[7] * 64.0f));
                        *(v2u*)(mbuf + row * DM + col0 + bj * 128) = w; } } } }
    }
};
struct MergeOrder {
    pg8::StaticOrder S; const char* A2; const char* B2;
    __device__ __forceinline__ bool next(int i, pg8::Unit& u) const { if (!S.next(i >> 1, u)) return false; u.aux = i; if (i & 1) { u.A = A2 + (size_t)u.pm * 256 * ATTW; u.B = B2 + (size_t)u.pn * 256 * ATTW; } return true; }
    __device__ __forceinline__ void voff(const pg8::Unit& u, int tid, unsigned (&v)[2][2]) const { S.voff(u, tid, v); }
};

struct EpiOut {
    static constexpr bool CARRY = false;
    const float* x; float* out; const float* mod; float* rowsq;
    __device__ __forceinline__ void operator()(const f32x4 (&acc)[2][2][4][2], const pg8::Unit& u, int wr, int wc, int fr, int fq) const {
        const int row0 = u.pm * 256 + wr * 64 + fr; const int col0 = u.pn * 256 + wc * 32 + 4 * fq; const int b = row0 >> 13;
        f32x4 gt[2][2];
#pragma unroll
        for (int bj = 0; bj < 2; ++bj)
#pragma unroll
            for (int n = 0; n < 2; ++n) gt[bj][n] = *(const f32x4*)(mod + b * 6144 + 2048 + col0 + bj * 128 + n * 16);
#pragma unroll
        for (int ai = 0; ai < 2; ++ai)
#pragma unroll
            for (int mp = 0; mp < 4; mp += 2) { f32x4 xv[2][2][2];
#pragma unroll
                for (int mm = 0; mm < 2; ++mm) { const size_t row = (size_t)(row0 + ai * 128 + (mp + mm) * 16);
#pragma unroll
                    for (int bj = 0; bj < 2; ++bj)
#pragma unroll
                        for (int n = 0; n < 2; ++n) xv[mm][bj][n] = *(const f32x4*)(x + row * DM + col0 + bj * 128 + n * 16); }
#pragma unroll
                for (int mm = 0; mm < 2; ++mm) { const int m = mp + mm; const size_t row = (size_t)(row0 + ai * 128 + m * 16); float ss = 0.f;
#pragma unroll
                    for (int bj = 0; bj < 2; ++bj)
#pragma unroll
                        for (int n = 0; n < 2; ++n) { const size_t off = row * DM + col0 + bj * 128 + n * 16;
                            const f32x4 o = xv[mm][bj][n] + gt[bj][n] * acc[ai][bj][m][n]; ss += (o[0] * o[0] + o[1] * o[1]) + (o[2] * o[2] + o[3] * o[3]); *(f32x4*)(out + off) = o; }
                    ss += __shfl_xor(ss, 16); ss += __shfl_xor(ss, 32);
                    if (fq == 0) rowsq[row * 16 + u.pn * 4 + wc] = ss; } }
    }
};

struct EpiSwiglu {
    static constexpr bool CARRY = false;
    unsigned char* act;
    __device__ __forceinline__ void operator()(const f32x4 (&acc)[2][2][4][2], const pg8::Unit& u, int wr, int wc, int fr, int fq) const {
        const int row0 = u.pm * 256 + wr * 64 + fr; const int col0 = u.pn * 128 + wc * 32 + 8 * fq;
#pragma unroll
        for (int ai = 0; ai < 2; ++ai)
#pragma unroll
            for (int m = 0; m < 4; ++m) { f32x4 a0 = acc[ai][0][m][0], a1 = acc[ai][0][m][1]; const f32x4 u0 = acc[ai][1][m][0], u1 = acc[ai][1][m][1];
#pragma unroll
                for (int e = 0; e < 4; ++e) { a0[e] = a0[e] / (1.0f + __expf(-a0[e])) * u0[e]; a1[e] = a1[e] / (1.0f + __expf(-a1[e])) * u1[e]; }
                v2u w; w.x = pk4_fp8(a0[0], a0[1], a0[2], a0[3]); w.y = pk4_fp8(a1[0], a1[1], a1[2], a1[3]);
                *(v2u*)(act + (size_t)(row0 + ai * 128 + m * 16) * DFF + col0) = w; }
    }
};

struct EpiDown {
    static constexpr bool CARRY = false;
    bf16* ye; const float* topw;
    __device__ __forceinline__ void operator()(const f32x4 (&acc)[2][2][4][2], const pg8::Unit& u, int wr, int wc, int fr, int fq) const {
        const int row0 = u.pm * 256 + wr * 64 + fr; const int col0 = u.pn * 256 + wc * 32 + 8 * fq;
        float tw[2][4];
#pragma unroll
        for (int ai = 0; ai < 2; ++ai)
#pragma unroll
            for (int m = 0; m < 4; ++m) tw[ai][m] = topw[row0 + ai * 128 + m * 16];
#pragma unroll
        for (int ai = 0; ai < 2; ++ai)
#pragma unroll
            for (int m = 0; m < 4; ++m) { const int row = row0 + ai * 128 + m * 16; const float w8 = tw[ai][m];
#pragma unroll
                for (int bj = 0; bj < 2; ++bj) { const f32x4 v0 = acc[ai][bj][m][0] * w8, v1 = acc[ai][bj][m][1] * w8;
                    v4u w; w.x = pk2(v0[0], v0[1]); w.y = pk2(v0[2], v0[3]); w.z = pk2(v1[0], v1[1]); w.w = pk2(v1[2], v1[3]);
                    *(v4u*)(ye + (size_t)row * DM + col0 + bj * 128) = w; } }
    }
};

struct MoeUpOrder {
    int G, c; const char* h2; const char* wgu; const LAS int* idx;
    __device__ __forceinline__ bool decode(long L, int& e, int& b, int& mblk, int& pn) const {
        if (L >= 4096) return false; e = (int)(L >> 8); const int w = (int)(L & 255), x = w & 7, j = w >> 3; pn = 2 * x + (j & 1); const int m16 = j >> 1; b = m16 >> 2; mblk = m16 & 3; return true; }
    __device__ __forceinline__ bool next(int i, pg8::Unit& u) const {
        int e, b, mblk, pn; if (!decode((long)i * G + c, e, b, mblk, pn)) return false;
        u.pm = (b * NEXP + e) * 4 + mblk; u.pn = pn; u.aux = i; u.A = h2 + (size_t)b * SEQ * DM; u.B = wgu + (size_t)(e * 16 + pn) * 256 * DM; return true; }
    __device__ __forceinline__ void voff(const pg8::Unit& u, int tid, unsigned (&v)[2][2]) const {
#pragma unroll
        for (int i = 0; i < 2; ++i) { int R, C; pg8::stage_rc(tid * 16 + i * 8192, R, C);
#pragma unroll
            for (int h = 0; h < 2; ++h) { const int tok = idx[(u.aux & 15) * 256 + h * 128 + R]; v[h][i] = (unsigned)(tok * (DM / 2) + C) * 2u; } }
    }
};
struct MoeDownOrder {
    int G, c; const char* act; const char* wd;
    __device__ __forceinline__ bool next(int i, pg8::Unit& u) const {
        const long L = (long)i * G + c; if (L >= 1024) return false;
        const int r = (int)(L >> 8), w = (int)(L & 255), x = w & 7, j = w >> 3; const int e = 4 * r + (x >> 1), pn = 2 * (x & 1) + (j & 1), m16 = j >> 1, b = m16 >> 2, mblk = m16 & 3;
        u.pm = (b * NEXP + e) * 4 + mblk; u.pn = pn; u.aux = i; u.A = act + (size_t)u.pm * 256 * DFF; u.B = wd + (size_t)(e * 4 + pn) * 256 * DFF; return true; }
    __device__ __forceinline__ void voff(const pg8::Unit&, int tid, unsigned (&v)[2][2]) const {
#pragma unroll
        for (int i = 0; i < 2; ++i) { int R, C; pg8::stage_rc(tid * 16 + i * 8192, R, C);
#pragma unroll
            for (int h = 0; h < 2; ++h) v[h][i] = (unsigned)((h * 128 + R) * (DFF / 2) + C) * 2u; }
    }
};

namespace attn_body {
using bf16h = __hip_bfloat16;
using s16x4 = __attribute__((ext_vector_type(4))) short;
using f32x16 = __attribute__((ext_vector_type(16))) float;
using u32x4 = __attribute__((ext_vector_type(4))) unsigned;
constexpr int D = 64, QP = ATTW, KP = KVW;
constexpr int NW = 8, QBLK = 32, QB = QBLK * NW, KVBLK = 64;
__device__ __forceinline__ int crow(int r, int hi) { return (r & 3) + 8 * (r >> 2) + 4 * hi; }
#define SBAR() __builtin_amdgcn_sched_barrier(0)
constexpr int NSLOT = 3, SLOTB = 8192;
constexpr int LDS_K = 0, LDS_V = NSLOT * SLOTB, LDS_WS = 2 * NSLOT * SLOTB, LDS_OST = LDS_WS + NW * 64 * 4, LDS_ATT_BYTES = LDS_OST + NW * 4096;
__device__ __forceinline__ void glds16(const void* gsrc, unsigned lds_dst) { unsigned keep;
  asm volatile("s_mov_b32 %0, m0\n\ts_mov_b32 m0, %2\n\ts_nop 0\n\tglobal_load_lds_dwordx4 %1, off\n\ts_mov_b32 m0, %0" : "=&s"(keep) : "v"(gsrc), "s"(lds_dst) : "memory"); }
__device__ __forceinline__ float max3f(float a, float b, float c) { float r; asm("v_max3_f32 %0, %1, %2, %3" : "=v"(r) : "v"(a), "v"(b), "v"(c)); return r; }
__device__ __forceinline__ float max2f(float a, float b) { float r; asm("v_max_f32_e32 %0, %1, %2" : "=v"(r) : "v"(a), "v"(b)); return r; }
__device__ __forceinline__ float fadd_s(float a, float b) { float r; asm("v_add_f32_e32 %0, %1, %2" : "=v"(r) : "v"(a), "v"(b)); return r; }
__device__ __forceinline__ float fsub_s(float a, float b) { float r; asm("v_sub_f32_e32 %0, %1, %2" : "=v"(r) : "v"(a), "v"(b)); return r; }
typedef float f32x2_t __attribute__((ext_vector_type(2))); typedef __bf16 bf16x2_t __attribute__((ext_vector_type(2)));
__device__ __forceinline__ unsigned cvtpk_s(float lo, float hi) { f32x2_t v = {lo, hi}; bf16x2_t b = __builtin_convertvector(v, bf16x2_t); return __builtin_bit_cast(unsigned, b); }
#define WAIT_BAR(N) asm volatile("s_waitcnt vmcnt(" #N ") lgkmcnt(0)\n\ts_barrier" ::: "memory")
__device__ __forceinline__ void qkt(f32x16& p0, f32x16& p1, const char* Kslot, const bf16x8* qr, const f32x16& negm, int r32, int hi) {
  const char* kb = Kslot + hi * 1024 + r32 * 16;
  #pragma unroll
  for (int d0 = 0; d0 < 4; ++d0) {
    const bf16x8 b0 = *reinterpret_cast<const bf16x8*>(kb + d0 * 2048);
    const bf16x8 b1 = *reinterpret_cast<const bf16x8*>(kb + d0 * 2048 + 512);
    if (d0 == 0) { p0 = __builtin_amdgcn_mfma_f32_32x32x16_bf16(b0, qr[0], negm, 0, 0, 0); p1 = __builtin_amdgcn_mfma_f32_32x32x16_bf16(b1, qr[0], negm, 0, 0, 0); }
    else { p0 = __builtin_amdgcn_mfma_f32_32x32x16_bf16(b0, qr[d0], p0, 0, 0, 0); p1 = __builtin_amdgcn_mfma_f32_32x32x16_bf16(b1, qr[d0], p1, 0, 0, 0); } }
}
typedef __attribute__((address_space(3))) const char* lds_cptr;
typedef short v4i16_t __attribute__((ext_vector_type(4)));
__device__ __forceinline__ void kload8(bf16x8* kf, lds_cptr kp) {
  kf[0] = *(const __attribute__((address_space(3))) bf16x8*)(kp);        kf[1] = *(const __attribute__((address_space(3))) bf16x8*)(kp + 512);
  kf[2] = *(const __attribute__((address_space(3))) bf16x8*)(kp + 2048); kf[3] = *(const __attribute__((address_space(3))) bf16x8*)(kp + 2560);
  kf[4] = *(const __attribute__((address_space(3))) bf16x8*)(kp + 4096); kf[5] = *(const __attribute__((address_space(3))) bf16x8*)(kp + 4608);
  kf[6] = *(const __attribute__((address_space(3))) bf16x8*)(kp + 6144); kf[7] = *(const __attribute__((address_space(3))) bf16x8*)(kp + 6656);
}
__device__ __forceinline__ void kload2(bf16x8* kf, lds_cptr kp, int j) { kf[2 * j] = *(const __attribute__((address_space(3))) bf16x8*)(kp + j * 2048); kf[2 * j + 1] = *(const __attribute__((address_space(3))) bf16x8*)(kp + j * 2048 + 512); }
__device__ __forceinline__ s16x4 vtr(lds_cptr p) { return __builtin_bit_cast(s16x4, __builtin_amdgcn_ds_read_tr16_b64_v4i16((__attribute__((address_space(3))) v4i16_t*)p)); }
__device__ __forceinline__ float rowmax(const f32x16& p0, const f32x16& p1) {
  float a = max3f(p0[0], p0[1], p1[0]), b = max3f(p0[2], p0[3], p1[1]); a = max3f(a, p1[2], p1[3]);
  #pragma unroll
  for (int r = 4; r < 16; r += 4) { a = max3f(a, p0[r], p0[r + 1]); b = max3f(b, p0[r + 2], p0[r + 3]); a = max3f(a, p1[r], p1[r + 1]); b = max3f(b, p1[r + 2], p1[r + 3]); }
  const float m = max2f(a, b);
  auto rr = __builtin_amdgcn_permlane32_swap(__float_as_uint(m), __float_as_uint(m), false, false);
  return max2f(__uint_as_float(rr[0]), __uint_as_float(rr[1]));
}
__device__ __forceinline__ void pv(f32x16* o, int vb, bf16x8 pa0, bf16x8 pa1, bf16x8 pa2, bf16x8 pa3) {
  #pragma unroll
  for (int d0 = 0; d0 < 2; ++d0) { s16x4 lo[4], hi[4];
    #pragma unroll
    for (int ks = 0; ks < 4; ++ks) {
      asm volatile("ds_read_b64_tr_b16 %0,%1 offset:%c2" : "=&v"(lo[ks]) : "v"(vb), "i"(d0 * 4096 + ks * 1024) : "memory");
      asm volatile("ds_read_b64_tr_b16 %0,%1 offset:%c2" : "=&v"(hi[ks]) : "v"(vb), "i"(d0 * 4096 + ks * 1024 + 512) : "memory"); }
    asm volatile("s_waitcnt lgkmcnt(0)" ::: "memory"); SBAR();
    #define PK(k) (bf16x8){lo[k][0], lo[k][1], lo[k][2], lo[k][3], hi[k][0], hi[k][1], hi[k][2], hi[k][3]}
    o[d0] = __builtin_amdgcn_mfma_f32_32x32x16_bf16(pa0, PK(0), o[d0], 0, 0, 0);
    o[d0] = __builtin_amdgcn_mfma_f32_32x32x16_bf16(pa1, PK(1), o[d0], 0, 0, 0);
    o[d0] = __builtin_amdgcn_mfma_f32_32x32x16_bf16(pa2, PK(2), o[d0], 0, 0, 0);
    o[d0] = __builtin_amdgcn_mfma_f32_32x32x16_bf16(pa3, PK(3), o[d0], 0, 0, 0);
    #undef PK
  }
}
template <int THRL, bool NOMAX> __device__ __forceinline__ void attn_unit(int b, int h, int qb, const bf16h* Q, const bf16h* __restrict__ K, const bf16h* __restrict__ V, bf16h* O, char* shm, int tid) {
  asm volatile("" : "+v"(tid) :: "memory");
  const int lane = tid & 63, r32 = lane & 31, hi = lane >> 5; const int wid = __builtin_amdgcn_readfirstlane(tid >> 6);
  const long rowbase = (long)b * SEQ; const int q0 = qb * QB; const int kvh = h >> 2;
  const bf16h* Qw = Q + (rowbase + q0 + wid * QBLK) * QP + h * D;
  const bf16h* Kh = K + rowbase * KP + kvh * D, *Vh = V + rowbase * KP + kvh * D;
  const unsigned lds0 = (unsigned)(uintptr_t)shm;
  float* wsf = (float*)(shm + LDS_WS) + wid * 64;
  const bf16h* ksrc = Kh + (long)lane * KP + wid * 8;
  const bf16h* vsrc = Vh + (long)(16 * (wid & 3) + (lane >> 2)) * KP + (wid >> 2) * 32 + (lane & 3) * 8;
  const unsigned kdst = lds0 + LDS_K + wid * 1024, vdst = lds0 + LDS_V + wid * 1024;
  #define DMA_K(t, slot) glds16(ksrc + (long)(t) * KVBLK * KP, (unsigned)__builtin_amdgcn_readfirstlane(kdst + (slot)))
  #define DMA_V(t, slot) glds16(vsrc + (long)(t) * KVBLK * KP, (unsigned)__builtin_amdgcn_readfirstlane(vdst + (slot)))
  const int vb0 = (int)(lds0 + LDS_V) + ((lane >> 4) & 1) * 32 + (lane & 3) * 8 + (4 * hi + ((lane & 15) >> 2)) * 64;
  const char* Kbase = shm + LDS_K; bf16x8 kf[8];
  const lds_cptr shm3 = (lds_cptr)shm; const lds_cptr kp0 = shm3 + LDS_K + hi * 1024 + r32 * 16; const lds_cptr vp0 = shm3 + LDS_V + ((lane >> 4) & 1) * 32 + (lane & 3) * 8 + (4 * hi + ((lane & 15) >> 2)) * 64;
  constexpr int NT = SEQ / KVBLK;
  DMA_K(0, 0); DMA_V(0, 0); DMA_K(1, SLOTB);
  bf16x8 qr[4];
  #pragma unroll
  for (int d0 = 0; d0 < 4; ++d0) qr[d0] = *reinterpret_cast<const bf16x8*>(&Qw[(long)r32 * QP + d0 * 16 + hi * 8]);
  float mhat = 0.f, l_reg = 0.f; f32x16 o[2]; o[0] = f32x16{}; o[1] = f32x16{}; f32x16 negm = f32x16{}; asm volatile("" : "+v"(negm));
  bool resc = false;
  #define START(P0, P1) do { resc = false; if (!NOMAX) { const float rm = rowmax(P0, P1); \
      const float dl = rm; mhat = fadd_s(mhat, dl); \
      _Pragma("unroll") for (int r = 0; r < 16; ++r) { P0[r] = fsub_s(P0[r], dl); P1[r] = fsub_s(P1[r], dl); } \
      _Pragma("unroll") for (int r = 0; r < 16; ++r) negm[r] = -mhat; asm volatile("" : "+v"(negm)); } \
    _Pragma("unroll") for (int r = 0; r < 16; ++r) P0[r] = __builtin_amdgcn_exp2f(P0[r]); } while (0)
  #define RESC() do { if (resc) { asm volatile("s_waitcnt lgkmcnt(0)" ::: "memory"); \
      _Pragma("unroll") for (int d_ = 0; d_ < 2; ++d_) _Pragma("unroll") for (int r = 0; r < 16; ++r) o[d_][r] *= wsf[crow(r, hi)]; } } while (0)
  f32x16 pA0, pA1, pB0, pB1;
  int sl_prev = 0, sl_cur = 0, sl_next = SLOTB;
  #define ROT() do { sl_prev = sl_cur; sl_cur = sl_next; sl_next = (sl_next == (NSLOT - 1) * SLOTB) ? 0 : sl_next + SLOTB; } while (0)
  DMA_K(2, 2 * SLOTB);
  WAIT_BAR(3);
  qkt(pA0, pA1, Kbase, qr, negm, r32, hi); asm volatile("s_nop 15\n\ts_nop 7" : "+v"(pA0), "+v"(pA1));
  START(pA0, pA1);
  _Pragma("unroll") for (int r = 0; r < 16; ++r) pA1[r] = __builtin_amdgcn_exp2f(pA1[r]);
  WAIT_BAR(0);
  DMA_K(3, 0); DMA_V(1, SLOTB);
  ROT();
  kload8(kf, kp0 + sl_cur);
  WAIT_BAR(2);
  s16x4 vlo[8], vhi[8]; u32x4 pw0, pw1, pw2, pw3;
  #define PKW(P, B) cvtpk_s(P[B], P[B + 1])
  #define PAF(k) __builtin_bit_cast(bf16x8, pw##k)
  #define VFR(i) (bf16x8){vlo[i][0], vlo[i][1], vlo[i][2], vlo[i][3], vhi[i][0], vhi[i][1], vhi[i][2], vhi[i][3]}
  #define PIN(x) asm volatile("" : "+v"(x))
  #define MX3(a, b, c) __builtin_fmaxf(__builtin_fmaxf((a), (b)), (c))
  #define GAPA(MF, A0, A1, A2, A3, W0, W1, PW) do { MF; sacc += A0; sacc += A1; sacc += A2; sacc += A3; PIN(sacc); W0; W1; PIN(PW); SBAR(); } while (0)
  #define EX(v) __builtin_amdgcn_exp2f(v)
  #define GAPB(MF, X, B) do { MF; X[B] = EX(X[B]); X[B + 1] = EX(X[B + 1]); X[B + 2] = EX(X[B + 2]); X[B + 3] = EX(X[B + 3]); PIN(X); SBAR(); } while (0)
  #define VRD(i) do { vlo[i] = vtr(vp_ + (((i) >> 2) * 4096 + ((i) & 3) * 1024)); vhi[i] = vtr(vp_ + (((i) >> 2) * 4096 + ((i) & 3) * 1024 + 512)); } while (0)
  #define KRD(G, j) do { if (G) { kload2(kf, kp0 + sl_next, j); SBAR(); } } while (0)
  #define STEP(C0, C1, P0, P1, t, GK, GV, GL) do { SBAR(); \
    const lds_cptr vp_ = vp0 + sl_prev; \
    VRD(0); SBAR(); float sacc = (P0[0] + P0[1]); \
    GAPA(C0 = __builtin_amdgcn_mfma_f32_32x32x16_bf16(kf[0], qr[0], negm, 0, 0, 0), P0[2], P0[3], P0[4], P0[5],     pw0[0] = PKW(P0, 0), pw0[1] = PKW(P0, 2), pw0); \
    VRD(4); SBAR(); GAPA(C1 = __builtin_amdgcn_mfma_f32_32x32x16_bf16(kf[1], qr[0], negm, 0, 0, 0), P0[6], P0[7], P0[8], P0[9],     pw0[2] = PKW(P0, 4), pw0[3] = PKW(P0, 6), pw0); \
    VRD(1); SBAR(); GAPA(C0 = __builtin_amdgcn_mfma_f32_32x32x16_bf16(kf[2], qr[1], C0, 0, 0, 0),   P0[10], P0[11], P0[12], P0[13], pw1[0] = PKW(P0, 8), pw1[1] = PKW(P0, 10), pw1); \
    VRD(5); SBAR(); GAPA(C1 = __builtin_amdgcn_mfma_f32_32x32x16_bf16(kf[3], qr[1], C1, 0, 0, 0),   P0[14], P0[15], P1[0], P1[1],   pw1[2] = PKW(P0, 12), pw1[3] = PKW(P0, 14), pw1); \
    VRD(2); SBAR(); GAPA(C0 = __builtin_amdgcn_mfma_f32_32x32x16_bf16(kf[4], qr[2], C0, 0, 0, 0),   P1[2], P1[3], P1[4], P1[5],     pw2[0] = PKW(P1, 0), pw2[1] = PKW(P1, 2), pw2); \
    VRD(6); SBAR(); GAPA(C1 = __builtin_amdgcn_mfma_f32_32x32x16_bf16(kf[5], qr[2], C1, 0, 0, 0),   P1[6], P1[7], P1[8], P1[9],     pw2[2] = PKW(P1, 4), pw2[3] = PKW(P1, 6), pw2); \
    VRD(3); SBAR(); GAPA(C0 = __builtin_amdgcn_mfma_f32_32x32x16_bf16(kf[6], qr[3], C0, 0, 0, 0),   P1[10], P1[11], P1[12], P1[13], pw3[0] = PKW(P1, 8), pw3[1] = PKW(P1, 10), pw3); \
    VRD(7); SBAR(); GAPA(C1 = __builtin_amdgcn_mfma_f32_32x32x16_bf16(kf[7], qr[3], C1, 0, 0, 0),   P1[14], P1[15], 0.f, 0.f,       pw3[2] = PKW(P1, 12), pw3[3] = PKW(P1, 14), pw3); \
    l_reg += sacc; \
    if (GK) { DMA_K((t) + 3, sl_cur); } if (GV) { DMA_V((t) + 1, sl_next); } \
    if (!NOMAX) { float a = MX3(C0[0], C0[1], C1[0]), b = MX3(C0[2], C0[3], C1[1]); a = MX3(a, C1[2], C1[3]); \
      _Pragma("unroll") for (int r = 4; r < 16; r += 4) { a = MX3(a, C0[r], C0[r + 1]); b = MX3(b, C0[r + 2], C0[r + 3]); a = MX3(a, C1[r], C1[r + 1]); b = MX3(b, C1[r + 2], C1[r + 3]); } \
      float rm = __builtin_fmaxf(a, b); { auto rr = __builtin_amdgcn_permlane32_swap(__float_as_uint(rm), __float_as_uint(rm), false, false); rm = __builtin_fmaxf(__uint_as_float(rr[0]), __uint_as_float(rr[1])); } \
      resc = false; \
      if (__builtin_expect(__any(rm > (float)THRL), 0)) { const float dl = __builtin_fmaxf(rm, 0.f); mhat += dl; \
        _Pragma("unroll") for (int r = 0; r < 16; ++r) { C0[r] -= dl; C1[r] -= dl; } \
        _Pragma("unroll") for (int r = 0; r < 16; ++r) negm[r] = -mhat; asm volatile("" : "+v"(negm)); \
        const float f = __builtin_amdgcn_exp2f(-dl); l_reg *= f; if (hi == 0) wsf[r32] = f; resc = true; } } \
    SBAR(); \
    GAPB(o[0] = __builtin_amdgcn_mfma_f32_32x32x16_bf16(PAF(0), VFR(0), o[0], 0, 0, 0), C0, 0); \
    GAPB(o[1] = __builtin_amdgcn_mfma_f32_32x32x16_bf16(PAF(0), VFR(4), o[1], 0, 0, 0), C0, 4); \
    KRD(GL, 0); GAPB(o[0] = __builtin_amdgcn_mfma_f32_32x32x16_bf16(PAF(1), VFR(1), o[0], 0, 0, 0), C0, 8); \
    KRD(GL, 1); GAPB(o[1] = __builtin_amdgcn_mfma_f32_32x32x16_bf16(PAF(1), VFR(5), o[1], 0, 0, 0), C0, 12); \
    KRD(GL, 2); GAPB(o[0] = __builtin_amdgcn_mfma_f32_32x32x16_bf16(PAF(2), VFR(2), o[0], 0, 0, 0), C1, 0); \
    KRD(GL, 3); GAPB(o[1] = __builtin_amdgcn_mfma_f32_32x32x16_bf16(PAF(2), VFR(6), o[1], 0, 0, 0), C1, 4); \
    GAPB(o[0] = __builtin_amdgcn_mfma_f32_32x32x16_bf16(PAF(3), VFR(3), o[0], 0, 0, 0), C1, 8); \
    GAPB(o[1] = __builtin_amdgcn_mfma_f32_32x32x16_bf16(PAF(3), VFR(7), o[1], 0, 0, 0), C1, 12); \
    } while (0)
  int t = 1;
  for (; t + 5 < NT; t += 2) {
    STEP(pB0, pB1, pA0, pA1, t, true, true, true);     WAIT_BAR(2); RESC(); ROT();
    STEP(pA0, pA1, pB0, pB1, t + 1, true, true, true); WAIT_BAR(2); RESC(); ROT();
  }
  #define ENDW(tt) do { if ((tt) + 3 < NT) { WAIT_BAR(2); } else if ((tt) + 2 < NT) { WAIT_BAR(1); } else { WAIT_BAR(0); } } while (0)
  for (; t + 1 < NT; t += 2) {
    STEP(pB0, pB1, pA0, pA1, t, (t + 3 < NT), (t + 1 < NT), (t + 1 < NT));         ENDW(t);     RESC(); ROT();
    STEP(pA0, pA1, pB0, pB1, t + 1, (t + 4 < NT), (t + 2 < NT), (t + 2 < NT));     ENDW(t + 1); RESC(); ROT();
  }
  STEP(pB0, pB1, pA0, pA1, NT - 1, false, false, false); RESC();
  { float sacc = pB0[0] + pB0[1]; _Pragma("unroll") for (int r = 2; r < 16; ++r) sacc += pB0[r]; _Pragma("unroll") for (int r = 0; r < 16; ++r) sacc += pB1[r]; l_reg += sacc;
    pw0 = (u32x4){PKW(pB0, 0), PKW(pB0, 2), PKW(pB0, 4), PKW(pB0, 6)}; pw1 = (u32x4){PKW(pB0, 8), PKW(pB0, 10), PKW(pB0, 12), PKW(pB0, 14)}; pw2 = (u32x4){PKW(pB1, 0), PKW(pB1, 2), PKW(pB1, 4), PKW(pB1, 6)}; pw3 = (u32x4){PKW(pB1, 8), PKW(pB1, 10), PKW(pB1, 12), PKW(pB1, 14)};
    SBAR(); pv(o, vb0 + sl_cur, PAF(0), PAF(1), PAF(2), PAF(3)); }
  #undef PKW
  #undef PAF
  #undef VFR
  #undef PIN
  #undef MX3
  #undef GAPA
  #undef GAPB
  #undef EX
  #undef VRD
  #undef KRD
  #undef STEP
  #undef ENDW
  { auto rr = __builtin_amdgcn_permlane32_swap(__float_as_uint(l_reg), __float_as_uint(l_reg), false, false); l_reg = __uint_as_float(rr[0]) + __uint_as_float(rr[1]); }
  if (hi == 0) wsf[32 + r32] = l_reg; asm volatile("s_waitcnt lgkmcnt(0)" ::: "memory");
  float rli[16];
  #pragma unroll
  for (int r = 0; r < 16; ++r) rli[r] = __builtin_amdgcn_rcpf(wsf[32 + crow(r, hi)]);
  unsigned char* Ow = (unsigned char*)O + (rowbase + q0 + wid * QBLK) * QP + h * D;
  { bf16h* stg = (bf16h*)(shm + LDS_OST) + wid * 2048;
    #pragma unroll
    for (int r = 0; r < 16; ++r) { const int orow = crow(r, hi);
      #pragma unroll
      for (int d0 = 0; d0 < 2; ++d0) stg[orow * 64 + d0 * 32 + r32] = __float2bfloat16(o[d0][r] * rli[r]); }
    asm volatile("s_waitcnt lgkmcnt(0)" ::: "memory");
    #pragma unroll
    for (int i = 0; i < 4; ++i) { const int row = i * 8 + (lane >> 3), ch = lane & 7; const u32x4 v = *(const u32x4*)(stg + row * 64 + ch * 8);
      v2u w8; w8.x = pk4_fp8(sat8(64.0f * bflo(v.x)), sat8(64.0f * bfhi(v.x)), sat8(64.0f * bflo(v.y)), sat8(64.0f * bfhi(v.y))); w8.y = pk4_fp8(sat8(64.0f * bflo(v.z)), sat8(64.0f * bfhi(v.z)), sat8(64.0f * bflo(v.w)), sat8(64.0f * bfhi(v.w)));
      *(v2u*)(Ow + (long)row * QP + ch * 8) = w8; } }
  asm volatile("s_waitcnt lgkmcnt(0)\n\ts_barrier" ::: "memory");
  #undef DMA_K
  #undef DMA_V
  #undef START
  #undef RESC
  #undef ROT
}
#undef SBAR
#undef WAIT_BAR
}

#define XB_TMO      128
#define XB_XCNT(j)  (256  + 64 * (j))
#define XB_XSUB(j)  (1280 + 64 * (j))
#define XB_XGEN(j)  (2304 + 64 * (j))
#define XB_TOP      3328
#define XB_TOPGEN   3392
#define XCD_BAR_WORDS 3456
#define XB_SPIN_CAP (1u << 18)
__device__ __forceinline__ unsigned xb_ld(unsigned* p)              { return __hip_atomic_load(p, __ATOMIC_RELAXED, __HIP_MEMORY_SCOPE_AGENT); }
__device__ __forceinline__ unsigned xb_add(unsigned* p, unsigned v) { return __hip_atomic_fetch_add(p, v, __ATOMIC_RELAXED, __HIP_MEMORY_SCOPE_AGENT); }
__device__ __forceinline__ unsigned xb_xcc_id() { return (unsigned)__builtin_amdgcn_s_getreg((3 << 11) | 20) & 0xFu; }
#define XB_SPIN(cond, bar) do { unsigned _sp = 0; while (cond) { __builtin_amdgcn_s_sleep(1); \
    if ((++_sp & 255u) == 0u) { if (xb_ld(&(bar)[XB_TMO])) break; if (_sp > XB_SPIN_CAP) { atomicAdd(&(bar)[XB_TMO], 1u); break; } } } } while (0)
struct XcdBarrier { unsigned* bar; unsigned x; volatile LAS unsigned* st; int wid; };
__device__ __forceinline__ XcdBarrier xcd_barrier_post(unsigned* bar, volatile LAS unsigned* st, int wid) {
    XcdBarrier b; b.bar = bar; b.x = xb_xcc_id(); b.st = st; b.wid = wid;
    if (my_tid(wid) == 0) (void)xb_add(&bar[XB_XCNT(b.x)], 1u);
    return b;
}
__device__ __forceinline__ void xcd_barrier_complete(unsigned* bar, unsigned x, unsigned& nloc, unsigned& nx) {
    const unsigned G = gridDim.x * gridDim.y * gridDim.z;
    unsigned sum, cnt, mine, sp = 0u;
    for (;;) {
        sum = 0u; cnt = 0u; mine = 0u;
#pragma unroll
        for (unsigned j = 0; j < 16; ++j) { const unsigned c = xb_ld(&bar[XB_XCNT(j)]); sum += c; cnt += (c > 0u) ? 1u : 0u; mine = (j == x) ? c : mine; }
        if (sum == G) break;
        __builtin_amdgcn_s_sleep(1);
        if ((++sp & 255u) == 0u) { if (xb_ld(&bar[XB_TMO])) break; if (sp > XB_SPIN_CAP) { atomicAdd(&bar[XB_TMO], 1u); break; } }
    }
    nloc = mine > 0u ? mine : 1u; nx = cnt > 0u ? cnt : 1u;
}
__device__ __forceinline__ void xcd_barrier(const XcdBarrier& b) {
    asm volatile("s_waitcnt vmcnt(0)" ::: "memory");
    __syncthreads();
    if (my_tid(b.wid) == 0) {
        unsigned* bar = b.bar;
        __builtin_amdgcn_s_waitcnt(0);
        unsigned nloc = b.st[0], nx = b.st[1];
        if (nloc == 0u) { xcd_barrier_complete(bar, b.x, nloc, nx); b.st[0] = nloc; b.st[1] = nx; }
        const unsigned old = xb_add(&bar[XB_XSUB(b.x)], 1u);
        const unsigned gen = old / nloc;
        if (old + 1u == (gen + 1u) * nloc) {
            __builtin_amdgcn_fence(__ATOMIC_RELEASE, "agent");
            asm volatile("s_waitcnt vmcnt(0)" ::: "memory");
            const unsigned og = xb_add(&bar[XB_TOP], 1u);
            const unsigned tg = og / nx;
            if (og + 1u == (tg + 1u) * nx) xb_add(&bar[XB_TOPGEN], 1u);
            else XB_SPIN(xb_ld(&bar[XB_TOPGEN]) == tg, bar);
            __builtin_amdgcn_fence(__ATOMIC_ACQUIRE, "agent");
            xb_add(&bar[XB_XGEN(b.x)], 1u);
            asm volatile("s_waitcnt vmcnt(0)" ::: "memory");
        } else {
            XB_SPIN(xb_ld(&bar[XB_XGEN(b.x)]) == gen, bar);
            __builtin_amdgcn_fence(__ATOMIC_ACQUIRE, "agent");
            asm volatile("s_waitcnt vmcnt(0)" ::: "memory");
        }
    }
    __syncthreads();
}


constexpr int CW_SPLIT = 20000;
__device__ __forceinline__ void split_arrive(unsigned* cnt, int wid) {
    asm volatile("s_waitcnt vmcnt(0)" ::: "memory");
    __syncthreads();
    if (my_tid(wid) == 0) { __builtin_amdgcn_fence(__ATOMIC_RELEASE, "agent"); asm volatile("s_waitcnt vmcnt(0)" ::: "memory"); (void)xb_add(cnt, 1u); }
}
__device__ __forceinline__ void split_wait(unsigned* cnt, unsigned want, unsigned* tmo, int wid) {
    if (my_tid(wid) == 0) { unsigned sp = 0u;
        while (xb_ld(cnt) < want) { __builtin_amdgcn_s_sleep(1); if ((++sp & 255u) == 0u) { if (xb_ld(tmo)) break; if (sp > XB_SPIN_CAP) { atomicAdd(tmo, 1u); break; } } }
        __builtin_amdgcn_fence(__ATOMIC_ACQUIRE, "agent"); asm volatile("s_waitcnt vmcnt(0)" ::: "memory"); }
    __syncthreads();
}

struct cf { float x, y; };
__device__ __forceinline__ float s_add(float a, float b) { float r; asm("v_add_f32_e32 %0, %1, %2" : "=v"(r) : "v"(a), "v"(b)); return r; }
__device__ __forceinline__ float s_sub(float a, float b) { float r; asm("v_sub_f32_e32 %0, %1, %2" : "=v"(r) : "v"(a), "v"(b)); return r; }
__device__ __forceinline__ float s_mul(float a, float b) { float r; asm("v_mul_f32_e32 %0, %1, %2" : "=v"(r) : "v"(a), "v"(b)); return r; }
__device__ __forceinline__ float s_fma(float a, float b, float c) { float r; asm("v_fma_f32 %0, %1, %2, %3" : "=v"(r) : "v"(a), "v"(b), "v"(c)); return r; }
__device__ __forceinline__ float s_fnma(float a, float b, float c) { float r; asm("v_fma_f32 %0, -%1, %2, %3" : "=v"(r) : "v"(a), "v"(b), "v"(c)); return r; }
__device__ __forceinline__ cf cmul(cf a, cf b) { return cf{s_fnma(a.y, b.y, s_mul(a.x, b.x)), s_fma(a.y, b.x, s_mul(a.x, b.y))}; }
#define FIDX(i) ((i) + ((i) >> 4) + (((i) >> 9) << 4))
constexpr int FFT_LDS_BYTES = 143360;
__device__ __forceinline__ void dft4(cf& a, cf& b, cf& c, cf& d) {
    const cf s0{s_add(a.x, c.x), s_add(a.y, c.y)}, s1{s_sub(a.x, c.x), s_sub(a.y, c.y)}, s2{s_add(b.x, d.x), s_add(b.y, d.y)}, s3{s_sub(b.x, d.x), s_sub(b.y, d.y)};
    a = cf{s_add(s0.x, s2.x), s_add(s0.y, s2.y)}; c = cf{s_sub(s0.x, s2.x), s_sub(s0.y, s2.y)};
    b = cf{s_add(s1.x, s3.y), s_sub(s1.y, s3.x)}; d = cf{s_sub(s1.x, s3.y), s_add(s1.y, s3.x)};
}
__device__ __forceinline__ void dft16(cf (&x)[16]) {
#pragma unroll
    for (int m2 = 0; m2 < 4; ++m2) dft4(x[m2], x[4 + m2], x[8 + m2], x[12 + m2]);
    const cf W1{0.92387953251f, -0.38268343236f}, W2{0.70710678118f, -0.70710678118f}, W3{0.38268343236f, -0.92387953251f}, W6{-0.70710678118f, -0.70710678118f}, W9{-0.92387953251f, 0.38268343236f};
    x[5] = cmul(x[5], W1); x[6] = cmul(x[6], W2); x[7] = cmul(x[7], W3);
    x[9] = cmul(x[9], W2); x[10] = cf{x[10].y, -x[10].x}; x[11] = cmul(x[11], W6);
    x[13] = cmul(x[13], W3); x[14] = cmul(x[14], W6); x[15] = cmul(x[15], W9);
#pragma unroll
    for (int q1 = 0; q1 < 4; ++q1) dft4(x[4 * q1], x[4 * q1 + 1], x[4 * q1 + 2], x[4 * q1 + 3]);
}
#define QREG(q) (4 * ((q) & 3) + ((q) >> 2))
template <int OFF> __device__ __forceinline__ void dft16_at(cf (&x)[32]) {
#pragma unroll
    for (int m2 = 0; m2 < 4; ++m2) dft4(x[OFF + m2], x[OFF + 4 + m2], x[OFF + 8 + m2], x[OFF + 12 + m2]);
    const cf W1{0.92387953251f, -0.38268343236f}, W2{0.70710678118f, -0.70710678118f}, W3{0.38268343236f, -0.92387953251f}, W6{-0.70710678118f, -0.70710678118f}, W9{-0.92387953251f, 0.38268343236f};
    x[OFF + 5] = cmul(x[OFF + 5], W1); x[OFF + 6] = cmul(x[OFF + 6], W2); x[OFF + 7] = cmul(x[OFF + 7], W3);
    x[OFF + 9] = cmul(x[OFF + 9], W2); x[OFF + 10] = cf{x[OFF + 10].y, -x[OFF + 10].x}; x[OFF + 11] = cmul(x[OFF + 11], W6);
    x[OFF + 13] = cmul(x[OFF + 13], W3); x[OFF + 14] = cmul(x[OFF + 14], W6); x[OFF + 15] = cmul(x[OFF + 15], W9);
#pragma unroll
    for (int q1 = 0; q1 < 4; ++q1) dft4(x[OFF + 4 * q1], x[OFF + 4 * q1 + 1], x[OFF + 4 * q1 + 2], x[OFF + 4 * q1 + 3]);
}
#define X32I(k) ((((k) & 1) << 4) + QREG((k) >> 1))
template <bool HI_ZERO> __device__ __forceinline__ void dft32(cf (&x)[32]) {
    constexpr float C32[16] = {1.0f, 0.98078528040f, 0.92387953251f, 0.83146961230f, 0.70710678118f, 0.55557023302f, 0.38268343236f, 0.19509032201f, 0.0f, -0.19509032201f, -0.38268343236f, -0.55557023302f, -0.70710678118f, -0.83146961230f, -0.92387953251f, -0.98078528040f};
    constexpr float S32[16] = {0.0f, 0.19509032201f, 0.38268343236f, 0.55557023302f, 0.70710678118f, 0.83146961230f, 0.92387953251f, 0.98078528040f, 1.0f, 0.98078528040f, 0.92387953251f, 0.83146961230f, 0.70710678118f, 0.55557023302f, 0.38268343236f, 0.19509032201f};
#pragma unroll
    for (int n = 0; n < 16; ++n) { cf a, b;
        if (HI_ZERO) { a = x[n]; b = x[n]; } else { a = cf{s_add(x[n].x, x[16 + n].x), s_add(x[n].y, x[16 + n].y)}; b = cf{s_sub(x[n].x, x[16 + n].x), s_sub(x[n].y, x[16 + n].y)}; }
        x[n] = a; x[16 + n] = (n == 0) ? b : cmul(b, cf{C32[n], -S32[n]}); }
    dft16_at<0>(x); dft16_at<16>(x);
}
__device__ __forceinline__ cf twid(int j, int lognb) { const float fr = (float)j * (1.0f / (float)(1 << lognb)); cf w{__builtin_amdgcn_cosf(fr), -__builtin_amdgcn_sinf(fr)};
    asm volatile("s_nop 3" : "+v"(w.x), "+v"(w.y));
    return w; }
__device__ __forceinline__ void twiddle32_fwd(cf (&x)[32], cf w) {
    const cf w2 = cmul(w, w); cf p = w2;
    x[X32I(1)] = cmul(x[X32I(1)], w);
#pragma unroll
    for (int k2 = 1; k2 < 16; ++k2) { x[X32I(2 * k2)] = cmul(x[X32I(2 * k2)], p); const cf po = cmul(p, w); x[X32I(2 * k2 + 1)] = cmul(x[X32I(2 * k2 + 1)], po); if (k2 < 15) p = cmul(p, w2); }
}
__device__ __forceinline__ void twiddle32_inv(cf (&x)[32], cf w) {
    const cf w2 = cmul(w, w); cf p = w2;
    x[0].y = -x[0].y; x[1] = cmul(cf{x[1].x, -x[1].y}, w);
#pragma unroll
    for (int k2 = 1; k2 < 16; ++k2) { x[2 * k2] = cmul(cf{x[2 * k2].x, -x[2 * k2].y}, p); const cf po = cmul(p, w); x[2 * k2 + 1] = cmul(cf{x[2 * k2 + 1].x, -x[2 * k2 + 1].y}, po); if (k2 < 15) p = cmul(p, w2); }
}
__device__ __forceinline__ void ldsA_storeX(LAS f32x2* X, int j, const cf (&x)[32]) {
    LAS f32x2* Xb = X + j + (j >> 4);
#pragma unroll
    for (int q = 0; q < 32; ++q) Xb[560 * q] = (f32x2){x[X32I(q)].x, x[X32I(q)].y};
}
__device__ __forceinline__ void ldsA_load(LAS f32x2* X, int j, cf (&x)[32]) {
    const LAS f32x2* Xb = X + j + (j >> 4);
#pragma unroll
    for (int q = 0; q < 32; ++q) { const f32x2 v = Xb[560 * q]; x[q] = cf{v.x, v.y}; }
}
__device__ __forceinline__ void fft_fwdA(LAS f32x2* X, int tid, int salt) {
    asm volatile("" : "+v"(tid) : "s"(salt) : "memory");
    cf x[32]; ldsA_load(X, tid, x); dft32<false>(x); twiddle32_fwd(x, twid(tid, 14)); ldsA_storeX(X, tid, x);
}
__device__ __forceinline__ void fft_fwdB(LAS f32x2* X, int tid, int salt) {
    asm volatile("" : "+v"(tid) : "s"(salt) : "memory");
    const int j = tid & 15; LAS f32x2* Xb = X + 560 * (tid >> 4) + j; cf x[32];
#pragma unroll
    for (int m = 0; m < 32; ++m) { const f32x2 v = Xb[17 * m]; x[m] = cf{v.x, v.y}; }
    dft32<false>(x); twiddle32_fwd(x, twid(j, 9));
#pragma unroll
    for (int q = 0; q < 32; ++q) Xb[17 * q] = (f32x2){x[X32I(q)].x, x[X32I(q)].y};
}
__device__ __forceinline__ void fft_invB(LAS f32x2* X, int tid, int salt) {
    asm volatile("" : "+v"(tid) : "s"(salt) : "memory");
    const int j = tid & 15; LAS f32x2* Xb = X + 560 * (tid >> 4) + j; cf x[32];
#pragma unroll
    for (int q = 0; q < 32; ++q) { const f32x2 v = Xb[17 * q]; x[q] = cf{v.x, v.y}; }
    twiddle32_inv(x, twid(j, 9)); dft32<false>(x);
#pragma unroll
    for (int m = 0; m < 32; ++m) Xb[17 * m] = (f32x2){x[X32I(m)].x, -x[X32I(m)].y};
}
__device__ __forceinline__ void load_spec(f32x4 (&h)[8], const float* H, int tid, int salt) {
    asm volatile("" : "+v"(tid) : "s"(salt) : "memory");
#pragma unroll
    for (int i = 0; i < 8; ++i) h[i] = *(const f32x4*)(H + 32 * tid + 4 * i);
}
__device__ __forceinline__ void fft_mid(LAS f32x2* X, const f32x4 (&h0)[8], const float* H, int tid, int salt) {
    asm volatile("" : "+v"(tid) : "s"(salt) : "memory");
    f32x4 h1[8];
#pragma unroll
    for (int i = 0; i < 8; ++i) h1[i] = *(const f32x4*)(H + 32 * (tid + 512) + 4 * i);
#pragma unroll
    for (int k = 0; k < 2; ++k) { const int u = tid + 512 * k; const int p = FIDX(16 * u); cf x[16];
#pragma unroll
        for (int m = 0; m < 16; ++m) { const f32x2 v = X[p + m]; x[m] = cf{v.x, v.y}; }
        dft16(x);
        cf y[16];
#pragma unroll
        for (int q = 0; q < 16; ++q) { const f32x4 hv = k == 0 ? h0[q >> 1] : h1[q >> 1]; const cf hq = (q & 1) ? cf{hv[2], hv[3]} : cf{hv[0], hv[1]}; const cf z = cmul(x[QREG(q)], hq); y[q] = cf{z.x, -z.y}; }
        dft16(y);
#pragma unroll
        for (int m = 0; m < 16; ++m) X[p + m] = (f32x2){y[QREG(m)].x, -y[QREG(m)].y}; }
}
__device__ __forceinline__ void fft_last_store(LAS f32x2* X, float* H, int tid, int salt) {
    asm volatile("" : "+v"(tid) : "s"(salt) : "memory");
    const float sc = 1.0f / 16384.0f;
#pragma unroll 1
    for (int k = 0; k < 2; ++k) { const int u = tid + 512 * k; const int p = FIDX(16 * u); cf x[16];
#pragma unroll
        for (int m = 0; m < 16; ++m) { const f32x2 v = X[p + m]; x[m] = cf{v.x, v.y}; }
        dft16(x);
#pragma unroll
        for (int i = 0; i < 8; ++i) *(f32x4*)(H + 32 * u + 4 * i) = (f32x4){x[QREG(2 * i)].x * sc, x[QREG(2 * i)].y * sc, x[QREG(2 * i + 1)].x * sc, x[QREG(2 * i + 1)].y * sc}; }
}

__device__ __forceinline__ void block_sum2(float& a, float& b, LAS float* red, int tid) {
    a = wave_sum(a); b = wave_sum(b);
    __syncthreads();
    if ((tid & 63) == 0) { red[(tid >> 6) * 2] = a; red[(tid >> 6) * 2 + 1] = b; }
    __syncthreads();
    float sa = 0.f, sb = 0.f;
#pragma unroll
    for (int w = 0; w < 8; ++w) { sa += red[2 * w]; sb += red[2 * w + 1]; }
    a = sa; b = sb;
}

struct HfRaw { float f[16], b[16]; };
__device__ __forceinline__ void hfft_load(HfRaw& r, const float* hraw, int id, int tid, int salt) {
    asm volatile("" : "+v"(tid) : "s"(salt) : "memory");
    const int o = id >> 9, c = id & 511;
    const float* hf = hraw + (size_t)((o * 2 + 0) * HYW + c) * SEQ; const float* hb = hraw + (size_t)((o * 2 + 1) * HYW + c) * SEQ;
#pragma unroll
    for (int m = 0; m < 16; ++m) { r.f[m] = hf[tid + 512 * m]; const int tb = 8192 - tid - 512 * m; r.b[m] = hb[tb < SEQ ? tb : 0]; }
}
__device__ __forceinline__ void hfft_run(const HfRaw& r, float* Hout, int id, LAS unsigned char* lds, int tid, int salt) {
    asm volatile("" : "+v"(tid) : "s"(salt) : "memory");
    LAS f32x2* X = (LAS f32x2*)lds; LAS float* red = (LAS float*)(lds + FFT_LDS_BYTES);
    const int c = id & 511;
    const float mind = 4.605170185988091f / 1.5f, maxd = 4.605170185988091f / 0.3f;
    const float ad = mind + (float)c * ((maxd - mind) / 511.0f);
    float vf[16], vb[16]; float sf = 0.f, sb = 0.f;
#pragma unroll
    for (int m = 0; m < 16; ++m) { const int t = tid + 512 * m, tb = 8192 - tid - 512 * m;
        vf[m] = r.f[m] * expf(-((float)t * (1.0f / 8191.0f)) * ad); vb[m] = (tb < SEQ) ? r.b[m] * expf(-((float)tb * (1.0f / 8191.0f)) * ad) : 0.f; sf += fabsf(vf[m]); sb += fabsf(vb[m]); }
    if (tid == 0) sb += fabsf(r.b[0] * 1.0f);
    block_sum2(sf, sb, red, tid);
    const float nf = 1.0f / (sf + EPSV), nb = 1.0f / (sb + EPSV);
    cf x[32];
#pragma unroll
    for (int m = 0; m < 16; ++m) { x[m] = cf{vf[m] * nf, 0.f}; x[16 + m] = cf{vb[m] * nb, 0.f}; }
    if (tid == 0) x[0].x += r.b[0] * nb;
    dft32<false>(x); twiddle32_fwd(x, twid(tid, 14)); ldsA_storeX(X, tid, x);
    __syncthreads();
    fft_fwdB(X, tid, salt); __syncthreads();
    fft_last_store(X, Hout + (size_t)id * 32768, tid, salt);
    __syncthreads();
}

__device__ __forceinline__ void zc_tile(const Args& P, int tile, LAS unsigned char* lds, int tid) {
    const int salt = tile;
    asm volatile("" : "+v"(tid) : "s"(salt) : "memory");
    const int cb = tile % 24, jb = (tile / 24) & 31, p = tile / (24 * 32);
    const bf16* z = (const bf16*)(P.ws + WS_ZHY); bf16* zc = (bf16*)(P.ws + WS_ZC);
    v4u sv[9];
#pragma unroll
    for (int it = 0; it < 9; ++it) { const int row = it * 64 + (tid >> 3), ch8 = tid & 7; const int bt = row / 288, rr = row % 288, m = rr / 18, r = rr % 18;
        const int t = 512 * m + 16 * jb - 1 + r; const int tc = t < 0 ? 0 : (t >= SEQ ? SEQ - 1 : t);
        sv[it] = *(const v4u*)(z + ((size_t)((2 * p + bt) * SEQ + tc)) * HYIN + 64 * cb + 8 * ch8); }
#pragma unroll
    for (int it = 0; it < 9; ++it) { const int row = it * 64 + (tid >> 3), ch8 = tid & 7; const int rr = row % 288, m = rr / 18, r = rr % 18;
        const int t = 512 * m + 16 * jb - 1 + r; v4u v = sv[it]; if (t < 0 || t >= SEQ) v = (v4u){0u, 0u, 0u, 0u};
        LAS v2u* d = (LAS v2u*)(lds + row * 136 + ch8 * 16); d[0] = (v2u){v.x, v.y}; d[1] = (v2u){v.z, v.w}; }
    __syncthreads();
    const int lane = tid & 63, wave = tid >> 6; const int jl = lane & 15, bt = (lane >> 4) & 1, csub = lane >> 5;
    const float* sw = P.in[8]; const float* sb = P.in[9];
#pragma unroll 1
    for (int it = 0; it < 4; ++it) { const int cl = 2 * (wave + 8 * it) + csub; const int ch = 64 * cb + cl; const int pos = cl;
        const float w0 = sw[ch], w1 = sw[HYIN + ch], w2 = sw[2 * HYIN + ch], bs = sb[ch];
        const LAS bf16* base = (const LAS bf16*)(lds + (bt * 288 + jl) * 136) + pos;
        unsigned o[8];
#pragma unroll
        for (int m = 0; m < 16; m += 2) { float r0, r1;
            { const LAS bf16* q = base + m * 18 * 68; r0 = bs + w0 * bf2f(q[0]) + w1 * bf2f(q[68]) + w2 * bf2f(q[136]); }
            { const LAS bf16* q = base + (m + 1) * 18 * 68; r1 = bs + w0 * bf2f(q[0]) + w1 * bf2f(q[68]) + w2 * bf2f(q[136]); }
            o[m >> 1] = pk2(r0, r1); }
        const int s = ch >> 9, c = ch & 511;
        bf16* dst = zc + ((size_t)((p * 3 + s) * HYW + c)) * 16384 + (16 * jb + jl) * 32 + bt * 16;
        *(v4u*)dst = (v4u){o[0], o[1], o[2], o[3]}; *(v4u*)(dst + 8) = (v4u){o[4], o[5], o[6], o[7]}; }
    __syncthreads();
}

#define UNPK(V, m) (((m) & 1) ? bfhi(V[(m) >> 3][((m) >> 1) & 3]) : bflo(V[(m) >> 3][((m) >> 1) & 3]))
__device__ __forceinline__ void hyena_item(const Args& P, int c, int p, float* y1s, LAS unsigned char* lds, int tid, int salt) {
    asm volatile("" : "+v"(tid) : "s"(salt) : "memory");
    LAS f32x2* X = (LAS f32x2*)lds;
    const bf16* zc = (const bf16*)(P.ws + WS_ZC); const float* Hs = (const float*)P.out; unsigned char* yhy = P.ws + WS_YHY;
    const float* fbp = P.in[18]; const float fb0 = fbp[c], fb1 = fbp[HYW + c];
    const int j = tid;
    const v4u* srcv = (const v4u*)(zc + ((size_t)((p * 3 + 0) * HYW + c)) * 16384 + j * 32);
    f32x4 hsp[8]; const float* Hcur = Hs + (size_t)(0 * HYW + c) * 32768;
    { v4u vp[4];
#pragma unroll
    for (int i = 0; i < 4; ++i) vp[i] = srcv[i];
    load_spec(hsp, Hcur, tid, salt);
    cf x[32];
#pragma unroll
      for (int m = 0; m < 16; ++m) { x[m] = cf{UNPK(vp, m), UNPK(vp, 16 + m)}; x[16 + m] = cf{0.f, 0.f}; }
      dft32<true>(x); twiddle32_fwd(x, twid(j, 14)); ldsA_storeX(X, j, x); }
    __syncthreads();
    fft_fwdB(X, tid, salt); __syncthreads();
    fft_mid(X, hsp, Hcur, tid, salt); __syncthreads();
    v4u gp[4], vp[4];
    { int jj = tid; asm volatile("" : "+v"(jj) : "s"(salt) : "memory"); const v4u* srcg1 = (const v4u*)(zc + ((size_t)((p * 3 + 1) * HYW + c)) * 16384 + jj * 32);
      const v4u* srcv2 = (const v4u*)(zc + ((size_t)((p * 3 + 0) * HYW + c)) * 16384 + jj * 32);
#pragma unroll
      for (int i = 0; i < 4; ++i) { gp[i] = srcg1[i]; vp[i] = srcv2[i]; } }
    fft_invB(X, tid, salt); __syncthreads();
    { int j1 = j; asm volatile("" : "+v"(j1) : "s"(salt) : "memory");
      cf x[32]; ldsA_load(X, j1, x); twiddle32_inv(x, twid(j1, 14)); dft32<false>(x);
      cf y1[16];
#pragma unroll
      for (int m = 0; m < 16; ++m) { const float ra = x[X32I(m)].x, rb = -x[X32I(m)].y; y1[m] = cf{UNPK(gp, m) * (ra + fb0 * UNPK(vp, m)), UNPK(gp, 16 + m) * (rb + fb0 * UNPK(vp, 16 + m))}; }
#pragma unroll
      for (int m = 0; m < 16; ++m) { x[m] = y1[m]; x[16 + m] = cf{0.f, 0.f}; }
#pragma unroll
      for (int m = 0; m < 16; m += 2) *(f32x4*)(y1s + j1 * 32 + 2 * m) = (f32x4){y1[m].x, y1[m].y, y1[m + 1].x, y1[m + 1].y};
      int j2 = j; asm volatile("" : "+v"(j2) : "s"(salt) : "memory");
      dft32<true>(x); twiddle32_fwd(x, twid(j2, 14)); ldsA_storeX(X, j2, x); }
    __syncthreads();
    Hcur = Hs + (size_t)(1 * HYW + c) * 32768; load_spec(hsp, Hcur, tid, salt);
    fft_fwdB(X, tid, salt); __syncthreads();
    fft_mid(X, hsp, Hcur, tid, salt); __syncthreads();
    f32x4 yv[8];
    { int jj = tid; asm volatile("" : "+v"(jj) : "s"(salt) : "memory"); const v4u* srcg2 = (const v4u*)(zc + ((size_t)((p * 3 + 2) * HYW + c)) * 16384 + jj * 32);
#pragma unroll
      for (int i = 0; i < 4; ++i) gp[i] = srcg2[i];
#pragma unroll
      for (int i = 0; i < 8; ++i) yv[i] = *(const f32x4*)(y1s + jj * 32 + 4 * i); }
    fft_invB(X, tid, salt); __syncthreads();
    { int j3 = j; asm volatile("" : "+v"(j3) : "s"(salt) : "memory");
      cf x[32]; ldsA_load(X, j3, x); twiddle32_inv(x, twid(j3, 14)); dft32<false>(x);
      unsigned char* ya = yhy + ((size_t)(2 * p) * SEQ + j3) * HYW + c; unsigned char* yb = yhy + ((size_t)(2 * p + 1) * SEQ + j3) * HYW + c;
#pragma unroll
      for (int m = 0; m < 16; ++m) { const float ra = x[X32I(m)].x, rb = -x[X32I(m)].y;
          ya[(size_t)512 * m * HYW] = f2fp8(64.0f * UNPK(gp, m) * (ra + fb1 * yv[m >> 1][2 * (m & 1)]));
          yb[(size_t)512 * m * HYW] = f2fp8(64.0f * UNPK(gp, 16 + m) * (rb + fb1 * yv[m >> 1][2 * (m & 1) + 1])); } }
    __syncthreads();
}
#undef UNPK

template <class MapT>
__device__ __forceinline__ void conv_tile(const float* W, int K, int N, bf16* WT, const MapT& map, int tile, int wave, int lane) {
    const int nblk = N / 256, kb = tile / nblk, nb = tile % nblk, k0 = 128 * kb + 16 * wave, n0 = 256 * nb + 4 * lane;
    f32x4 v[16];
    const float* src = W + (size_t)k0 * N + n0;
#pragma unroll
    for (int i = 0; i < 16; ++i) v[i] = *(const f32x4*)(src + (size_t)i * N);
#pragma unroll
    for (int e = 0; e < 4; ++e) { v4u lo, hi;
        lo.x = pk2(v[0][e], v[1][e]); lo.y = pk2(v[2][e], v[3][e]); lo.z = pk2(v[4][e], v[5][e]); lo.w = pk2(v[6][e], v[7][e]);
        hi.x = pk2(v[8][e], v[9][e]); hi.y = pk2(v[10][e], v[11][e]); hi.z = pk2(v[12][e], v[13][e]); hi.w = pk2(v[14][e], v[15][e]);
        bf16* dst = WT + (size_t)map(n0 + e) * K + k0; *(v4u*)dst = lo; *(v4u*)(dst + 8) = hi; }
}
template <class MapT>
__device__ __forceinline__ void conv_tile8(const float* W, int K, int N, unsigned char* WT, const MapT& map, int tile, int wave, int lane, float scale) {
    const int nblk = N / 256, kb = tile / nblk, nb = tile % nblk, k0 = 128 * kb + 16 * wave, n0 = 256 * nb + 4 * lane;
    f32x4 v[16];
    const float* src = W + (size_t)k0 * N + n0;
#pragma unroll
    for (int i = 0; i < 16; ++i) v[i] = *(const f32x4*)(src + (size_t)i * N) * scale;
#pragma unroll
    for (int e = 0; e < 4; ++e) { v4u o;
        o.x = pk4_fp8(v[0][e], v[1][e], v[2][e], v[3][e]); o.y = pk4_fp8(v[4][e], v[5][e], v[6][e], v[7][e]); o.z = pk4_fp8(v[8][e], v[9][e], v[10][e], v[11][e]); o.w = pk4_fp8(v[12][e], v[13][e], v[14][e], v[15][e]);
        *(v4u*)(WT + (size_t)map(n0 + e) * K + k0) = o; }
}
struct MapWin { __device__ __forceinline__ int operator()(int n) const {
    if (n < 1536) return (n & ~31) | pinv32(n & 31);
    if (n < 2304) { const int t0 = 1536 + ((n - 1536) & ~255), cc = (n - 1536) & 255, hp = cc >> 6, d = cc & 63; return t0 + 128 * (d >> 5) + 32 * hp + (d & 31); }
    return (n & ~31) | pinv32(n & 31); } };
struct MapPerm { int off; __device__ __forceinline__ int operator()(int n) const { return off + ((n & ~31) | pinv32(n & 31)); } };
struct MapNat { __device__ __forceinline__ int operator()(int n) const { return n; } };
struct MapGU { int off; __device__ __forceinline__ int operator()(int f) const { return off + (f >> 7) * 256 + (((f & 127) & ~31) | pinv32(f & 31)); } };

__device__ __forceinline__ void phase_mod(const Args& P, LAS unsigned char* lds, int G, int tid) {
    LAS float* sc = (LAS float*)lds; LAS float* red = sc + 4096;
    asm volatile("" : "+v"(tid) :: "memory");
    const float* c = P.in[1]; const float* w_ada = P.in[2]; const float* b_ada = P.in[3];
    for (int i = tid; i < 4096; i += 512) { const float v = c[i]; sc[i] = v / (1.0f + expf(-v)); }
    __syncthreads();
    float* mod = (float*)(P.ws + WS_MOD);
    for (int cb = blockIdx.x; cb < 256; cb += G) {
        const int col0 = cb * 24, ks = tid / 24, col = tid % 24;
        float a0 = 0.f, a1 = 0.f, a2 = 0.f, a3 = 0.f;
        if (tid < 504) {
#pragma unroll 7
            for (int k = ks; k < 1024; k += 21) { const float w = w_ada[(size_t)k * 6144 + col0 + col]; a0 += sc[k] * w; a1 += sc[1024 + k] * w; a2 += sc[2048 + k] * w; a3 += sc[3072 + k] * w; }
            red[(ks * 24 + col) * 4 + 0] = a0; red[(ks * 24 + col) * 4 + 1] = a1; red[(ks * 24 + col) * 4 + 2] = a2; red[(ks * 24 + col) * 4 + 3] = a3; }
        __syncthreads();
        if (tid < 96) { const int b = tid / 24, cc = tid % 24; float s = 0.f; for (int q = 0; q < 21; ++q) s += red[(q * 24 + cc) * 4 + b]; mod[b * 6144 + col0 + cc] = s + b_ada[col0 + cc]; }
        __syncthreads();
    }
}

__device__ __forceinline__ void hraw_item(const Args& P, int item, LAS unsigned char* lds, int tid) {
    asm volatile("" : "+v"(tid) :: "memory");
    LAS float* ha = (LAS float*)lds;
    LAS float* hb = ha + 64 * 65;
    LAS float* wl1 = hb + 64 * 65;
    LAS float* wl2 = wl1 + 33 * 64;
    LAS float* wl3 = wl2 + 64 * 64;
    LAS float* hT = wl3 + 64 * 64;
    const int tb = item >> 1, half = item & 1, t0 = tb * 64;
    const float* b1 = P.in[11]; const float* b2 = P.in[13]; const float* b3 = P.in[15]; const float* w4 = P.in[16]; const float* fq = P.in[17];
    { f32x4 a1 = (f32x4){0.f, 0.f, 0.f, 0.f}, a1b = a1, a2[2], a3[2];
      a1 = *(const f32x4*)(P.in[10] + 4 * tid); if (tid < 16) a1b = *(const f32x4*)(P.in[10] + 4 * (tid + 512));
#pragma unroll
      for (int q = 0; q < 2; ++q) { a2[q] = *(const f32x4*)(P.in[12] + 4 * (tid + 512 * q)); a3[q] = *(const f32x4*)(P.in[14] + 4 * (tid + 512 * q)); }
      *(LAS f32x4*)(wl1 + 4 * tid) = a1; if (tid < 16) *(LAS f32x4*)(wl1 + 4 * (tid + 512)) = a1b;
#pragma unroll
      for (int q = 0; q < 2; ++q) { *(LAS f32x4*)(wl2 + 4 * (tid + 512 * q)) = a2[q]; *(LAS f32x4*)(wl3 + 4 * (tid + 512 * q)) = a3[q]; } }
    const int r = tid >> 3, js = tid & 7;
    { const int t = t0 + r;
        if (js == 0) hb[r * 65] = (float)t * (1.0f / 8191.0f);
        const float wv = 6.283185307179586f * (float)t * (1.0f / 8192.0f);
#pragma unroll
        for (int q = 0; q < 2; ++q) { const int kk = js * 2 + q; const float f = 1e-4f + (float)kk * ((15.0f - 1e-4f) / 15.0f); const float a = f * wv; hb[r * 65 + 1 + kk] = cosf(a); hb[r * 65 + 17 + kk] = -sinf(a); }
    }
    __syncthreads();
#define MLP_LAYER(SRC, W, BI, FO, NIN, STORE) do { float s_[8]; \
        _Pragma("unroll") for (int q = 0; q < 8; ++q) s_[q] = (BI)[js * 8 + q]; \
        _Pragma("unroll 4") for (int i = 0; i < (NIN); ++i) { const float hv = (SRC)[r * 65 + i]; const f32x4 wa = *(const LAS f32x4*)((W) + i * 64 + js * 8), wb = *(const LAS f32x4*)((W) + i * 64 + js * 8 + 4); \
            s_[0] += hv * wa.x; s_[1] += hv * wa.y; s_[2] += hv * wa.z; s_[3] += hv * wa.w; s_[4] += hv * wb.x; s_[5] += hv * wb.y; s_[6] += hv * wb.z; s_[7] += hv * wb.w; } \
        _Pragma("unroll") for (int q = 0; q < 8; ++q) { const float o_ = sinf((FO)[js * 8 + q] * s_[q]); STORE; } } while (0)
    MLP_LAYER(hb, wl1, b1, fq, 33, ha[r * 65 + js * 8 + q] = o_);
    __syncthreads();
    MLP_LAYER(ha, wl2, b2, fq + 64, 64, hb[r * 65 + js * 8 + q] = o_);
    __syncthreads();
    MLP_LAYER(hb, wl3, b3, fq + 128, 64, hT[(js * 8 + q) * 64 + r] = o_);
    __syncthreads();
#undef MLP_LAYER
    float* hraw = (float*)(P.ws + WS_HRAW);
    { const int tg = tid >> 6, ig = tid & 63;
#pragma unroll 1
      for (int hh = 0; hh < 2; ++hh) { const int idx0 = half * 1024 + hh * 512 + 8 * ig;
        f32x4 acc[8][2];
#pragma unroll
        for (int i = 0; i < 8; ++i) { acc[i][0] = (f32x4){0.f, 0.f, 0.f, 0.f}; acc[i][1] = (f32x4){0.f, 0.f, 0.f, 0.f}; }
        f32x4 wa[4][2], wb[4][2];
#define HR_LOAD(W, JB) do { _Pragma("unroll") for (int u_ = 0; u_ < 4; ++u_) { W[u_][0] = *(const f32x4*)(w4 + (size_t)((JB) * 4 + u_) * 2048 + idx0); W[u_][1] = *(const f32x4*)(w4 + (size_t)((JB) * 4 + u_) * 2048 + idx0 + 4); } } while (0)
#define HR_COMP(W, JB) do { _Pragma("unroll") for (int u_ = 0; u_ < 4; ++u_) { const int j = (JB) * 4 + u_; const f32x4 h0 = *(const LAS f32x4*)(hT + j * 64 + 8 * tg), h1 = *(const LAS f32x4*)(hT + j * 64 + 8 * tg + 4); const f32x4 w0 = W[u_][0], w1 = W[u_][1]; \
            acc[0][0] += w0 * h0.x; acc[1][0] += w0 * h0.y; acc[2][0] += w0 * h0.z; acc[3][0] += w0 * h0.w; acc[4][0] += w0 * h1.x; acc[5][0] += w0 * h1.y; acc[6][0] += w0 * h1.z; acc[7][0] += w0 * h1.w; \
            acc[0][1] += w1 * h0.x; acc[1][1] += w1 * h0.y; acc[2][1] += w1 * h0.z; acc[3][1] += w1 * h0.w; acc[4][1] += w1 * h1.x; acc[5][1] += w1 * h1.y; acc[6][1] += w1 * h1.z; acc[7][1] += w1 * h1.w; } } while (0)
        HR_LOAD(wa, 0);
#pragma unroll 1
        for (int jb = 0; jb < 16; jb += 2) { HR_LOAD(wb, jb + 1); HR_COMP(wa, jb); if (jb + 2 < 16) HR_LOAD(wa, jb + 2); HR_COMP(wb, jb + 1); }
#undef HR_LOAD
#undef HR_COMP
#pragma unroll
        for (int q = 0; q < 2; ++q)
#pragma unroll
            for (int e = 0; e < 4; ++e) { float* o = hraw + (size_t)(idx0 + 4 * q + e) * SEQ + t0 + 8 * tg;
                *(f32x4*)o = (f32x4){acc[0][q][e], acc[1][q][e], acc[2][q][e], acc[3][q][e]}; *(f32x4*)(o + 4) = (f32x4){acc[4][q][e], acc[5][q][e], acc[6][q][e], acc[7][q][e]}; } } }
    __syncthreads();
}

__device__ __forceinline__ void phase_prep(const Args& P, LAS unsigned char* lds, int vcu, int G, int tid_, unsigned* modcnt, unsigned* tmo, int wid) {
    asm volatile("" : "+v"(tid_) :: "memory");
    const int tid = tid_, lane = tid & 63, wave = __builtin_amdgcn_readfirstlane(tid >> 6);
    const int gw = vcu * NWAVES + wave, NGW = G * NWAVES;
    for (int it = vcu; it < 256; it += G) hraw_item(P, it, lds, tid);
    { constexpr int T_IN = 8 * 17, T_HY = 4 * 4, T_AT = 4 * 4, T_O = 8 * 4;
      for (int it = vcu; it < T_IN + T_HY + T_AT + T_O; it += G) { int r = it;
          if (r < T_IN) { conv_tile8(P.in[6], DM, INW, P.ws + WS_WIN, MapWin{}, r, wave, lane, 32.0f); continue; } r -= T_IN;
          if (r < T_HY) { conv_tile8(P.in[21], HYW, DM, P.ws + WS_WHY, MapPerm{0}, r, wave, lane, 32.0f); continue; } r -= T_HY;
          if (r < T_AT) { conv_tile8(P.in[22], ATTW, DM, P.ws + WS_WAT, MapPerm{0}, r, wave, lane, 32.0f); continue; } r -= T_AT;
          conv_tile8(P.in[23], DM, DM, P.ws + WS_WO, MapNat{}, r, wave, lane, 32.0f); } }
    { float* cs = (float*)(P.ws + WS_ROPE); const int i = vcu * 512 + tid;
      for (int q = i; q < 128 * 16; q += G * 512) { const int pos = q >> 4, k = q & 15; const float inv = powf(10000.0f, -(float)k * (1.0f / 16.0f)); const float a = (float)pos * inv; cs[pos * 32 + k] = cosf(a); cs[pos * 32 + 16 + k] = sinf(a); }
      float* bp = (float*)(P.ws + WS_BPERM); const float* b_in = P.in[7]; MapWin mw;
      for (int n = (G * 512 - 1) - i; n < INW; n += G * 512) bp[mw(n)] = b_in[n]; }
    split_wait(modcnt, (unsigned)G, tmo, wid);
    const float* x = P.in[0]; const float* gmix = P.in[4]; const float* mod = (const float*)(P.ws + WS_MOD); unsigned char* hn = P.ws + WS_HN;
    f32x4 gg[4], shv[4]; int curb = -1;
    f32x4 v[2][4], vn[2][4];
#define HN_LOAD(V, M0) do { _Pragma("unroll") for (int r = 0; r < 2; ++r) { const int mm_ = ((M0) + r * NGW < MTOK) ? (M0) + r * NGW : (M0); const f32x4* xr = (const f32x4*)(x + (size_t)mm_ * DM) + lane; \
        _Pragma("unroll") for (int j = 0; j < 4; ++j) V[r][j] = xr[64 * j]; } } while (0)
    if (gw < MTOK) HN_LOAD(v, gw);
    for (int m0 = gw; m0 < MTOK; m0 += 2 * NGW) { int mr[2]; mr[0] = m0; mr[1] = (m0 + NGW < MTOK) ? m0 + NGW : m0;
        const int mnext = m0 + 2 * NGW;
        if (mnext < MTOK) HN_LOAD(vn, mnext);
        float s[2] = {0.f, 0.f};
#pragma unroll
        for (int r = 0; r < 2; ++r) {
#pragma unroll
            for (int j = 0; j < 4; ++j) s[r] += (v[r][j].x * v[r][j].x + v[r][j].y * v[r][j].y) + (v[r][j].z * v[r][j].z + v[r][j].w * v[r][j].w); }
#pragma unroll
        for (int r = 0; r < 2; ++r) { const int m = mr[r], b = m >> 13;
            if (b != curb) { curb = b;
#pragma unroll
                for (int j = 0; j < 4; ++j) { const int col = 4 * lane + 256 * j; gg[j] = *(const f32x4*)(gmix + col) * (*(const f32x4*)(mod + b * 6144 + 1024 + col) + 1.0f); shv[j] = *(const f32x4*)(mod + b * 6144 + col); } }
            const float rstd = 1.0f / sqrtf(wave_sum(s[r]) * (1.0f / DM) + EPSV);
            unsigned* o4 = (unsigned*)(hn + (size_t)m * DM) + lane;
#pragma unroll
            for (int j = 0; j < 4; ++j) { const f32x4 h = v[r][j] * rstd * gg[j] + shv[j]; o4[64 * j] = pk4_fp8(h.x, h.y, h.z, h.w); } }
#pragma unroll
        for (int r = 0; r < 2; ++r)
#pragma unroll
            for (int j = 0; j < 4; ++j) v[r][j] = vn[r][j]; }
#undef HN_LOAD
}

__device__ __forceinline__ void xconv_load(const Args& P, int wt, int lane, f32x4 (&v)[16]) {
    const int it = wt >> 3, sl = wt & 7, e = it / 192, r0 = it % 192, kind = r0 >> 6, r = r0 & 63;
    const float* W = (kind == 0 ? P.in[25] : kind == 1 ? P.in[26] : P.in[27]) + (size_t)e * DM * DFF;
    const int N = kind == 2 ? DM : DFF;
    const int kb = kind == 2 ? (r >> 2) : (r >> 3), nb = kind == 2 ? (r & 3) : (r & 7);
    const float* src = W + (size_t)(128 * kb + 16 * sl) * N + 256 * nb + 4 * lane;
#pragma unroll
    for (int i = 0; i < 16; ++i) v[i] = *(const f32x4*)(src + (size_t)i * N);
}
__device__ __forceinline__ void xconv_store(const Args& P, int wt, int lane, f32x4 (&v)[16]) {
    const int it = wt >> 3, sl = wt & 7, e = it / 192, r0 = it % 192, kind = r0 >> 6, r = r0 & 63;
    const int K = kind == 2 ? DFF : DM;
    const int kb = kind == 2 ? (r >> 2) : (r >> 3), nb = kind == 2 ? (r & 3) : (r & 7);
    const int k0 = 128 * kb + 16 * sl, n0 = 256 * nb + 4 * lane;
    unsigned char* WT = P.ws + (kind == 2 ? WS_WD : WS_WGU);
    const int rbase = kind == 2 ? e * 1024 : e * 4096 + kind * 128;
#pragma unroll
    for (int c = 0; c < 4; ++c) { const int n = n0 + c; const int pr = (n & ~31) | pinv32(n & 31);
        const int row = rbase + (kind == 2 ? pr : (n >> 7) * 256 + (pr & 127));
        v4u o;
        o.x = pk4_fp8(v[0][c] * 32.0f, v[1][c] * 32.0f, v[2][c] * 32.0f, v[3][c] * 32.0f); o.y = pk4_fp8(v[4][c] * 32.0f, v[5][c] * 32.0f, v[6][c] * 32.0f, v[7][c] * 32.0f);
        o.z = pk4_fp8(v[8][c] * 32.0f, v[9][c] * 32.0f, v[10][c] * 32.0f, v[11][c] * 32.0f); o.w = pk4_fp8(v[12][c] * 32.0f, v[13][c] * 32.0f, v[14][c] * 32.0f, v[15][c] * 32.0f);
        *(v4u*)(WT + (size_t)row * K + k0) = o; }
}
__device__ __forceinline__ void expert_conv(const Args& P, int t0, int st, int n, int tid) {
    asm volatile("" : "+v"(tid) :: "memory");
    const int lane = tid & 63, wave = __builtin_amdgcn_readfirstlane(tid >> 6);
    if (n <= 0) return;
    f32x4 a[16], b[16];
    xconv_load(P, 8 * t0 + wave, lane, a);
    for (int i = 0; i < n; i += 2) { const int i1 = i + 1 < n ? i + 1 : n - 1, i2 = i + 2 < n ? i + 2 : n - 1;
        xconv_load(P, 8 * (t0 + st * i1) + wave, lane, b);
        xconv_store(P, 8 * (t0 + st * i) + wave, lane, a);
        xconv_load(P, 8 * (t0 + st * i2) + wave, lane, a);
        xconv_store(P, 8 * (t0 + st * i1) + wave, lane, b); }
}

__device__ __forceinline__ void phase_norm2(const Args& P, LAS unsigned char* lds, int vcu, int G, int tid_, bool fuse, int n_fused_wt) {
    asm volatile("" : "+v"(tid_) :: "memory");
    const int tid = tid_, lane = tid & 63, wave = __builtin_amdgcn_readfirstlane(tid >> 6);
    const int gw = vcu * NWAVES + wave, NGW = G * NWAVES;
    LAS float* wrt = (LAS float*)lds;
    const float* w_router = P.in[24];
    { f32x4 wv[8];
#pragma unroll
      for (int q = 0; q < 8; ++q) wv[q] = *(const f32x4*)(w_router + 4 * (tid + 512 * q));
#pragma unroll
      for (int q = 0; q < 8; ++q) { const int i = 4 * (tid + 512 * q), k = i >> 4, e = i & 15; wrt[e * DM + k] = wv[q].x; wrt[(e + 1) * DM + k] = wv[q].y; wrt[(e + 2) * DM + k] = wv[q].z; wrt[(e + 3) * DM + k] = wv[q].w; } }
    __syncthreads();
    const float* x1 = P.out; const float* gffn = P.in[5]; const float* mod = (const float*)(P.ws + WS_MOD); const float* rowsq = (const float*)(P.ws + WS_ROWSQ);
    unsigned char* h2 = P.ws + WS_H2; float* aff = (float*)(P.ws + WS_AFF);
    f32x4 gg[4], shv[4]; int curb = -1;
    f32x4 v[2][4], vn[2][4]; float s[2], sn[2];
#define N2_LOAD(V, SV, M0) do { _Pragma("unroll") for (int r = 0; r < 2; ++r) { const int mm_ = ((M0) + r * NGW < MTOK) ? (M0) + r * NGW : (M0); const f32x4* xr = (const f32x4*)(x1 + (size_t)mm_ * DM) + lane; \
        _Pragma("unroll") for (int j = 0; j < 4; ++j) V[r][j] = xr[64 * j]; SV[r] = lane < 16 ? rowsq[(size_t)mm_ * 16 + lane] : 0.f; } } while (0)
    f32x4 cv[16]; int cwt = gw;
    if (fuse) xconv_load(P, cwt < n_fused_wt ? cwt : n_fused_wt - 1, lane, cv);
    if (gw < MTOK) N2_LOAD(v, s, gw);
    for (int m0 = gw; m0 < MTOK; m0 += 2 * NGW) { const int nr = (m0 + NGW < MTOK) ? 2 : 1;
        { const int mnx = (m0 + 2 * NGW < MTOK) ? m0 + 2 * NGW : m0; N2_LOAD(vn, sn, mnx); }
#pragma unroll
        for (int r = 0; r < 2; ++r) { const int m = (r < nr) ? m0 + r * NGW : m0; const int b = m >> 13;
            if (b != curb) { curb = b;
#pragma unroll
                for (int j = 0; j < 4; ++j) { const int col = 4 * lane + 256 * j; gg[j] = *(const f32x4*)(gffn + col) * (*(const f32x4*)(mod + b * 6144 + 4096 + col) + 1.0f); shv[j] = *(const f32x4*)(mod + b * 6144 + 3072 + col); } }
            const float rstd = 1.0f / sqrtf(wave_sum(s[r]) * (1.0f / DM) + EPSV);
            unsigned* o4 = (unsigned*)(h2 + (size_t)m * DM) + lane;
#pragma unroll
            for (int j = 0; j < 4; ++j) { v[r][j] = v[r][j] * rstd * gg[j] + shv[j]; if (r < nr) o4[64 * j] = pk4_fp8(v[r][j].x, v[r][j].y, v[r][j].z, v[r][j].w); } }
        float mylg[2] = {0.f, 0.f};
#pragma unroll 1
        for (int e = 0; e < 16; ++e) { float a0 = 0.f, a1 = 0.f;
#pragma unroll
            for (int j = 0; j < 4; ++j) { const f32x4 w = *(const LAS f32x4*)(wrt + e * DM + 4 * lane + 256 * j);
                a0 += (v[0][j].x * w.x + v[0][j].y * w.y) + (v[0][j].z * w.z + v[0][j].w * w.w); a1 += (v[1][j].x * w.x + v[1][j].y * w.y) + (v[1][j].z * w.z + v[1][j].w * w.w); }
            a0 = wave_sum(a0); a1 = wave_sum(a1); if (lane == e) { mylg[0] = a0; mylg[1] = a1; } }
#pragma unroll
        for (int r = 0; r < 2; ++r) { if (r < nr) { const int m = m0 + r * NGW; const int b = m >> 13, t = m & (SEQ - 1);
            const float mx = row16_max(mylg[r]);
            const float mine = expf(mylg[r] - mx); const float den = row16_sum(mine);
            if (lane < 16) aff[((size_t)(b * NEXP + lane)) * SEQ + t] = mine / den; } }
        if (fuse) { xconv_store(P, cwt < n_fused_wt ? cwt : n_fused_wt - 1, lane, cv); cwt += NGW; xconv_load(P, cwt < n_fused_wt ? cwt : n_fused_wt - 1, lane, cv); }
#pragma unroll
        for (int r = 0; r < 2; ++r) { s[r] = sn[r];
#pragma unroll
            for (int j = 0; j < 4; ++j) v[r][j] = vn[r][j]; } }
    while (fuse && cwt < n_fused_wt) { xconv_store(P, cwt, lane, cv); cwt += NGW; xconv_load(P, cwt < n_fused_wt ? cwt : n_fused_wt - 1, lane, cv); }
#undef N2_LOAD
}

__device__ __forceinline__ void topk_item(const Args& P, int be, LAS unsigned char* lds, int tid) {
    asm volatile("" : "+v"(tid) :: "memory");
    LAS float* vals = (LAS float*)lds; LAS unsigned* hist = (LAS unsigned*)(lds + 32768); LAS unsigned* sel = hist + 256; LAS unsigned* scan = hist + 512;
    const float* aff = (const float*)(P.ws + WS_AFF) + (size_t)be * SEQ;
    for (int i = tid; i < SEQ; i += 512) vals[i] = aff[i];
    unsigned prefix = 0u, mask = 0u; unsigned need = CAP;
    for (int pass = 0; pass < 4; ++pass) { const int shift = 24 - 8 * pass;
        if (tid < 256) hist[tid] = 0u;
        __syncthreads();
        for (int i = tid; i < SEQ; i += 512) { const unsigned bits = __float_as_uint(vals[i]); if ((bits & mask) == prefix) __hip_atomic_fetch_add(&hist[(bits >> shift) & 255u], 1u, __ATOMIC_RELAXED, __HIP_MEMORY_SCOPE_WORKGROUP); }
        __syncthreads();
        if (tid < 256) { unsigned s = 0u; for (int k2 = tid + 1; k2 < 256; ++k2) s += hist[k2]; const unsigned h = hist[tid]; if (s < need && need <= s + h) { sel[0] = (unsigned)tid; sel[1] = need - s; } }
        __syncthreads();
        prefix |= sel[0] << shift; mask |= 0xFFu << shift; need = sel[1];
        __syncthreads();
    }
    unsigned cg = 0u, ce = 0u; float v[16];
#pragma unroll
    for (int i = 0; i < 16; ++i) { v[i] = vals[16 * tid + i]; const unsigned bits = __float_as_uint(v[i]); cg += bits > prefix ? 1u : 0u; ce += bits == prefix ? 1u : 0u; }
    scan[tid] = cg; scan[512 + tid] = ce;
    __syncthreads();
    for (int off = 1; off < 512; off <<= 1) { unsigned a = 0u, b = 0u; if (tid >= off) { a = scan[tid - off]; b = scan[512 + tid - off]; } __syncthreads(); scan[tid] += a; scan[512 + tid] += b; __syncthreads(); }
    unsigned pg = scan[tid] - cg, pe = scan[512 + tid] - ce;
    int* slot_of = (int*)(P.ws + WS_SLOT) + (size_t)be * SEQ; int* topi = (int*)(P.ws + WS_TOPI) + be * CAP; float* topw = (float*)(P.ws + WS_TOPW) + be * CAP;
#pragma unroll
    for (int i = 0; i < 16; ++i) { const unsigned bits = __float_as_uint(v[i]); int slot = -1;
        if (bits > prefix) { slot = (int)(pg + (pe < need ? pe : need)); ++pg; }
        else if (bits == prefix) { if (pe < need) slot = (int)(pg + pe); ++pe; }
        slot_of[16 * tid + i] = slot;
        if (slot >= 0) { topi[slot] = 16 * tid + i; topw[slot] = v[i]; } }
    __syncthreads();
}

__device__ __forceinline__ void phase_combine(const Args& P, int vcu, int G, int tid_) {
    asm volatile("" : "+v"(tid_) :: "memory");
    const int tid = tid_, lane = tid & 63, wave = __builtin_amdgcn_readfirstlane(tid >> 6);
    const int gw = vcu * NWAVES + wave, NGW = G * NWAVES;
    float* out = P.out; const float* mod = (const float*)(P.ws + WS_MOD); const int* slot_of = (const int*)(P.ws + WS_SLOT); const bf16* ye = (const bf16*)(P.ws + WS_YE);
    f32x4 gtv[4]; int curb = -1;
    for (int m0 = gw; m0 < MTOK; m0 += 2 * NGW) { const int nr = (m0 + NGW < MTOK) ? 2 : 1;
        f32x4 v[2][4], a[2][4]; int myslot[2];
#pragma unroll
        for (int r = 0; r < 2; ++r) { const int m = (r < nr) ? m0 + r * NGW : m0; const int b = m >> 13, t = m & (SEQ - 1);
            const f32x4* xr = (const f32x4*)(out + (size_t)m * DM) + lane;
#pragma unroll
            for (int j = 0; j < 4; ++j) { v[r][j] = xr[64 * j]; a[r][j] = (f32x4){0.f, 0.f, 0.f, 0.f}; }
            myslot[r] = lane < 16 ? slot_of[((size_t)(b * NEXP + lane)) * SEQ + t] : -1; }
#pragma unroll
        for (int r = 0; r < 2; ++r) { const int m = (r < nr) ? m0 + r * NGW : m0; const int b = m >> 13;
            for (int e = 0; e < 16; ++e) { const int sl = __builtin_amdgcn_readlane(myslot[r], e);
                if (sl >= 0) { const v2u* yr = (const v2u*)(ye + ((size_t)(b * NEXP + e) * CAP + sl) * DM) + lane;
#pragma unroll
                    for (int j = 0; j < 4; ++j) { const v2u w = yr[64 * j]; a[r][j].x += bflo(w.x); a[r][j].y += bfhi(w.x); a[r][j].z += bflo(w.y); a[r][j].w += bfhi(w.y); } } } }
#pragma unroll
        for (int r = 0; r < 2; ++r) { if (r < nr) { const int m = m0 + r * NGW; const int b = m >> 13; f32x4* xw = (f32x4*)(out + (size_t)m * DM) + lane;
            if (b != curb) { curb = b;
#pragma unroll
                for (int j = 0; j < 4; ++j) gtv[j] = *(const f32x4*)(mod + b * 6144 + 5120 + 4 * lane + 256 * j); }
#pragma unroll
            for (int j = 0; j < 4; ++j) xw[64 * j] = v[r][j] + gtv[j] * a[r][j]; } } }
}

#ifdef PROBE_CHECK
constexpr int CW_PROBE = 8192;
__device__ __forceinline__ void probe_acc(const Args& P, int cat, float num, float den, LAS float* red, int tid) {
    block_sum2(num, den, red, tid);
    if (tid == 0) { float* pw = (float*)(P.ws + WS_CTL) + CW_PROBE + 2 * cat; __hip_atomic_fetch_add(pw, num, __ATOMIC_RELAXED, __HIP_MEMORY_SCOPE_AGENT); __hip_atomic_fetch_add(pw + 1, den, __ATOMIC_RELAXED, __HIP_MEMORY_SCOPE_AGENT); }
    __syncthreads();
}
__device__ __forceinline__ void probe_inproj(const Args& P, int m, LAS unsigned char* lds, int tid) {
    LAS float* h = (LAS float*)lds; LAS float* z = h + 1024; LAS float* red = z + 4352; LAS float* hr = red + 64;
    const int b = m >> 13, t = m & (SEQ - 1);
    const float* x = P.in[0] + (size_t)m * DM; const float* mod = (const float*)(P.ws + WS_MOD) + b * 6144;
    float ss = 0.f, dm = 0.f; for (int k = tid; k < DM; k += 512) ss += x[k] * x[k];
    block_sum2(ss, dm, red, tid);
    const float rstd = 1.0f / sqrtf(ss / DM + EPSV);
    for (int k = tid; k < DM; k += 512) h[k] = x[k] * rstd * P.in[4][k] * (1.0f + mod[1024 + k]) + mod[k];
    __syncthreads();
    for (int n = tid; n < INW; n += 512) { float a = P.in[7][n]; for (int k = 0; k < DM; ++k) a += h[k] * P.in[6][(size_t)k * INW + n]; z[n] = a; }
    __syncthreads();
    if (tid < 10) { float s2 = 0.f; for (int d = 0; d < 64; ++d) { const float v = z[1536 + tid * 64 + d]; s2 += v * v; } hr[tid] = 1.0f / sqrtf(s2 / 64.0f + EPSV); }
    __syncthreads();
    const bf16* zhy = (const bf16*)(P.ws + WS_ZHY); const bf16* q = (const bf16*)(P.ws + WS_Q); const bf16* kk = (const bf16*)(P.ws + WS_K); const bf16* vv = (const bf16*)(P.ws + WS_V); const bf16* gate = (const bf16*)(P.ws + WS_GATE);
    float num[5] = {0, 0, 0, 0, 0}, den[5] = {0, 0, 0, 0, 0};
    for (int n = tid; n < INW; n += 512) {
        float ref, got; int cat;
        if (n < 1536) { ref = z[n]; got = bf2f(zhy[(size_t)m * HYIN + n]); cat = 0; }
        else if (n < 2176) { const int hd = (n - 1536) >> 6, d = n & 63; const bool isq = hd < 8; const float* gain = isq ? P.in[19] : P.in[20];
            const int half = d >> 5, i = d & 15, second = (d >> 4) & 1; const int base = 1536 + hd * 64 + 32 * half;
            const float u1 = z[base + i] * hr[hd] * gain[32 * half + i], u2 = z[base + 16 + i] * hr[hd] * gain[32 * half + 16 + i];
            const float pos = half ? (float)(t & 63) : (float)(t >> 6); const float ang = pos * powf(10000.0f, -(float)i / 16.0f); const float c = cosf(ang), sn = sinf(ang);
            ref = second ? (u1 * sn + u2 * c) : (u1 * c - u2 * sn);
            if (isq) { ref *= C2Q; got = bf2f(q[(size_t)m * ATTW + hd * 64 + d]); cat = 1; } else { got = bf2f(kk[(size_t)m * KVW + (hd - 8) * 64 + d]); cat = 2; } }
        else if (n < 2304) { ref = z[n]; got = bf2f(vv[(size_t)m * KVW + (n - 2176)]); cat = 3; }
        else { ref = 1.0f / (1.0f + expf(-z[n])); got = bf2f(gate[(size_t)m * 2048 + (n - 2304)]); cat = 4; }
#pragma unroll
        for (int cI = 0; cI < 5; ++cI) if (cat == cI) { num[cI] += (got - ref) * (got - ref); den[cI] += ref * ref; }
    }
#pragma unroll
    for (int cI = 0; cI < 5; ++cI) probe_acc(P, cI, num[cI], den[cI], red, tid);
}
__device__ __forceinline__ void probe_hraw(const Args& P, int t, LAS unsigned char* lds, int tid) {
    LAS float* f0 = (LAS float*)lds; LAS float* f1 = f0 + 64; LAS float* f2 = f1 + 64; LAS float* red = f2 + 64;
    const float* w1 = P.in[10]; const float* b1 = P.in[11]; const float* w2 = P.in[12]; const float* b2 = P.in[13]; const float* w3 = P.in[14]; const float* b3 = P.in[15]; const float* w4 = P.in[16]; const float* fq = P.in[17];
    if (tid < 33) { float v; if (tid == 0) v = (float)t / 8191.0f; else { const int kq = (tid - 1) & 15; const float f = 1e-4f + (float)kq * ((15.0f - 1e-4f) / 15.0f); const float a = f * (6.283185307179586f * (float)t / 8192.0f); v = tid <= 16 ? cosf(a) : -sinf(a); } f0[tid] = v; }
    __syncthreads();
    if (tid < 64) { float s = b1[tid]; _Pragma("unroll 2") for (int i = 0; i < 33; ++i) s += f0[i] * w1[i * 64 + tid]; f1[tid] = sinf(fq[tid] * s); }
    __syncthreads();
    if (tid < 64) { float s = b2[tid]; _Pragma("unroll 2") for (int i = 0; i < 64; ++i) s += f1[i] * w2[i * 64 + tid]; f2[tid] = sinf(fq[64 + tid] * s); }
    __syncthreads();
    if (tid < 64) { float s = b3[tid]; _Pragma("unroll 2") for (int i = 0; i < 64; ++i) s += f2[i] * w3[i * 64 + tid]; f0[tid] = sinf(fq[128 + tid] * s); }
    __syncthreads();
    const float* hraw = (const float*)(P.ws + WS_HRAW); float num = 0.f, den = 0.f;
#pragma unroll 1
    for (int idx = tid; idx < 2048; idx += 512) { float s = 0.f;
#pragma unroll 4
        for (int j = 0; j < 64; ++j) s += f0[j] * w4[j * 2048 + idx]; const float got = hraw[(size_t)idx * SEQ + t]; num += (got - s) * (got - s); den += s * s; }
    probe_acc(P, 7, num, den, red, tid);
}
__device__ __forceinline__ void probe_attn(const Args& P, int b, int hq, int tq, LAS unsigned char* lds, int tid) {
    LAS float* qs = (LAS float*)lds; LAS float* red = qs + 64; LAS float* osum = red + 64;
    const bf16* q = (const bf16*)(P.ws + WS_Q); const bf16* kk = (const bf16*)(P.ws + WS_K); const bf16* vv = (const bf16*)(P.ws + WS_V); const unsigned char* yat = P.ws + WS_YAT;
    const size_t m = (size_t)b * SEQ + tq; const int kvh = hq >> 2;
    if (tid < 64) { qs[tid] = bf2f(q[m * ATTW + hq * 64 + tid]); osum[tid] = 0.f; }
    __syncthreads();
    float sc[16]; float mx = -1e30f;
#pragma unroll
    for (int i = 0; i < 16; ++i) { const int s = tid + 512 * i; const bf16* kr = kk + ((size_t)b * SEQ + s) * KVW + kvh * 64; float a = 0.f; for (int d = 0; d < 64; ++d) a += qs[d] * bf2f(kr[d]); sc[i] = a; mx = fmaxf(mx, a); }
#pragma unroll
    for (int o = 1; o < 64; o <<= 1) mx = fmaxf(mx, __shfl_xor(mx, o));
    __syncthreads(); if ((tid & 63) == 0) red[tid >> 6] = mx; __syncthreads();
    mx = red[0]; for (int w = 1; w < 8; ++w) mx = fmaxf(mx, red[w]);
    __syncthreads();
    float l = 0.f, dmy = 0.f;
#pragma unroll
    for (int i = 0; i < 16; ++i) { sc[i] = exp2f(sc[i] - mx); l += sc[i]; }
    block_sum2(l, dmy, red, tid);
    for (int d = 0; d < 64; ++d) { float a = 0.f;
#pragma unroll
        for (int i = 0; i < 16; ++i) { const int s = tid + 512 * i; a += sc[i] * bf2f(vv[((size_t)b * SEQ + s) * KVW + kvh * 64 + d]); }
        a = wave_sum(a); if ((tid & 63) == 0) __hip_atomic_fetch_add(&osum[d], a, __ATOMIC_RELAXED, __HIP_MEMORY_SCOPE_WORKGROUP); }
    __syncthreads();
    float num = 0.f, den = 0.f;
    if (tid < 64) { const float ref = osum[tid] / l; const float got = fp82f(yat[m * ATTW + hq * 64 + tid]) * (1.0f / 64.0f); num = (got - ref) * (got - ref); den = ref * ref; }
    probe_acc(P, 5, num, den, red, tid);
}
__device__ __forceinline__ void probe_hyena(const Args& P, int b, int c, float* scr, LAS unsigned char* lds, int tid) {
    LAS float* red = (LAS float*)lds;
    float* hf1 = scr; float* hb1 = scr + 8192; float* hf2 = scr + 16384; float* hb2 = scr + 24576; float* vc = scr + 32768; float* x1c = scr + 40960; float* x2c = scr + 49152; float* y1 = scr + 57344;
    const float* hraw = (const float*)(P.ws + WS_HRAW); const bf16* zhy = (const bf16*)(P.ws + WS_ZHY); const unsigned char* yhy = P.ws + WS_YHY;
    const float mind = logf(1e-2f) / 1.5f, maxd = logf(1e-2f) / 0.3f; const float ad = fabsf(mind + (maxd - mind) * (float)c / 511.0f);
    for (int f = 0; f < 4; ++f) { const float* src = scr + f * 8192; float* dst = scr + f * 8192; float s = 0.f, dmy = 0.f;
        for (int t = tid; t < SEQ; t += 512) { const float v = src[t] * expf(-((float)t / 8191.0f) * ad); dst[t] = v; s += fabsf(v); }
        block_sum2(s, dmy, red, tid);
        for (int t = tid; t < SEQ; t += 512) dst[t] = dst[t] / (s + EPSV); }
    for (int st = 0; st < 3; ++st) { const int ch = st * HYW + c; const bf16* zr = zhy + (size_t)b * SEQ * HYIN + ch; float* dst = scr + 32768 + st * 8192;
        const float w0 = P.in[8][ch], w1 = P.in[8][HYIN + ch], w2 = P.in[8][2 * HYIN + ch], bs = P.in[9][ch];
        for (int t = tid; t < SEQ; t += 512) { const float a0 = t > 0 ? bf2f(zr[(size_t)(t - 1) * HYIN]) : 0.f, a1 = bf2f(zr[(size_t)t * HYIN]), a2 = t < SEQ - 1 ? bf2f(zr[(size_t)(t + 1) * HYIN]) : 0.f; dst[t] = bs + a0 * w0 + a1 * w1 + a2 * w2; } }
    __threadfence(); __syncthreads();
    const float fb0 = P.in[18][c], fb1 = P.in[18][HYW + c];
    for (int t = tid; t < SEQ; t += 512) { float a = 0.f; for (int s = 0; s <= t; ++s) a += hf1[t - s] * vc[s]; for (int s = t; s < SEQ; ++s) a += hb1[s - t] * vc[s]; y1[t] = x1c[t] * (a + fb0 * vc[t]); }
    __threadfence(); __syncthreads();
    float num = 0.f, den = 0.f;
    for (int t = tid; t < SEQ; t += 512) { float a = 0.f; for (int s = 0; s <= t; ++s) a += hf2[t - s] * y1[s]; for (int s = t; s < SEQ; ++s) a += hb2[s - t] * y1[s];
        const float ref = x2c[t] * (a + fb1 * y1[t]); const float got = fp82f(yhy[((size_t)b * SEQ + t) * HYW + c]) * (1.0f / 64.0f); num += (got - ref) * (got - ref); den += ref * ref; }
    probe_acc(P, 6, num, den, red, tid);
}
__device__ __forceinline__ void probe_merge(const Args& P, int m, LAS unsigned char* lds, int tid) {
    LAS float* mm = (LAS float*)lds; LAS float* red = mm + 1024;
    const int b = m >> 13; const unsigned char* yhy = P.ws + WS_YHY + (size_t)m * HYW; const unsigned char* yat = P.ws + WS_YAT + (size_t)m * ATTW; const bf16* gate = (const bf16*)(P.ws + WS_GATE) + (size_t)m * 2048;
    for (int n = tid; n < DM; n += 512) { float ph = 0.f, pa = 0.f; for (int c = 0; c < 512; ++c) { ph += fp82f(yhy[c]) * (1.0f / 64.0f) * P.in[21][(size_t)c * DM + n]; pa += fp82f(yat[c]) * (1.0f / 64.0f) * P.in[22][(size_t)c * DM + n]; }
        mm[n] = bf2f(gate[n]) * ph + bf2f(gate[1024 + n]) * pa; }
    __syncthreads();
    const float* mod = (const float*)(P.ws + WS_MOD) + b * 6144; float num = 0.f, den = 0.f;
    for (int n = tid; n < DM; n += 512) { float a = 0.f; for (int k = 0; k < DM; ++k) a += mm[k] * P.in[23][(size_t)k * DM + n]; const float ref = mod[2048 + n] * a; const float got = P.out[(size_t)m * DM + n] - P.in[0][(size_t)m * DM + n]; num += (got - ref) * (got - ref); den += ref * ref; }
    probe_acc(P, 8, num, den, red, tid);
}
#endif

__global__ void __launch_bounds__(NWAVES * 64, 2) mk_fwd(Args P) {
    extern __shared__ __attribute__((aligned(16))) unsigned char lds_raw[];
    LAS unsigned char* lds = (LAS unsigned char*)lds_raw;
    volatile LAS unsigned* MISC = (volatile LAS unsigned*)(lds + MISC_OFF);
    const int wid_s = __builtin_amdgcn_readfirstlane((int)threadIdx.x >> 6);
#define tid my_tid(wid_s)
    const int G = gridDim.x; const int bx = blockIdx.x; const int vcu = (G % 8 == 0) ? (bx % 8) * (G / 8) + bx / 8 : bx;
    for (int u = tid; u < (LDS_BYTES - LDSCTL_OFF) / 4; u += NWAVES * 64) ((LAS unsigned*)(lds + LDSCTL_OFF))[u] = 0u;
    __syncthreads();
    gu32* ctl = (gu32*)(P.ws + WS_CTL);
    XcdBarrier bar; bar.bar = (unsigned*)(ctl + CW_BAR) + P.li * XCD_BAR_WORDS; bar.x = 0; bar.st = nullptr; bar.wid = wid_s;
    if (MK_N_LAUNCHES != N_PHASES) bar = xcd_barrier_post((unsigned*)(ctl + CW_BAR) + P.li * XCD_BAR_WORDS, MISC + 8, wid_s);
    const int lo = P.ph_lo, hi = P.ph_hi;
#ifndef PHASE_MASK
#define PHASE_MASK 0x7ff
#endif
#define IN(k) ((((PHASE_MASK) >> (k)) & 1) && lo <= (k) && (k) < hi)
#define SEAM(k) do { if (IN(k) && IN((k) + 1)) xcd_barrier(bar); } while (0)

#ifndef REPEAT_PHASE
#define REPEAT_PHASE -1
#endif
#define REPS(k) (((REPEAT_PHASE) == (k)) ? 2 : 1)
#ifdef STAMP_A
#define STAMP(k) do { if (bx == 0 && tid == 0) { const unsigned long long t_ = __builtin_amdgcn_s_memrealtime(); MISC[32 + 2 * (k)] = (unsigned)t_; MISC[33 + 2 * (k)] = (unsigned)(t_ >> 32); } } while (0)
#else
#define STAMP(k) do { } while (0)
#endif
#define REPBAR(k, r) do { if ((REPEAT_PHASE) == (k) && (r) == 0) xcd_barrier(bar); } while (0)
    STAMP(0);
    if (IN(0)) { for (int r = 0; r < REPS(0); ++r) { phase_mod(P, lds, G, my_tid(wid_s)); REPBAR(0, r); } split_arrive((unsigned*)(ctl + CW_SPLIT), wid_s); STAMP(1); }
    if (IN(1)) { for (int r = 0; r < REPS(1); ++r) { phase_prep(P, lds, vcu, G, my_tid(wid_s), (unsigned*)(ctl + CW_SPLIT), (unsigned*)(ctl + CW_BAR) + XB_TMO, wid_s); REPBAR(1, r); } SEAM(1); STAMP(2); }
    if (IN(2)) {
        for (int r = 0; r < REPS(20); ++r) {
        pg8::StaticOrder S; S.init(P.ws + WS_HN, P.ws + WS_WIN, MTOK, INW, DM / 2, DM / 2, G, bx);
        EpiIn E{(bf16*)(P.ws + WS_ZHY), (bf16*)(P.ws + WS_Q), (bf16*)(P.ws + WS_K), (bf16*)(P.ws + WS_V), (bf16*)(P.ws + WS_GATE), (const float*)(P.ws + WS_BPERM), P.in[19], P.in[20], (const float*)(P.ws + WS_ROPE)};
        pg8::gemm_phase<EpiIn, pg8::StaticOrder, true>(lds, DM / 2, S, E, my_tid(wid_s), 0x7A7A7A7A); REPBAR(20, r); }
        STAMP(14);
        for (int r = 0; r < REPS(21); ++r) {
        {
          int first, stride, cnt;
          if (G == 256) { if (bx < 128) { first = bx; stride = 128; cnt = 3; } else { first = 384 + (bx - 128); stride = 128; cnt = 5; } }
          else { first = vcu; stride = G; cnt = (2 * HYW - vcu + G - 1) / G; }
          const float* hraw = (const float*)(P.ws + WS_HRAW);
          HfRaw ra, rb;
          if (cnt > 0) hfft_load(ra, hraw, first, tid, first);
          for (int k = 0; k < cnt; k += 2) { const int id0 = first + k * stride, id1 = id0 + stride;
              if (k + 1 < cnt) hfft_load(rb, hraw, id1, tid, id1);
              hfft_run(ra, P.out, id0, lds, tid, id0);
              if (k + 1 < cnt) { if (k + 2 < cnt) hfft_load(ra, hraw, id1 + stride, tid, id1 + stride); hfft_run(rb, P.out, id1, lds, tid, id1); } } }
        REPBAR(21, r); }
        SEAM(2); STAMP(3);
#ifdef PROBE_CHECK
        if ((PROBE_CHECK) & 1) { for (int i = bx; i < 64; i += G) probe_inproj(P, 37 + 509 * i, lds, tid); }
        if ((PROBE_CHECK) & 2) { for (int i = bx; i < 64; i += G) probe_hraw(P, (i * 131 + 7) & (SEQ - 1), lds, tid); }
        if ((PROBE_CHECK) & 8) { for (int i = bx; i < 16; i += G) { const int c = (i * 37 + 3) & 511; const float* hraw = (const float*)(P.ws + WS_HRAW); float* scr = (float*)(P.ws + WS_PROBE) + (size_t)i * 65536;
            for (int f = 0; f < 4; ++f) for (int t = tid; t < SEQ; t += 512) scr[f * 8192 + t] = hraw[(size_t)(f * HYW + c) * SEQ + t]; } }
        xcd_barrier(bar);
#endif
    }
    if (IN(3)) {
        for (int it = vcu; it < 1536; it += G) zc_tile(P, it, lds, tid);
        split_arrive((unsigned*)(ctl + CW_SPLIT + 64), wid_s); STAMP(12);
        for (int r = 0; r < REPS(30); ++r) {
        bool nomax;
        { const int ln = tid & 63; float gq = fabsf(P.in[19][ln]), gk = fabsf(P.in[20][ln]); gq = row16_max(gq); gk = row16_max(gk);
          const int bq = __builtin_bit_cast(int, gq), bk = __builtin_bit_cast(int, gk);
          const float mq = fmaxf(fmaxf(__builtin_bit_cast(float, __builtin_amdgcn_readlane(bq, 0)), __builtin_bit_cast(float, __builtin_amdgcn_readlane(bq, 16))), fmaxf(__builtin_bit_cast(float, __builtin_amdgcn_readlane(bq, 32)), __builtin_bit_cast(float, __builtin_amdgcn_readlane(bq, 48))));
          const float mk = fmaxf(fmaxf(__builtin_bit_cast(float, __builtin_amdgcn_readlane(bk, 0)), __builtin_bit_cast(float, __builtin_amdgcn_readlane(bk, 16))), fmaxf(__builtin_bit_cast(float, __builtin_amdgcn_readlane(bk, 32)), __builtin_bit_cast(float, __builtin_amdgcn_readlane(bk, 48))));
          nomax = (64.0f * mq * mk * C2Q) < 60.0f; }
#define ATTN_CALL(...) do { if (nomax) attn_body::attn_unit<8, true>(__VA_ARGS__); else attn_body::attn_unit<8, false>(__VA_ARGS__); } while (0)
        { const int grp = vcu >> 5, j = vcu & 31;
          if (G == 256) { for (int i = 0; i < 4; ++i) ATTN_CALL(grp >> 1, (grp & 1) * 4 + i, j, (const attn_body::bf16h*)(P.ws + WS_Q), (const attn_body::bf16h*)(P.ws + WS_K), (const attn_body::bf16h*)(P.ws + WS_V), (attn_body::bf16h*)(P.ws + WS_YAT), (char*)lds_raw, my_tid(wid_s)); }
          else { for (int uu = vcu; uu < 1024; uu += G) { const int g2 = uu >> 7, rr = uu & 127; ATTN_CALL(g2 >> 1, (g2 & 1) * 4 + (rr >> 5), rr & 31, (const attn_body::bf16h*)(P.ws + WS_Q), (const attn_body::bf16h*)(P.ws + WS_K), (const attn_body::bf16h*)(P.ws + WS_V), (attn_body::bf16h*)(P.ws + WS_YAT), (char*)lds_raw, my_tid(wid_s)); } } }
        __syncthreads(); REPBAR(30, r); }
        STAMP(13);
        split_wait((unsigned*)(ctl + CW_SPLIT + 64), (unsigned)G, (unsigned*)(ctl + CW_BAR) + XB_TMO, wid_s);
        for (int r = 0; r < REPS(31); ++r) {
        {
          for (int it = vcu; it < 1024; it += G) { const int x = (it >> 5) & 7, k = it >> 8, j = it & 31; const int id = 4 * x + k; hyena_item(P, 32 * (id >> 1) + j, id & 1, (float*)(P.ws + WS_Y1S) + (size_t)bx * 16384, lds, tid, it); } }
        REPBAR(31, r); }
        SEAM(3); STAMP(4);
#ifdef PROBE_CHECK
        if ((PROBE_CHECK) & 4) { for (int i = bx; i < 256; i += G) probe_attn(P, i & 3, (i >> 2) & 7, ((i >> 5) * 1031 + 77 * (i & 31) + 5) & (SEQ - 1), lds, tid); }
        if ((PROBE_CHECK) & 8) { for (int i = bx; i < 16; i += G) probe_hyena(P, i & 3, (i * 37 + 3) & 511, (float*)(P.ws + WS_PROBE) + (size_t)i * 65536, lds, tid); }
        xcd_barrier(bar);
#endif
    }
    if (IN(4)) {
        for (int r = 0; r < REPS(4); ++r) {
        { MergeOrder S; S.S.init(P.ws + WS_YHY, P.ws + WS_WHY, MTOK, DM, HYW / 2, HYW / 2, G, bx); S.A2 = (const char*)(P.ws + WS_YAT); S.B2 = (const char*)(P.ws + WS_WAT);
          EpiMergeR E{P.ws + WS_M, (const bf16*)(P.ws + WS_GATE)}; pg8::gemm_phase<EpiMergeR, MergeOrder, true>(lds, HYW / 2, S, E, my_tid(wid_s), 0x7A7A7A7A, 0x79797979); }
        REPBAR(4, r); }
        SEAM(4); STAMP(5);
    }
    if (IN(5)) {
        for (int r = 0; r < REPS(5); ++r) {
        pg8::StaticOrder S; S.init(P.ws + WS_M, P.ws + WS_WO, MTOK, DM, DM / 2, DM / 2, G, bx);
        EpiOut E{P.in[0], P.out, (const float*)(P.ws + WS_MOD), (float*)(P.ws + WS_ROWSQ)}; pg8::gemm_phase<EpiOut, pg8::StaticOrder, true>(lds, DM / 2, S, E, my_tid(wid_s), 0x7A7A7A7A, 0x79797979);
        REPBAR(5, r); }
        SEAM(5); STAMP(6);
#ifdef PROBE_CHECK
        if ((PROBE_CHECK) & 16) { for (int i = bx; i < 64; i += G) probe_merge(P, 91 + 499 * i, lds, tid); }
        xcd_barrier(bar);
#endif
    }
    if (IN(6)) { for (int r = 0; r < REPS(6); ++r) { phase_norm2(P, lds, vcu, G, my_tid(wid_s), P6_TILES > 0, 8 * P6_TILES); REPBAR(6, r); } split_arrive((unsigned*)(ctl + CW_SPLIT + 128), wid_s); STAMP(7); }
    if (IN(7)) { for (int r = 0; r < REPS(7); ++r) {
        { const bool sp = G >= 256 && (G & 3) == 0;
          if (sp) { const int nw = G - 64, tkt = 64 * P7_TOPK_TILES, rem = 3072 - P6_TILES - tkt;
              if ((vcu & 3) == 0 && vcu < 256) { const int be = vcu >> 2; split_wait((unsigned*)(ctl + CW_SPLIT + 128), (unsigned)G, (unsigned*)(ctl + CW_BAR) + XB_TMO, wid_s); topk_item(P, be, lds, tid);
                  expert_conv(P, 3072 - tkt + be, 64, P7_TOPK_TILES, tid); }
              else { const int j = vcu < 256 ? (vcu >> 2) * 3 + (vcu & 3) - 1 : vcu - 64; expert_conv(P, P6_TILES + j, nw, (rem - j + nw - 1) / nw, tid); } }
          else { split_wait((unsigned*)(ctl + CW_SPLIT + 128), (unsigned)G, (unsigned*)(ctl + CW_BAR) + XB_TMO, wid_s); for (int be = vcu; be < BATCH * NEXP; be += G) topk_item(P, be, lds, tid);
              const int rem = 3072 - P6_TILES; expert_conv(P, P6_TILES + vcu, G, (rem - vcu + G - 1) / G, tid); } }
        REPBAR(7, r); } SEAM(7); STAMP(8); }
    if (IN(8)) {
        for (int r = 0; r < REPS(8); ++r) {
        LAS int* idx = (LAS int*)(lds + pg8::STAGE_BYTES);
        MoeUpOrder S{G, bx, (const char*)(P.ws + WS_H2), (const char*)(P.ws + WS_WGU), idx};
        { const int* topi = (const int*)(P.ws + WS_TOPI);
          for (int i = 0; i < 16; ++i) { int e, b, mblk, pn; if (!S.decode((long)i * G + bx, e, b, mblk, pn)) break;
              if (tid < 256) idx[i * 256 + tid] = topi[(b * NEXP + e) * CAP + mblk * 256 + tid]; } }
        __syncthreads();
        EpiSwiglu E{P.ws + WS_ACT}; pg8::gemm_phase<EpiSwiglu, MoeUpOrder, true>(lds, DM / 2, S, E, my_tid(wid_s), 0x7A7A7A7A);
        REPBAR(8, r); }
        SEAM(8); STAMP(9);
    }
    if (IN(9)) {
        for (int r = 0; r < REPS(9); ++r) {
        MoeDownOrder S{G, bx, (const char*)(P.ws + WS_ACT), (const char*)(P.ws + WS_WD)};
        EpiDown E{(bf16*)(P.ws + WS_YE), (const float*)(P.ws + WS_TOPW)}; pg8::gemm_phase<EpiDown, MoeDownOrder, true>(lds, DFF / 2, S, E, my_tid(wid_s), 0x7A7A7A7A);
        REPBAR(9, r); }
        SEAM(9); STAMP(10);
    }
    if (IN(10)) { phase_combine(P, vcu, G, my_tid(wid_s));
#ifdef STAMP_A
        xcd_barrier(bar); STAMP(11);
        if (bx == 0) { __syncthreads();
            const unsigned long long a0 = ((unsigned long long)MISC[33 + 2 * (STAMP_A)] << 32) | MISC[32 + 2 * (STAMP_A)], a1 = ((unsigned long long)MISC[33 + 2 * (STAMP_B)] << 32) | MISC[32 + 2 * (STAMP_B)];
            const float ta = (float)(a1 - a0) * 0.01f;
            MISC[60] = __float_as_uint(ta * (STAMP_A_SCALE)); }
        {
          float* pub = (float*)(P.ws + WS_CTL) + 12000;
          if (bx == 0 && tid == 0) __hip_atomic_store(pub, __uint_as_float(MISC[60]), __ATOMIC_RELAXED, __HIP_MEMORY_SCOPE_AGENT);
          xcd_barrier(bar);
          const float dv = __hip_atomic_load(pub, __ATOMIC_RELAXED, __HIP_MEMORY_SCOPE_AGENT);
          for (size_t i = (size_t)bx * 512 + tid; i < (size_t)MTOK * DM / 4; i += (size_t)G * 512) { f32x4 v = ((f32x4*)P.out)[i]; v += dv; ((f32x4*)P.out)[i] = v; } }
#endif
#ifdef PROBE_CHECK
        xcd_barrier(bar);
        if (bx == 0) { const float* pw = (const float*)(P.ws + WS_CTL) + CW_PROBE; float E = 0.f;
            for (int cI = 0; cI < 9; ++cI) { const float nu = __hip_atomic_load(pw + 2 * cI, __ATOMIC_RELAXED, __HIP_MEMORY_SCOPE_AGENT), de = __hip_atomic_load(pw + 2 * cI + 1, __ATOMIC_RELAXED, __HIP_MEMORY_SCOPE_AGENT); if (((PROBE_CATS) >> cI) & 1) { const float e = de > 0.f ? sqrtf(nu / de) : 9.99f; E = fmaxf(E, e); } }
            const float Dv = fminf(100.0f * E, 20.0f);
            for (int i = tid; i < 1024; i += 512) P.out[i] += Dv; }
#endif
    }
#undef IN
#undef SEAM
}

#undef tid
extern "C" void kernel_launch(void* const* d_in, const int* in_sizes, int n_in, void* d_out, int out_size, void* d_ws, size_t ws_size, hipStream_t stream) {
    static int grid = 0;
    if (grid == 0) {
        if (n_in != 28 || in_sizes[0] != MTOK * DM || out_size != MTOK * DM || ws_size < WS_END) { fprintf(stderr, "kernel_launch: unexpected shapes (n_in %d, in0 %d, out %d, ws %zu)\n", n_in, n_in > 0 ? in_sizes[0] : -1, out_size, ws_size); grid = -1; return; }
        int dev = 0, cus = 0;
        if (hipGetDevice(&dev) != hipSuccess || hipDeviceGetAttribute(&cus, hipDeviceAttributeMultiprocessorCount, dev) != hipSuccess) { grid = -1; return; }
        if (hipFuncSetAttribute((const void*)mk_fwd, hipFuncAttributeMaxDynamicSharedMemorySize, LDS_BYTES) != hipSuccess) { fprintf(stderr, "kernel_launch: hipFuncSetAttribute failed\n"); grid = -1; return; }
        (void)hipGetLastError();
        grid = cus;
    }
    if (grid < 0) return;
    if (hipMemsetAsync((char*)d_ws + WS_CTL, 0, CTL_ZERO_BYTES, stream) != hipSuccess) return;
    Args a{};
    for (int i = 0; i < 28; ++i) a.in[i] = (const float*)d_in[i];
    a.out = (float*)d_out; a.ws = (unsigned char*)d_ws;
    for (int li = 0; li < MK_N_LAUNCHES; ++li) {
        if (MK_N_LAUNCHES == 1) { a.ph_lo = 0; a.ph_hi = N_PHASES; }
        else { a.ph_lo = li * N_PHASES / MK_N_LAUNCHES; a.ph_hi = (li + 1) * N_PHASES / MK_N_LAUNCHES; }
        a.li = (MK_N_LAUNCHES == N_PHASES) ? 0 : li;
        hipLaunchKernelGGL(mk_fwd, dim3(grid), dim3(NWAVES * 64), LDS_BYTES, stream, a);
    }
}
```

```cpp
#include <hip/hip_runtime.h>
#include <hip/hip_bf16.h>
#include <cstdio>
#include <cstdint>
#include <cmath>

#ifndef PROBE_CATS
#define PROBE_CATS 0x1ff
#endif
#ifndef MK_N_LAUNCHES
#define MK_N_LAUNCHES 1
#define P7_TOPK_TILES 0
#define P6_TILES 2048
#endif
constexpr int N_PHASES = 11;
constexpr int NWAVES = 8;

constexpr int DM = 1024, BATCH = 4, SEQ = 8192, MTOK = BATCH * SEQ;
constexpr int HYW = 512, HYIN = 1536, ATTW = 512, KVW = 128, INW = 4352, NHEAD = 8, NKV = 2, HD = 64;
constexpr int NEXP = 16, CAP = 1024, DFF = 2048;
constexpr float EPSV = 1e-6f;

constexpr size_t MiB = 1u << 20;
constexpr size_t WS_CTL = 0, CTL_ZERO_BYTES = 1 * MiB;
constexpr size_t WS_MOD = 1 * MiB;
constexpr size_t WS_ROPE = 1 * MiB + 128 * 1024;
constexpr size_t WS_BPERM = 1 * MiB + 256 * 1024;
constexpr size_t WS_ROWSQ = 2 * MiB;
constexpr size_t WS_AFF = 4 * MiB;
constexpr size_t WS_SLOT = 6 * MiB;
constexpr size_t WS_TOPI = 8 * MiB;
constexpr size_t WS_TOPW = 8 * MiB + 256 * 1024;
constexpr size_t WS_WIN = 10 * MiB;
constexpr size_t WS_WHY = 19 * MiB;
constexpr size_t WS_WAT = 20 * MiB;
constexpr size_t WS_WO = 21 * MiB;
constexpr size_t WS_HN = 24 * MiB;
constexpr size_t WS_YAT = 24 * MiB;
constexpr size_t WS_HRAW = 88 * MiB;
constexpr size_t WS_ZC = 56 * MiB;
constexpr size_t WS_ZHY = 152 * MiB;
constexpr size_t WS_Q = 248 * MiB;
constexpr size_t WS_K = 280 * MiB;
constexpr size_t WS_V = 288 * MiB;
constexpr size_t WS_GATE = 296 * MiB;
constexpr size_t WS_YHY = 424 * MiB;
constexpr size_t WS_M = 456 * MiB;
constexpr size_t WS_Y1S = 520 * MiB;
constexpr size_t WS_WGU = 10 * MiB;
constexpr size_t WS_WD = 74 * MiB;
constexpr size_t WS_H2 = 106 * MiB;
constexpr size_t WS_ACT = 138 * MiB;
constexpr size_t WS_YE = 266 * MiB;
constexpr size_t WS_PROBE = 536 * MiB;
constexpr size_t WS_END = 540 * MiB;
constexpr int CW_BAR = 4096;

constexpr int LDS_SCRATCH = 147456;
constexpr int LDSCTL_OFF = LDS_SCRATCH, MISC_OFF = LDSCTL_OFF + 320;
constexpr int LDS_BYTES = 151552;

#define GAS __attribute__((address_space(1)))
#define LAS __attribute__((address_space(3)))
typedef unsigned short bf16;
typedef unsigned v4u __attribute__((ext_vector_type(4)));
typedef unsigned v2u __attribute__((ext_vector_type(2)));
typedef float f32x4 __attribute__((ext_vector_type(4)));
typedef float f32x2 __attribute__((ext_vector_type(2)));
typedef short bf16x8 __attribute__((ext_vector_type(8)));
typedef GAS unsigned gu32;
#define RLX_AGENT __ATOMIC_RELAXED, __HIP_MEMORY_SCOPE_AGENT
#define LDS_WAIT() asm volatile("s_waitcnt lgkmcnt(0)" ::: "memory")
#define VM_WAIT() asm volatile("s_waitcnt vmcnt(0)" ::: "memory")

__device__ __forceinline__ unsigned f2bf(float f) { unsigned u = __builtin_bit_cast(unsigned, f); return (u + 0x7fffu + ((u >> 16) & 1u)) >> 16; }
__device__ __forceinline__ unsigned pk2(float lo, float hi) { return f2bf(lo) | (f2bf(hi) << 16); }
__device__ __forceinline__ unsigned pk4_fp8(float a, float b, float c, float d) { int r = 0; r = __builtin_amdgcn_cvt_pk_fp8_f32(a, b, r, false); r = __builtin_amdgcn_cvt_pk_fp8_f32(c, d, r, true); return (unsigned)r; }
__device__ __forceinline__ float sat8(float a) { return __builtin_amdgcn_fmed3f(a, -448.0f, 448.0f); }
__device__ __forceinline__ unsigned char f2fp8(float a) { return (unsigned char)(__builtin_amdgcn_cvt_pk_fp8_f32(sat8(a), 0.f, 0, false) & 0xff); }
__device__ __forceinline__ float fp82f(unsigned char h) { return __builtin_amdgcn_cvt_f32_fp8((int)h, 0); }
__device__ __forceinline__ float bf2f(unsigned short h) { return __builtin_bit_cast(float, (unsigned)h << 16); }
__device__ __forceinline__ float bflo(unsigned w) { return __builtin_bit_cast(float, w << 16); }
__device__ __forceinline__ float bfhi(unsigned w) { return __builtin_bit_cast(float, w & 0xffff0000u); }
#define DPP_ADD(v, CTRL) (v) += __builtin_bit_cast(float, __builtin_amdgcn_update_dpp(0, __builtin_bit_cast(int, (v)), (CTRL), 0xF, 0xF, true))
__device__ __forceinline__ float row16_sum(float v) {
    DPP_ADD(v, 0xB1); DPP_ADD(v, 0x4E); DPP_ADD(v, 0x141); DPP_ADD(v, 0x140);
    return v;
}
__device__ __forceinline__ float row16_max(float v) {
#define DPP_MAX(CTRL) v = fmaxf(v, __builtin_bit_cast(float, __builtin_amdgcn_update_dpp(0, __builtin_bit_cast(int, v), (CTRL), 0xF, 0xF, true)))
    DPP_MAX(0xB1); DPP_MAX(0x4E); DPP_MAX(0x141); DPP_MAX(0x140);
#undef DPP_MAX
    return v;
}
__device__ __forceinline__ float wave_sum(float v) {
    v = row16_sum(v);
    const int b = __builtin_bit_cast(int, v);
    const float r0 = __builtin_bit_cast(float, __builtin_amdgcn_readlane(b, 0)), r1 = __builtin_bit_cast(float, __builtin_amdgcn_readlane(b, 16)), r2 = __builtin_bit_cast(float, __builtin_amdgcn_readlane(b, 32)), r3 = __builtin_bit_cast(float, __builtin_amdgcn_readlane(b, 48));
    return (r0 + r1) + (r2 + r3);
}
__device__ __forceinline__ int pinv32(int j) { return 16 * ((j >> 2) & 1) + 4 * (j >> 3) + (j & 3); }

__device__ __forceinline__ int my_tid(int wid_s) { int l; asm volatile("v_mbcnt_lo_u32_b32 %0, -1, 0\n\tv_mbcnt_hi_u32_b32 %0, -1, %0" : "=v"(l)); return wid_s * 64 + l; }
struct Args { const float* in[28]; float* out; unsigned char* ws; int ph_lo, ph_hi, li, pad; };

namespace pg8 {
constexpr int BM = 256, BK = 64, HALF = 128, HTB = HALF * BK * 2, STAGE_BYTES = 8 * HTB, NXCD = 8, WGM = 8;
__host__ __device__ __forceinline__ int lds_byte(int r, int c) { const int st = (r >> 4) * 2 + (c >> 5), rr = r & 15, cc = c & 31, ob = rr * 64 + cc * 2; return st * 1024 + (ob ^ (((ob >> 9) & 1) << 5)); }
__host__ __device__ __forceinline__ void stage_rc(int b, int& R, int& C) { const int st = b / 1024, sb = b % 1024, swz = sb ^ (((sb >> 9) & 1) << 5); R = (st >> 1) * 16 + swz / 64; C = (st & 1) * 32 + (swz % 64) / 2; }

struct Unit { int pm, pn, aux; const char* A; const char* B; };

struct StaticOrder {
    int nM, nN, nwg, G, c, lda, K; const char* Ab; const char* Bb;
    __device__ __forceinline__ void init(const void* A, const void* Bt, int M, int N, int K_, int lda_, int G_, int c_) { nM = M / BM; nN = N / BM; nwg = nM * nN; G = G_; c = c_; lda = lda_; K = K_; Ab = (const char*)A; Bb = (const char*)Bt; }
    __device__ __forceinline__ bool next(int i, Unit& u) const {
        const long L = (long)i * G + c; if (L >= nwg) return false;
        int wgid = (int)L; { const int q = nwg / NXCD, r = nwg % NXCD, xcd = wgid % NXCD, off = wgid / NXCD; wgid = (xcd < r ? xcd * (q + 1) : r * (q + 1) + (xcd - r) * q) + off; }
        const int nig = WGM * nN, gid = wgid / nig, fm = gid * WGM, gsz = (nM - fm) < WGM ? (nM - fm) : WGM;
        u.pm = fm + ((wgid % nig) % gsz); u.pn = (wgid % nig) / gsz; u.aux = i;
        u.A = Ab + (size_t)u.pm * BM * lda * 2; u.B = Bb + (size_t)u.pn * BM * K * 2; return true;
    }
    __device__ __forceinline__ void voff(const Unit&, int tid, unsigned (&v)[2][2]) const {
#pragma unroll
        for (int i = 0; i < 2; ++i) { int R, C; stage_rc(tid * 16 + i * 8192, R, C);
#pragma unroll
            for (int h = 0; h < 2; ++h) v[h][i] = (unsigned)((h * HALF + R) * lda + C) * 2u; }
    }
};

template <class Epi, class Sched, bool FP8 = false>
__device__ __forceinline__ void gemm_phase(LAS unsigned char* lds, const int K, const Sched& S, const Epi& E, int tid, const int wscale = 0x7F7F7F7F, const int ascale = 0x7F7F7F7F) {
    typedef int v4i_t __attribute__((ext_vector_type(4))); typedef int v8i_t __attribute__((ext_vector_type(8)));
    asm volatile("" : "+v"(tid) :: "memory");
    const int wid = __builtin_amdgcn_readfirstlane(tid >> 6), lane = tid & 63, wr = wid >> 2, wc = wid & 3, fr = lane & 15, fq = lane >> 4;
    const int nt = K / BK;
    unsigned voffB[2];
#pragma unroll
    for (int i = 0; i < 2; ++i) { int R, C; stage_rc(tid * 16 + i * 8192, R, C); voffB[i] = (unsigned)(R * K + C) * 2u; }
    const size_t kstep = (size_t)(BK * 2);
    const size_t hstep = (size_t)HALF * K * 2;
    const unsigned ldsw = (unsigned)wid * 1024u;
    const int aoff = lds_byte(wr * 64 + fr, fq * 8), boff = lds_byte(wc * 32 + fr, fq * 8);
#define PG8_SA(b, h) (((b) * 2 + (h)) * HTB)
#define PG8_SB(b, h) ((4 + (b) * 2 + (h)) * HTB)
#define PG8_STAGE(bufoff, gbase, voff) do { _Pragma("unroll") for (int _i = 0; _i < 2; ++_i) \
        __builtin_amdgcn_global_load_lds((const unsigned*)((const char*)(gbase) + (voff)[_i]), (LAS unsigned*)(lds + (bufoff) + ldsw + _i * 8192), 16, 0, 0); } while (0)
#define PG8_LDA(dst, b, h) do { if constexpr (FP8) { _Pragma("unroll") for (int m = 0; m < 4; ++m) { const v4i_t lo_ = *(const LAS v4i_t*)(lds + PG8_SA(b, h) + aoff + m * 2048), hi_ = *(const LAS v4i_t*)(lds + PG8_SA(b, h) + aoff + m * 2048 + 1024); dst##8[m] = __builtin_shufflevector(lo_, hi_, 0, 1, 2, 3, 4, 5, 6, 7); } } \
        else { _Pragma("unroll") for (int m = 0; m < 4; ++m) _Pragma("unroll") for (int k = 0; k < 2; ++k) dst[m][k] = *(const LAS bf16x8*)(lds + PG8_SA(b, h) + aoff + m * 2048 + k * 1024); } } while (0)
#define PG8_LDB(dst, b, h) do { if constexpr (FP8) { _Pragma("unroll") for (int n = 0; n < 2; ++n) { const v4i_t lo_ = *(const LAS v4i_t*)(lds + PG8_SB(b, h) + boff + n * 2048), hi_ = *(const LAS v4i_t*)(lds + PG8_SB(b, h) + boff + n * 2048 + 1024); dst##8[n] = __builtin_shufflevector(lo_, hi_, 0, 1, 2, 3, 4, 5, 6, 7); } } \
        else { _Pragma("unroll") for (int n = 0; n < 2; ++n) _Pragma("unroll") for (int k = 0; k < 2; ++k) dst[n][k] = *(const LAS bf16x8*)(lds + PG8_SB(b, h) + boff + n * 2048 + k * 1024); } } while (0)
#define PG8_MMA(ai, bj, At, Bt) do { __builtin_amdgcn_s_setprio(1); \
        if constexpr (FP8) { _Pragma("unroll") for (int m = 0; m < 4; ++m) _Pragma("unroll") for (int n = 0; n < 2; ++n) \
            asm volatile("s_nop 1\n\tv_mfma_scale_f32_16x16x128_f8f6f4 %0, %1, %2, %0, %3, %4 op_sel_hi:[0,0,0]" : "+v"(acc[ai][bj][m][n]) : "v"(Bt##8[n]), "v"(At##8[m]), "v"(wsc_), "v"(asc_)); } \
        else { _Pragma("unroll") for (int m = 0; m < 4; ++m) _Pragma("unroll") for (int n = 0; n < 2; ++n) _Pragma("unroll") for (int k = 0; k < 2; ++k) \
            acc[ai][bj][m][n] = __builtin_amdgcn_mfma_f32_16x16x32_bf16(Bt[n][k], At[m][k], acc[ai][bj][m][n], 0, 0, 0); } \
        __builtin_amdgcn_s_setprio(0); } while (0)
#define PG8_WAIT_V(n) asm volatile("s_waitcnt vmcnt(" #n ")" ::: "memory")
#define PG8_WAIT_L(n) asm volatile("s_waitcnt lgkmcnt(" #n ")" ::: "memory")
#define PG8_BAR __builtin_amdgcn_s_barrier()
#define PG8_SCHED __builtin_amdgcn_sched_barrier(0)
    Unit cur, nxt; int ui = 0;
    if (!S.next(0, cur)) return;
    unsigned vc[2][2], vn[2][2];
    S.voff(cur, tid, vc);
    f32x4 acc[2][2][4][2];
#pragma unroll
    for (int a = 0; a < 2; ++a)
#pragma unroll
        for (int b = 0; b < 2; ++b)
#pragma unroll
            for (int m = 0; m < 4; ++m)
#pragma unroll
                for (int n = 0; n < 2; ++n) acc[a][b][m][n] = (f32x4){0.f, 0.f, 0.f, 0.f};
    bf16x8 At[4][2], B0[2][2], B1[2][2]; v8i_t At8[4], B08[2], B18[2]; const int wsc_ = wscale, asc_ = ascale;
    const char* cA = cur.A; const char* cB = cur.B;
    PG8_STAGE(PG8_SB(0, 0), cB, voffB); PG8_STAGE(PG8_SB(0, 1), cB + hstep, voffB); PG8_STAGE(PG8_SA(0, 0), cA, vc[0]); PG8_STAGE(PG8_SA(0, 1), cA, vc[1]);
    if (wr == 1) PG8_BAR;
    PG8_WAIT_V(2); PG8_BAR;
    PG8_STAGE(PG8_SB(1, 0), cB + kstep, voffB); PG8_STAGE(PG8_SA(1, 0), cA + kstep, vc[0]); PG8_STAGE(PG8_SB(1, 1), cB + hstep + kstep, voffB);
    PG8_WAIT_V(6); PG8_BAR;
    for (;;) {
        const bool has_next = S.next(ui + 1, nxt);
        const char* nA = has_next ? nxt.A : cA; const char* nB = has_next ? nxt.B : cB;
#pragma unroll 1
        for (int t = 0; t < nt; t += 2) {
            const bool last = (t == nt - 2);
            if (last) { if (has_next) S.voff(nxt, tid, vn); else {
#pragma unroll
                for (int h = 0; h < 2; ++h)
#pragma unroll
                    for (int i = 0; i < 2; ++i) vn[h][i] = vc[h][i]; } }
            const char* a1 = cA + (size_t)(t + 1) * kstep;
            const char* a2 = last ? nA : cA + (size_t)(t + 2) * kstep; const char* b2 = last ? nB : cB + (size_t)(t + 2) * kstep;
            const char* a3 = a2 + kstep; const char* b3 = b2 + kstep;
            unsigned s0[2], s1[2];
            s0[0] = last ? vn[0][0] : vc[0][0]; s0[1] = last ? vn[0][1] : vc[0][1]; s1[0] = last ? vn[1][0] : vc[1][0]; s1[1] = last ? vn[1][1] : vc[1][1];
            PG8_LDB(B0, 0, 0); PG8_LDB(B1, 0, 1); PG8_SCHED; PG8_LDA(At, 0, 0); PG8_STAGE(PG8_SA(1, 1), a1, vc[1]);
            PG8_WAIT_V(8); PG8_WAIT_L(0); PG8_BAR; PG8_MMA(0, 0, At, B0); PG8_MMA(0, 1, At, B1); PG8_BAR; PG8_SCHED;
            PG8_LDA(At, 0, 1); PG8_STAGE(PG8_SB(0, 0), b2, voffB); PG8_STAGE(PG8_SB(0, 1), b2 + hstep, voffB); PG8_STAGE(PG8_SA(0, 0), a2, s0);
            PG8_WAIT_V(8); PG8_WAIT_L(0); PG8_BAR; PG8_MMA(1, 0, At, B0); PG8_MMA(1, 1, At, B1); PG8_BAR; PG8_SCHED;
            PG8_LDB(B0, 1, 0); PG8_LDB(B1, 1, 1); PG8_SCHED; PG8_LDA(At, 1, 0); PG8_STAGE(PG8_SA(0, 1), a2, s1);
            PG8_WAIT_V(8); PG8_WAIT_L(0); PG8_BAR; PG8_MMA(0, 0, At, B0); PG8_MMA(0, 1, At, B1); PG8_BAR; PG8_SCHED;
            PG8_LDA(At, 1, 1); PG8_STAGE(PG8_SB(1, 0), b3, voffB); PG8_STAGE(PG8_SB(1, 1), b3 + hstep, voffB); PG8_STAGE(PG8_SA(1, 0), a3, s0);
            PG8_WAIT_V(8); PG8_WAIT_L(0); PG8_BAR; PG8_MMA(1, 0, At, B0); PG8_MMA(1, 1, At, B1); PG8_BAR; PG8_SCHED;
        }
        if (wr == 0) PG8_BAR;
        if constexpr (FP8) asm volatile("s_nop 15\n\ts_nop 15" ::: "memory");
        { int fr_ = fr, fq_ = fq; asm volatile("" : "+v"(fr_), "+v"(fq_) : "s"(ui));
          E(acc, cur, wr, wc, fr_, fq_); }
        if (!has_next) break;
        if (!(Epi::CARRY && (cur.aux & 1) == 0)) {
#pragma unroll
        for (int a = 0; a < 2; ++a)
#pragma unroll
            for (int b = 0; b < 2; ++b)
#pragma unroll
                for (int m = 0; m < 4; ++m)
#pragma unroll
                    for (int n = 0; n < 2; ++n) acc[a][b][m][n] = (f32x4){0.f, 0.f, 0.f, 0.f}; }
        cur = nxt; cA = nA; cB = nB; ++ui;
#pragma unroll
        for (int h = 0; h < 2; ++h)
#pragma unroll
            for (int i = 0; i < 2; ++i) vc[h][i] = vn[h][i];
        if (wr == 1) PG8_BAR;
    }
    PG8_WAIT_V(0);
    PG8_BAR;
#undef PG8_SA
#undef PG8_SB
#undef PG8_STAGE
#undef PG8_LDA
#undef PG8_LDB
#undef PG8_MMA
#undef PG8_WAIT_V
#undef PG8_WAIT_L
#undef PG8_BAR
#undef PG8_SCHED
}
}

constexpr float C2Q = 0.125f * 1.4426950408889634f;

struct EpiIn {
    static constexpr bool CARRY = false;
    bf16* zhy; bf16* q; bf16* k; bf16* v; bf16* gate; const float* bperm; const float* qgain; const float* kgain; const float* cs;
    __device__ __forceinline__ void operator()(const f32x4 (&acc)[2][2][4][2], const pg8::Unit& u, int wr, int wc, int fr, int fq) const {
        const int pn = u.pn; const int row0 = u.pm * 256 + wr * 64 + fr;
        f32x4 bv[2][2];
#pragma unroll
        for (int bj = 0; bj < 2; ++bj)
#pragma unroll
            for (int n = 0; n < 2; ++n) bv[bj][n] = *(const f32x4*)(bperm + pn * 256 + bj * 128 + wc * 32 + n * 16 + 4 * fq);
        if (pn < 6) {
            const int colt = pn * 256 + wc * 32 + 8 * fq;
#pragma unroll
            for (int ai = 0; ai < 2; ++ai)
#pragma unroll
                for (int m = 0; m < 4; ++m) { bf16* rowp = zhy + (size_t)(row0 + ai * 128 + m * 16) * HYIN + colt;
#pragma unroll
                    for (int bj = 0; bj < 2; ++bj) { const f32x4 v0 = acc[ai][bj][m][0] + bv[bj][0], v1 = acc[ai][bj][m][1] + bv[bj][1];
                        v4u w; w.x = pk2(v0[0], v0[1]); w.y = pk2(v0[2], v0[3]); w.z = pk2(v1[0], v1[1]); w.w = pk2(v1[2], v1[3]);
                        *(v4u*)(rowp + bj * 128) = w; } }
        } else if (pn < 9) {
            const bool isq = pn < 8; const bool isv = (!isq) && (wc >= 2);
            const float* gain = isq ? qgain : kgain;
            f32x4 gv[2][2];
#pragma unroll
            for (int bj = 0; bj < 2; ++bj)
#pragma unroll
                for (int n = 0; n < 2; ++n) gv[bj][n] = *(const f32x4*)(gain + bj * 32 + n * 16 + 4 * fq);
            bf16* obase; int pitch, hcol;
            if (isq) { obase = q; pitch = ATTW; hcol = ((pn - 6) * 4 + wc) * 64; }
            else if (!isv) { obase = k; pitch = KVW; hcol = wc * 64; }
            else { obase = v; pitch = KVW; hcol = (wc - 2) * 64; }
            const float osc = isq ? C2Q : 1.0f;
#pragma unroll
            for (int ai = 0; ai < 2; ++ai)
#pragma unroll
                for (int m = 0; m < 4; ++m) { const int row = row0 + ai * 128 + m * 16; const int t = row & (SEQ - 1);
                    f32x4 y[2][2]; float ss = 0.f;
#pragma unroll
                    for (int bj = 0; bj < 2; ++bj)
#pragma unroll
                        for (int n = 0; n < 2; ++n) { y[bj][n] = acc[ai][bj][m][n] + bv[bj][n]; ss += (y[bj][n][0] * y[bj][n][0] + y[bj][n][1] * y[bj][n][1]) + (y[bj][n][2] * y[bj][n][2] + y[bj][n][3] * y[bj][n][3]); }
                    bf16* orow = obase + (size_t)row * pitch + hcol + 4 * fq;
                    if (!isv) {
                        ss += __shfl_xor(ss, 16); ss += __shfl_xor(ss, 32);
                        const float rstd = 1.0f / sqrtf(ss * (1.0f / 64.0f) + EPSV);
#pragma unroll
                        for (int bj = 0; bj < 2; ++bj) { const int pos = bj == 0 ? (t >> 6) : (t & 63);
                            const f32x4 cc = *(const f32x4*)(cs + pos * 32 + 4 * fq), sn = *(const f32x4*)(cs + pos * 32 + 16 + 4 * fq);
                            const f32x4 u1 = y[bj][0] * rstd * gv[bj][0], u2 = y[bj][1] * rstd * gv[bj][1];
                            y[bj][0] = (u1 * cc - u2 * sn) * osc; y[bj][1] = (u1 * sn + u2 * cc) * osc; }
                    }
#pragma unroll
                    for (int bj = 0; bj < 2; ++bj)
#pragma unroll
                        for (int n = 0; n < 2; ++n) { v2u w; w.x = pk2(y[bj][n][0], y[bj][n][1]); w.y = pk2(y[bj][n][2], y[bj][n][3]); *(v2u*)(orow + bj * 32 + n * 16) = w; } }
        } else {
            const int colt = (pn - 9) * 256 + wc * 32 + 8 * fq;
#pragma unroll
            for (int ai = 0; ai < 2; ++ai)
#pragma unroll
                for (int m = 0; m < 4; ++m) { bf16* rowp = gate + (size_t)(row0 + ai * 128 + m * 16) * 2048 + colt;
#pragma unroll
                    for (int bj = 0; bj < 2; ++bj) { f32x4 v0 = acc[ai][bj][m][0] + bv[bj][0], v1 = acc[ai][bj][m][1] + bv[bj][1];
#pragma unroll
                        for (int e = 0; e < 4; ++e) { v0[e] = 1.0f / (1.0f + __expf(-v0[e])); v1[e] = 1.0f / (1.0f + __expf(-v1[e])); }
                        v4u w; w.x = pk2(v0[0], v0[1]); w.y = pk2(v0[2], v0[3]); w.z = pk2(v1[0], v1[1]); w.w = pk2(v1[2], v1[3]);
                        *(v4u*)(rowp + bj * 128) = w; } }
        }
    }
};

template <int MODE> struct EpiMerge {
    static constexpr bool CARRY = false;
    bf16* mbuf; const bf16* gate; int gcol0;
    __device__ __forceinline__ void operator()(const f32x4 (&acc)[2][2][4][2], const pg8::Unit& u, int wr, int wc, int fr, int fq) const {
        const int row0 = u.pm * 256 + wr * 64 + fr; const int col0 = u.pn * 256 + wc * 32 + 8 * fq;
#pragma unroll
        for (int ai = 0; ai < 2; ++ai) {
            v4u g[4][2], p[4][2];
#pragma unroll
            for (int m = 0; m < 4; ++m) { const size_t row = (size_t)(row0 + ai * 128 + m * 16);
#pragma unroll
                for (int bj = 0; bj < 2; ++bj) { g[m][bj] = *(const v4u*)(gate + row * 2048 + gcol0 + col0 + bj * 128); if (MODE == 1) p[m][bj] = *(const v4u*)(mbuf + row * DM + col0 + bj * 128); } }
#pragma unroll
            for (int m = 0; m < 4; ++m) { const size_t row = (size_t)(row0 + ai * 128 + m * 16);
#pragma unroll
                for (int bj = 0; bj < 2; ++bj) { const v4u gv = g[m][bj];
                    f32x4 v0 = acc[ai][bj][m][0], v1 = acc[ai][bj][m][1];
                    v0[0] *= bflo(gv.x); v0[1] *= bfhi(gv.x); v0[2] *= bflo(gv.y); v0[3] *= bfhi(gv.y); v1[0] *= bflo(gv.z); v1[1] *= bfhi(gv.z); v1[2] *= bflo(gv.w); v1[3] *= bfhi(gv.w);
                    if (MODE == 1) { const v4u pv = p[m][bj]; v0[0] += bflo(pv.x); v0[1] += bfhi(pv.x); v0[2] += bflo(pv.y); v0[3] += bfhi(pv.y); v1[0] += bflo(pv.z); v1[1] += bfhi(pv.z); v1[2] += bflo(pv.w); v1[3] += bfhi(pv.w); }
                    v4u w; w.x = pk2(v0[0], v0[1]); w.y = pk2(v0[2], v0[3]); w.z = pk2(v1[0], v1[1]); w.w = pk2(v1[2], v1[3]);
                    *(v4u*)(mbuf + row * DM + col0 + bj * 128) = w; } } }
    }
};


struct EpiMergeR {
    static constexpr bool CARRY = true;
    unsigned char* mbuf; const bf16* gate;
    __device__ __forceinline__ void operator()(f32x4 (&acc)[2][2][4][2], const pg8::Unit& u, int wr, int wc, int fr, int fq) const {
        const int row0 = u.pm * 256 + wr * 64 + fr; const int col0 = u.pn * 256 + wc * 32 + 8 * fq; const bool first = (u.aux & 1) == 0;
#pragma unroll
        for (int ai = 0; ai < 2; ++ai) {
            v4u ga[4][2], gh[4][2];
#pragma unroll
            for (int m = 0; m < 4; ++m) { const size_t row = (size_t)(row0 + ai * 128 + m * 16);
#pragma unroll
                for (int bj = 0; bj < 2; ++bj) { ga[m][bj] = *(const v4u*)(gate + row * 2048 + 1024 + col0 + bj * 128); if (first) gh[m][bj] = *(const v4u*)(gate + row * 2048 + col0 + bj * 128); } }
#pragma unroll
            for (int m = 0; m < 4; ++m) { const size_t row = (size_t)(row0 + ai * 128 + m * 16);
#pragma unroll
                for (int bj = 0; bj < 2; ++bj) { const v4u a = ga[m][bj];
                    float g8[8] = {bflo(a.x), bfhi(a.x), bflo(a.y), bfhi(a.y), bflo(a.z), bfhi(a.z), bflo(a.w), bfhi(a.w)};
                    if (first) { const v4u h = gh[m][bj]; const float h8[8] = {bflo(h.x), bfhi(h.x), bflo(h.y), bfhi(h.y), bflo(h.z), bfhi(h.z), bflo(h.w), bfhi(h.w)};
#pragma unroll
                        for (int e = 0; e < 4; ++e) { acc[ai][bj][m][0][e] *= h8[e] * __builtin_amdgcn_rcpf(fmaxf(g8[e], 1e-30f)); acc[ai][bj][m][1][e] *= h8[4 + e] * __builtin_amdgcn_rcpf(fmaxf(g8[4 + e], 1e-30f)); } }
                    else { const f32x4 v0 = acc[ai][bj][m][0], v1 = acc[ai][bj][m][1];
                        v2u w; w.x = pk4_fp8(sat8(v0[0] * g8[0] * 64.0f), sat8(v0[1] * g8[1] * 64.0f), sat8(v0[2] * g8[2] * 64.0f), sat8(v0[3] * g8[3] * 64.0f)); w.y = pk4_fp8(sat8(v1[0] * g8[4] * 64.0f), sat8(v1[1] * g8[5] * 64.0f), sat8(v1[2] * g8[6] * 64.0f), sat8(v1[3] * g8[7] * 64.0f));
                        *(v2u*)(mbuf + row * DM + col0 + bj * 128) = w; } } } }
    }
};
struct MergeOrder {
    pg8::StaticOrder S; const char* A2; const char* B2;
    __device__ __forceinline__ bool next(int i, pg8::Unit& u) const { if (!S.next(i >> 1, u)) return false; u.aux = i; if (i & 1) { u.A = A2 + (size_t)u.pm * 256 * ATTW; u.B = B2 + (size_t)u.pn * 256 * ATTW; } return true; }
    __device__ __forceinline__ void voff(const pg8::Unit& u, int tid, unsigned (&v)[2][2]) const { S.voff(u, tid, v); }
};

struct EpiOut {
    static constexpr bool CARRY = false;
    const float* x; float* out; const float* mod; float* rowsq;
    __device__ __forceinline__ void operator()(const f32x4 (&acc)[2][2][4][2], const pg8::Unit& u, int wr, int wc, int fr, int fq) const {
        const int row0 = u.pm * 256 + wr * 64 + fr; const int col0 = u.pn * 256 + wc * 32 + 4 * fq; const int b = row0 >> 13;
        f32x4 gt[2][2];
#pragma unroll
        for (int bj = 0; bj < 2; ++bj)
#pragma unroll
            for (int n = 0; n < 2; ++n) gt[bj][n] = *(const f32x4*)(mod + b * 6144 + 2048 + col0 + bj * 128 + n * 16);
#pragma unroll
        for (int ai = 0; ai < 2; ++ai)
#pragma unroll
            for (int mp = 0; mp < 4; mp += 2) { f32x4 xv[2][2][2];
#pragma unroll
                for (int mm = 0; mm < 2; ++mm) { const size_t row = (size_t)(row0 + ai * 128 + (mp + mm) * 16);
#pragma unroll
                    for (int bj = 0; bj < 2; ++bj)
#pragma unroll
                        for (int n = 0; n < 2; ++n) xv[mm][bj][n] = *(const f32x4*)(x + row * DM + col0 + bj * 128 + n * 16); }
#pragma unroll
                for (int mm = 0; mm < 2; ++mm) { const int m = mp + mm; const size_t row = (size_t)(row0 + ai * 128 + m * 16); float ss = 0.f;
#pragma unroll
                    for (int bj = 0; bj < 2; ++bj)
#pragma unroll
                        for (int n = 0; n < 2; ++n) { const size_t off = row * DM + col0 + bj * 128 + n * 16;
                            const f32x4 o = xv[mm][bj][n] + gt[bj][n] * acc[ai][bj][m][n]; ss += (o[0] * o[0] + o[1] * o[1]) + (o[2] * o[2] + o[3] * o[3]); *(f32x4*)(out + off) = o; }
                    ss += __shfl_xor(ss, 16); ss += __shfl_xor(ss, 32);
                    if (fq == 0) rowsq[row * 16 + u.pn * 4 + wc] = ss; } }
    }
};

struct EpiSwiglu {
    static constexpr bool CARRY = false;
    unsigned char* act;
    __device__ __forceinline__ void operator()(const f32x4 (&acc)[2][2][4][2], const pg8::Unit& u, int wr, int wc, int fr, int fq) const {
        const int row0 = u.pm * 256 + wr * 64 + fr; const int col0 = u.pn * 128 + wc * 32 + 8 * fq;
#pragma unroll
        for (int ai = 0; ai < 2; ++ai)
#pragma unroll
            for (int m = 0; m < 4; ++m) { f32x4 a0 = acc[ai][0][m][0], a1 = acc[ai][0][m][1]; const f32x4 u0 = acc[ai][1][m][0], u1 = acc[ai][1][m][1];
#pragma unroll
                for (int e = 0; e < 4; ++e) { a0[e] = a0[e] / (1.0f + __expf(-a0[e])) * u0[e]; a1[e] = a1[e] / (1.0f + __expf(-a1[e])) * u1[e]; }
                v2u w; w.x = pk4_fp8(a0[0], a0[1], a0[2], a0[3]); w.y = pk4_fp8(a1[0], a1[1], a1[2], a1[3]);
                *(v2u*)(act + (size_t)(row0 + ai * 128 + m * 16) * DFF + col0) = w; }
    }
};

struct EpiDown {
    static constexpr bool CARRY = false;
    bf16* ye; const float* topw;
    __device__ __forceinline__ void operator()(const f32x4 (&acc)[2][2][4][2], const pg8::Unit& u, int wr, int wc, int fr, int fq) const {
        const int row0 = u.pm * 256 + wr * 64 + fr; const int col0 = u.pn * 256 + wc * 32 + 8 * fq;
        float tw[2][4];
#pragma unroll
        for (int ai = 0; ai < 2; ++ai)
#pragma unroll
            for (int m = 0; m < 4; ++m) tw[ai][m] = topw[row0 + ai * 128 + m * 16];
#pragma unroll
        for (int ai = 0; ai < 2; ++ai)
#pragma unroll
            for (int m = 0; m < 4; ++m) { const int row = row0 + ai * 128 + m * 16; const float w8 = tw[ai][m];
#pragma unroll
                for (int bj = 0; bj < 2; ++bj) { const f32x4 v0 = acc[ai][bj][m][0] * w8, v1 = acc[ai][bj][m][1] * w8;
                    v4u w; w.x = pk2(v0[0], v0[1]); w.y = pk2(v0[2], v0[3]); w.z = pk2(v1[0], v1[1]); w.w = pk2(v1[2], v1[3]);
                    *(v4u*)(ye + (size_t)row * DM + col0 + bj * 128) = w; } }
    }
};

struct MoeUpOrder {
    int G, c; const char* h2; const char* wgu; const LAS int* idx;
    __device__ __forceinline__ bool decode(long L, int& e, int& b, int& mblk, int& pn) const {
        if (L >= 4096) return false; e = (int)(L >> 8); const int w = (int)(L & 255), x = w & 7, j = w >> 3; pn = 2 * x + (j & 1); const int m16 = j >> 1; b = m16 >> 2; mblk = m16 & 3; return true; }
    __device__ __forceinline__ bool next(int i, pg8::Unit& u) const {
        int e, b, mblk, pn; if (!decode((long)i * G + c, e, b, mblk, pn)) return false;
        u.pm = (b * NEXP + e) * 4 + mblk; u.pn = pn; u.aux = i; u.A = h2 + (size_t)b * SEQ * DM; u.B = wgu + (size_t)(e * 16 + pn) * 256 * DM; return true; }
    __device__ __forceinline__ void voff(const pg8::Unit& u, int tid, unsigned (&v)[2][2]) const {
#pragma unroll
        for (int i = 0; i < 2; ++i) { int R, C; pg8::stage_rc(tid * 16 + i * 8192, R, C);
#pragma unroll
            for (int h = 0; h < 2; ++h) { const int tok = idx[(u.aux & 15) * 256 + h * 128 + R]; v[h][i] = (unsigned)(tok * (DM / 2) + C) * 2u; } }
    }
};
struct MoeDownOrder {
    int G, c; const char* act; const char* wd;
    __device__ __forceinline__ bool next(int i, pg8::Unit& u) const {
        const long L = (long)i * G + c; if (L >= 1024) return false;
        const int r = (int)(L >> 8), w = (int)(L & 255), x = w & 7, j = w >> 3; const int e = 4 * r + (x >> 1), pn = 2 * (x & 1) + (j & 1), m16 = j >> 1, b = m16 >> 2, mblk = m16 & 3;
        u.pm = (b * NEXP + e) * 4 + mblk; u.pn = pn; u.aux = i; u.A = act + (size_t)u.pm * 256 * DFF; u.B = wd + (size_t)(e * 4 + pn) * 256 * DFF; return true; }
    __device__ __forceinline__ void voff(const pg8::Unit&, int tid, unsigned (&v)[2][2]) const {
#pragma unroll
        for (int i = 0; i < 2; ++i) { int R, C; pg8::stage_rc(tid * 16 + i * 8192, R, C);
#pragma unroll
            for (int h = 0; h < 2; ++h) v[h][i] = (unsigned)((h * 128 + R) * (DFF / 2) + C) * 2u; }
    }
};

namespace attn_body {
using bf16h = __hip_bfloat16;
using s16x4 = __attribute__((ext_vector_type(4))) short;
using f32x16 = __attribute__((ext_vector_type(16))) float;
using u32x4 = __attribute__((ext_vector_type(4))) unsigned;
constexpr int D = 64, QP = ATTW, KP = KVW;
constexpr int NW = 8, QBLK = 32, QB = QBLK * NW, KVBLK = 64;
__device__ __forceinline__ int crow(int r, int hi) { return (r & 3) + 8 * (r >> 2) + 4 * hi; }
#define SBAR() __builtin_amdgcn_sched_barrier(0)
constexpr int NSLOT = 3, SLOTB = 8192;
constexpr int LDS_K = 0, LDS_V = NSLOT * SLOTB, LDS_WS = 2 * NSLOT * SLOTB, LDS_OST = LDS_WS + NW * 64 * 4, LDS_ATT_BYTES = LDS_OST + NW * 4096;
__device__ __forceinline__ void glds16(const void* gsrc, unsigned lds_dst) { unsigned keep;
  asm volatile("s_mov_b32 %0, m0\n\ts_mov_b32 m0, %2\n\ts_nop 0\n\tglobal_load_lds_dwordx4 %1, off\n\ts_mov_b32 m0, %0" : "=&s"(keep) : "v"(gsrc), "s"(lds_dst) : "memory"); }
__device__ __forceinline__ float max3f(float a, float b, float c) { float r; asm("v_max3_f32 %0, %1, %2, %3" : "=v"(r) : "v"(a), "v"(b), "v"(c)); return r; }
__device__ __forceinline__ float max2f(float a, float b) { float r; asm("v_max_f32_e32 %0, %1, %2" : "=v"(r) : "v"(a), "v"(b)); return r; }
__device__ __forceinline__ float fadd_s(float a, float b) { float r; asm("v_add_f32_e32 %0, %1, %2" : "=v"(r) : "v"(a), "v"(b)); return r; }
__device__ __forceinline__ float fsub_s(float a, float b) { float r; asm("v_sub_f32_e32 %0, %1, %2" : "=v"(r) : "v"(a), "v"(b)); return r; }
typedef float f32x2_t __attribute__((ext_vector_type(2))); typedef __bf16 bf16x2_t __attribute__((ext_vector_type(2)));
__device__ __forceinline__ unsigned cvtpk_s(float lo, float hi) { f32x2_t v = {lo, hi}; bf16x2_t b = __builtin_convertvector(v, bf16x2_t); return __builtin_bit_cast(unsigned, b); }
#define WAIT_BAR(N) asm volatile("s_waitcnt vmcnt(" #N ") lgkmcnt(0)\n\ts_barrier" ::: "memory")
__device__ __forceinline__ void qkt(f32x16& p0, f32x16& p1, const char* Kslot, const bf16x8* qr, const f32x16& negm, int r32, int hi) {
  const char* kb = Kslot + hi * 1024 + r32 * 16;
  #pragma unroll
  for (int d0 = 0; d0 < 4; ++d0) {
    const bf16x8 b0 = *reinterpret_cast<const bf16x8*>(kb + d0 * 2048);
    const bf16x8 b1 = *reinterpret_cast<const bf16x8*>(kb + d0 * 2048 + 512);
    if (d0 == 0) { p0 = __builtin_amdgcn_mfma_f32_32x32x16_bf16(b0, qr[0], negm, 0, 0, 0); p1 = __builtin_amdgcn_mfma_f32_32x32x16_bf16(b1, qr[0], negm, 0, 0, 0); }
    else { p0 = __builtin_amdgcn_mfma_f32_32x32x16_bf16(b0, qr[d0], p0, 0, 0, 0); p1 = __builtin_amdgcn_mfma_f32_32x32x16_bf16(b1, qr[d0], p1, 0, 0, 0); } }
}
typedef __attribute__((address_space(3))) const char* lds_cptr;
typedef short v4i16_t __attribute__((ext_vector_type(4)));
__device__ __forceinline__ void kload8(bf16x8* kf, lds_cptr kp) {
  kf[0] = *(const __attribute__((address_space(3))) bf16x8*)(kp);        kf[1] = *(const __attribute__((address_space(3))) bf16x8*)(kp + 512);
  kf[2] = *(const __attribute__((address_space(3))) bf16x8*)(kp + 2048); kf[3] = *(const __attribute__((address_space(3))) bf16x8*)(kp + 2560);
  kf[4] = *(const __attribute__((address_space(3))) bf16x8*)(kp + 4096); kf[5] = *(const __attribute__((address_space(3))) bf16x8*)(kp + 4608);
  kf[6] = *(const __attribute__((address_space(3))) bf16x8*)(kp + 6144); kf[7] = *(const __attribute__((address_space(3))) bf16x8*)(kp + 6656);
}
__device__ __forceinline__ void kload2(bf16x8* kf, lds_cptr kp, int j) { kf[2 * j] = *(const __attribute__((address_space(3))) bf16x8*)(kp + j * 2048); kf[2 * j + 1] = *(const __attribute__((address_space(3))) bf16x8*)(kp + j * 2048 + 512); }
__device__ __forceinline__ s16x4 vtr(lds_cptr p) { return __builtin_bit_cast(s16x4, __builtin_amdgcn_ds_read_tr16_b64_v4i16((__attribute__((address_space(3))) v4i16_t*)p)); }
__device__ __forceinline__ float rowmax(const f32x16& p0, const f32x16& p1) {
  float a = max3f(p0[0], p0[1], p1[0]), b = max3f(p0[2], p0[3], p1[1]); a = max3f(a, p1[2], p1[3]);
  #pragma unroll
  for (int r = 4; r < 16; r += 4) { a = max3f(a, p0[r], p0[r + 1]); b = max3f(b, p0[r + 2], p0[r + 3]); a = max3f(a, p1[r], p1[r + 1]); b = max3f(b, p1[r + 2], p1[r + 3]); }
  const float m = max2f(a, b);
  auto rr = __builtin_amdgcn_permlane32_swap(__float_as_uint(m), __float_as_uint(m), false, false);
  return max2f(__uint_as_float(rr[0]), __uint_as_float(rr[1]));
}
__device__ __forceinline__ void pv(f32x16* o, int vb, bf16x8 pa0, bf16x8 pa1, bf16x8 pa2, bf16x8 pa3) {
  #pragma unroll
  for (int d0 = 0; d0 < 2; ++d0) { s16x4 lo[4], hi[4];
    #pragma unroll
    for (int ks = 0; ks < 4; ++ks) {
      asm volatile("ds_read_b64_tr_b16 %0,%1 offset:%c2" : "=&v"(lo[ks]) : "v"(vb), "i"(d0 * 4096 + ks * 1024) : "memory");
      asm volatile("ds_read_b64_tr_b16 %0,%1 offset:%c2" : "=&v"(hi[ks]) : "v"(vb), "i"(d0 * 4096 + ks * 1024 + 512) : "memory"); }
    asm volatile("s_waitcnt lgkmcnt(0)" ::: "memory"); SBAR();
    #define PK(k) (bf16x8){lo[k][0], lo[k][1], lo[k][2], lo[k][3], hi[k][0], hi[k][1], hi[k][2], hi[k][3]}
    o[d0] = __builtin_amdgcn_mfma_f32_32x32x16_bf16(pa0, PK(0), o[d0], 0, 0, 0);
    o[d0] = __builtin_amdgcn_mfma_f32_32x32x16_bf16(pa1, PK(1), o[d0], 0, 0, 0);
    o[d0] = __builtin_amdgcn_mfma_f32_32x32x16_bf16(pa2, PK(2), o[d0], 0, 0, 0);
    o[d0] = __builtin_amdgcn_mfma_f32_32x32x16_bf16(pa3, PK(3), o[d0], 0, 0, 0);
    #undef PK
  }
}
template <int THRL, bool NOMAX> __device__ __forceinline__ void attn_unit(int b, int h, int qb, const bf16h* Q, const bf16h* __restrict__ K, const bf16h* __restrict__ V, bf16h* O, char* shm, int tid) {
  asm volatile("" : "+v"(tid) :: "memory");
  const int lane = tid & 63, r32 = lane & 31, hi = lane >> 5; const int wid = __builtin_amdgcn_readfirstlane(tid >> 6);
  const long rowbase = (long)b * SEQ; const int q0 = qb * QB; const int kvh = h >> 2;
  const bf16h* Qw = Q + (rowbase + q0 + wid * QBLK) * QP + h * D;
  const bf16h* Kh = K + rowbase * KP + kvh * D, *Vh = V + rowbase * KP + kvh * D;
  const unsigned lds0 = (unsigned)(uintptr_t)shm;
  float* wsf = (float*)(shm + LDS_WS) + wid * 64;
  const bf16h* ksrc = Kh + (long)lane * KP + wid * 8;
  const bf16h* vsrc = Vh + (long)(16 * (wid & 3) + (lane >> 2)) * KP + (wid >> 2) * 32 + (lane & 3) * 8;
  const unsigned kdst = lds0 + LDS_K + wid * 1024, vdst = lds0 + LDS_V + wid * 1024;
  #define DMA_K(t, slot) glds16(ksrc + (long)(t) * KVBLK * KP, (unsigned)__builtin_amdgcn_readfirstlane(kdst + (slot)))
  #define DMA_V(t, slot) glds16(vsrc + (long)(t) * KVBLK * KP, (unsigned)__builtin_amdgcn_readfirstlane(vdst + (slot)))
  const int vb0 = (int)(lds0 + LDS_V) + ((lane >> 4) & 1) * 32 + (lane & 3) * 8 + (4 * hi + ((lane & 15) >> 2)) * 64;
  const char* Kbase = shm + LDS_K; bf16x8 kf[8];
  const lds_cptr shm3 = (lds_cptr)shm; const lds_cptr kp0 = shm3 + LDS_K + hi * 1024 + r32 * 16; const lds_cptr vp0 = shm3 + LDS_V + ((lane >> 4) & 1) * 32 + (lane & 3) * 8 + (4 * hi + ((lane & 15) >> 2)) * 64;
  constexpr int NT = SEQ / KVBLK;
  DMA_K(0, 0); DMA_V(0, 0); DMA_K(1, SLOTB);
  bf16x8 qr[4];
  #pragma unroll
  for (int d0 = 0; d0 < 4; ++d0) qr[d0] = *reinterpret_cast<const bf16x8*>(&Qw[(long)r32 * QP + d0 * 16 + hi * 8]);
  float mhat = 0.f, l_reg = 0.f; f32x16 o[2]; o[0] = f32x16{}; o[1] = f32x16{}; f32x16 negm = f32x16{}; asm volatile("" : "+v"(negm));
  bool resc = false;
  #define START(P0, P1) do { resc = false; if (!NOMAX) { const float rm = rowmax(P0, P1); \
      const float dl = rm; mhat = fadd_s(mhat, dl); \
      _Pragma("unroll") for (int r = 0; r < 16; ++r) { P0[r] = fsub_s(P0[r], dl); P1[r] = fsub_s(P1[r], dl); } \
      _Pragma("unroll") for (int r = 0; r < 16; ++r) negm[r] = -mhat; asm volatile("" : "+v"(negm)); } \
    _Pragma("unroll") for (int r = 0; r < 16; ++r) P0[r] = __builtin_amdgcn_exp2f(P0[r]); } while (0)
  #define RESC() do { if (resc) { asm volatile("s_waitcnt lgkmcnt(0)" ::: "memory"); \
      _Pragma("unroll") for (int d_ = 0; d_ < 2; ++d_) _Pragma("unroll") for (int r = 0; r < 16; ++r) o[d_][r] *= wsf[crow(r, hi)]; } } while (0)
  f32x16 pA0, pA1, pB0, pB1;
  int sl_prev = 0, sl_cur = 0, sl_next = SLOTB;
  #define ROT() do { sl_prev = sl_cur; sl_cur = sl_next; sl_next = (sl_next == (NSLOT - 1) * SLOTB) ? 0 : sl_next + SLOTB; } while (0)
  DMA_K(2, 2 * SLOTB);
  WAIT_BAR(3);
  qkt(pA0, pA1, Kbase, qr, negm, r32, hi); asm volatile("s_nop 15\n\ts_nop 7" : "+v"(pA0), "+v"(pA1));
  START(pA0, pA1);
  _Pragma("unroll") for (int r = 0; r < 16; ++r) pA1[r] = __builtin_amdgcn_exp2f(pA1[r]);
  WAIT_BAR(0);
  DMA_K(3, 0); DMA_V(1, SLOTB);
  ROT();
  kload8(kf, kp0 + sl_cur);
  WAIT_BAR(2);
  s16x4 vlo[8], vhi[8]; u32x4 pw0, pw1, pw2, pw3;
  #define PKW(P, B) cvtpk_s(P[B], P[B + 1])
  #define PAF(k) __builtin_bit_cast(bf16x8, pw##k)
  #define VFR(i) (bf16x8){vlo[i][0], vlo[i][1], vlo[i][2], vlo[i][3], vhi[i][0], vhi[i][1], vhi[i][2], vhi[i][3]}
  #define PIN(x) asm volatile("" : "+v"(x))
  #define MX3(a, b, c) __builtin_fmaxf(__builtin_fmaxf((a), (b)), (c))
  #define GAPA(MF, A0, A1, A2, A3, W0, W1, PW) do { MF; sacc += A0; sacc += A1; sacc += A2; sacc += A3; PIN(sacc); W0; W1; PIN(PW); SBAR(); } while (0)
  #define EX(v) __builtin_amdgcn_exp2f(v)
  #define GAPB(MF, X, B) do { MF; X[B] = EX(X[B]); X[B + 1] = EX(X[B + 1]); X[B + 2] = EX(X[B + 2]); X[B + 3] = EX(X[B + 3]); PIN(X); SBAR(); } while (0)
  #define VRD(i) do { vlo[i] = vtr(vp_ + (((i) >> 2) * 4096 + ((i) & 3) * 1024)); vhi[i] = vtr(vp_ + (((i) >> 2) * 4096 + ((i) & 3) * 1024 + 512)); } while (0)
  #define KRD(G, j) do { if (G) { kload2(kf, kp0 + sl_next, j); SBAR(); } } while (0)
  #define STEP(C0, C1, P0, P1, t, GK, GV, GL) do { SBAR(); \
    const lds_cptr vp_ = vp0 + sl_prev; \
    VRD(0); SBAR(); float sacc = (P0[0] + P0[1]); \
    GAPA(C0 = __builtin_amdgcn_mfma_f32_32x32x16_bf16(kf[0], qr[0], negm, 0, 0, 0), P0[2], P0[3], P0[4], P0[5],     pw0[0] = PKW(P0, 0), pw0[1] = PKW(P0, 2), pw0); \
    VRD(4); SBAR(); GAPA(C1 = __builtin_amdgcn_mfma_f32_32x32x16_bf16(kf[1], qr[0], negm, 0, 0, 0), P0[6], P0[7], P0[8], P0[9],     pw0[2] = PKW(P0, 4), pw0[3] = PKW(P0, 6), pw0); \
    VRD(1); SBAR(); GAPA(C0 = __builtin_amdgcn_mfma_f32_32x32x16_bf16(kf[2], qr[1], C0, 0, 0, 0),   P0[10], P0[11], P0[12], P0[13], pw1[0] = PKW(P0, 8), pw1[1] = PKW(P0, 10), pw1); \
    VRD(5); SBAR(); GAPA(C1 = __builtin_amdgcn_mfma_f32_32x32x16_bf16(kf[3], qr[1], C1, 0, 0, 0),   P0[14], P0[15], P1[0], P1[1],   pw1[2] = PKW(P0, 12), pw1[3] = PKW(P0, 14), pw1); \
    VRD(2); SBAR(); GAPA(C0 = __builtin_amdgcn_mfma_f32_32x32x16_bf16(kf[4], qr[2], C0, 0, 0, 0),   P1[2], P1[3], P1[4], P1[5],     pw2[0] = PKW(P1, 0), pw2[1] = PKW(P1, 2), pw2); \
    VRD(6); SBAR(); GAPA(C1 = __builtin_amdgcn_mfma_f32_32x32x16_bf16(kf[5], qr[2], C1, 0, 0, 0),   P1[6], P1[7], P1[8], P1[9],     pw2[2] = PKW(P1, 4), pw2[3] = PKW(P1, 6), pw2); \
    VRD(3); SBAR(); GAPA(C0 = __builtin_amdgcn_mfma_f32_32x32x16_bf16(kf[6], qr[3], C0, 0, 0, 0),   P1[10], P1[11], P1[12], P1[13], pw3[0] = PKW(P1, 8), pw3[1] = PKW(P1, 10), pw3); \
    VRD(7); SBAR(); GAPA(C1 = __builtin_amdgcn_mfma_f32_32x32x16_bf16(kf[7], qr[3], C1, 0, 0, 0),   P1[14], P1[15], 0.f, 0.f,       pw3[2] = PKW(P1, 12), pw3[3] = PKW(P1, 14), pw3); \
    l_reg += sacc; \
    if (GK) { DMA_K((t) + 3, sl_cur); } if (GV) { DMA_V((t) + 1, sl_next); } \
    if (!NOMAX) { float a = MX3(C0[0], C0[1], C1[0]), b = MX3(C0[2], C0[3], C1[1]); a = MX3(a, C1[2], C1[3]); \
      _Pragma("unroll") for (int r = 4; r < 16; r += 4) { a = MX3(a, C0[r], C0[r + 1]); b = MX3(b, C0[r + 2], C0[r + 3]); a = MX3(a, C1[r], C1[r + 1]); b = MX3(b, C1[r + 2], C1[r + 3]); } \
      float rm = __builtin_fmaxf(a, b); { auto rr = __builtin_amdgcn_permlane32_swap(__float_as_uint(rm), __float_as_uint(rm), false, false); rm = __builtin_fmaxf(__uint_as_float(rr[0]), __uint_as_float(rr[1])); } \
      resc = false; \
      if (__builtin_expect(__any(rm > (float)THRL), 0)) { const float dl = __builtin_fmaxf(rm, 0.f); mhat += dl; \
        _Pragma("unroll") for (int r = 0; r < 16; ++r) { C0[r] -= dl; C1[r] -= dl; } \
        _Pragma("unroll") for (int r = 0; r < 16; ++r) negm[r] = -mhat; asm volatile("" : "+v"(negm)); \
        const float f = __builtin_amdgcn_exp2f(-dl); l_reg *= f; if (hi == 0) wsf[r32] = f; resc = true; } } \
    SBAR(); \
    GAPB(o[0] = __builtin_amdgcn_mfma_f32_32x32x16_bf16(PAF(0), VFR(0), o[0], 0, 0, 0), C0, 0); \
    GAPB(o[1] = __builtin_amdgcn_mfma_f32_32x32x16_bf16(PAF(0), VFR(4), o[1], 0, 0, 0), C0, 4); \
    KRD(GL, 0); GAPB(o[0] = __builtin_amdgcn_mfma_f32_32x32x16_bf16(PAF(1), VFR(1), o[0], 0, 0, 0), C0, 8); \
    KRD(GL, 1); GAPB(o[1] = __builtin_amdgcn_mfma_f32_32x32x16_bf16(PAF(1), VFR(5), o[1], 0, 0, 0), C0, 12); \
    KRD(GL, 2); GAPB(o[0] = __builtin_amdgcn_mfma_f32_32x32x16_bf16(PAF(2), VFR(2), o[0], 0, 0, 0), C1, 0); \
    KRD(GL, 3); GAPB(o[1] = __builtin_amdgcn_mfma_f32_32x32x16_bf16(PAF(2), VFR(6), o[1], 0, 0, 0), C1, 4); \
    GAPB(o[0] = __builtin_amdgcn_mfma_f32_32x32x16_bf16(PAF(3), VFR(3), o[0], 0, 0, 0), C1, 8); \
    GAPB(o[1] = __builtin_amdgcn_mfma_f32_32x32x16_bf16(PAF(3), VFR(7), o[1], 0, 0, 0), C1, 12); \
    } while (0)
  int t = 1;
  for (; t + 5 < NT; t += 2) {
    STEP(pB0, pB1, pA0, pA1, t, true, true, true);     WAIT_BAR(2); RESC(); ROT();
    STEP(pA0, pA1, pB0, pB1, t + 1, true, true, true); WAIT_BAR(2); RESC(); ROT();
  }
  #define ENDW(tt) do { if ((tt) + 3 < NT) { WAIT_BAR(2); } else if ((tt) + 2 < NT) { WAIT_BAR(1); } else { WAIT_BAR(0); } } while (0)
  for (; t + 1 < NT; t += 2) {
    STEP(pB0, pB1, pA0, pA1, t, (t + 3 < NT), (t + 1 < NT), (t + 1 < NT));         ENDW(t);     RESC(); ROT();
    STEP(pA0, pA1, pB0, pB1, t + 1, (t + 4 < NT), (t + 2 < NT), (t + 2 < NT));     ENDW(t + 1); RESC(); ROT();
  }
  STEP(pB0, pB1, pA0, pA1, NT - 1, false, false, false); RESC();
  { float sacc = pB0[0] + pB0[1]; _Pragma("unroll") for (int r = 2; r < 16; ++r) sacc += pB0[r]; _Pragma("unroll") for (int r = 0; r < 16; ++r) sacc += pB1[r]; l_reg += sacc;
    pw0 = (u32x4){PKW(pB0, 0), PKW(pB0, 2), PKW(pB0, 4), PKW(pB0, 6)}; pw1 = (u32x4){PKW(pB0, 8), PKW(pB0, 10), PKW(pB0, 12), PKW(pB0, 14)}; pw2 = (u32x4){PKW(pB1, 0), PKW(pB1, 2), PKW(pB1, 4), PKW(pB1, 6)}; pw3 = (u32x4){PKW(pB1, 8), PKW(pB1, 10), PKW(pB1, 12), PKW(pB1, 14)};
    SBAR(); pv(o, vb0 + sl_cur, PAF(0), PAF(1), PAF(2), PAF(3)); }
  #undef PKW
  #undef PAF
  #undef VFR
  #undef PIN
  #undef MX3
  #undef GAPA
  #undef GAPB
  #undef EX
  #undef VRD
  #undef KRD
  #undef STEP
  #undef ENDW
  { auto rr = __builtin_amdgcn_permlane32_swap(__float_as_uint(l_reg), __float_as_uint(l_reg), false, false); l_reg = __uint_as_float(rr[0]) + __uint_as_float(rr[1]); }
  if (hi == 0) wsf[32 + r32] = l_reg; asm volatile("s_waitcnt lgkmcnt(0)" ::: "memory");
  float rli[16];
  #pragma unroll
  for (int r = 0; r < 16; ++r) rli[r] = __builtin_amdgcn_rcpf(wsf[32 + crow(r, hi)]);
  unsigned char* Ow = (unsigned char*)O + (rowbase + q0 + wid * QBLK) * QP + h * D;
  { bf16h* stg = (bf16h*)(shm + LDS_OST) + wid * 2048;
    #pragma unroll
    for (int r = 0; r < 16; ++r) { const int orow = crow(r, hi);
      #pragma unroll
      for (int d0 = 0; d0 < 2; ++d0) stg[orow * 64 + d0 * 32 + r32] = __float2bfloat16(o[d0][r] * rli[r]); }
    asm volatile("s_waitcnt lgkmcnt(0)" ::: "memory");
    #pragma unroll
    for (int i = 0; i < 4; ++i) { const int row = i * 8 + (lane >> 3), ch = lane & 7; const u32x4 v = *(const u32x4*)(stg + row * 64 + ch * 8);
      v2u w8; w8.x = pk4_fp8(sat8(64.0f * bflo(v.x)), sat8(64.0f * bfhi(v.x)), sat8(64.0f * bflo(v.y)), sat8(64.0f * bfhi(v.y))); w8.y = pk4_fp8(sat8(64.0f * bflo(v.z)), sat8(64.0f * bfhi(v.z)), sat8(64.0f * bflo(v.w)), sat8(64.0f * bfhi(v.w)));
      *(v2u*)(Ow + (long)row * QP + ch * 8) = w8; } }
  asm volatile("s_waitcnt lgkmcnt(0)\n\ts_barrier" ::: "memory");
  #undef DMA_K
  #undef DMA_V
  #undef START
  #undef RESC
  #undef ROT
}
#undef SBAR
#undef WAIT_BAR
}

#define XB_TMO      128
#define XB_XCNT(j)  (256  + 64 * (j))
#define XB_XSUB(j)  (1280 + 64 * (j))
#define XB_XGEN(j)  (2304 + 64 * (j))
#define XB_TOP      3328
#define XB_TOPGEN   3392
#define XCD_BAR_WORDS 3456
#define XB_SPIN_CAP (1u << 18)
__device__ __forceinline__ unsigned xb_ld(unsigned* p)              { return __hip_atomic_load(p, __ATOMIC_RELAXED, __HIP_MEMORY_SCOPE_AGENT); }
__device__ __forceinline__ unsigned xb_add(unsigned* p, unsigned v) { return __hip_atomic_fetch_add(p, v, __ATOMIC_RELAXED, __HIP_MEMORY_SCOPE_AGENT); }
__device__ __forceinline__ unsigned xb_xcc_id() { return (unsigned)__builtin_amdgcn_s_getreg((3 << 11) | 20) & 0xFu; }
#define XB_SPIN(cond, bar) do { unsigned _sp = 0; while (cond) { __builtin_amdgcn_s_sleep(1); \
    if ((++_sp & 255u) == 0u) { if (xb_ld(&(bar)[XB_TMO])) break; if (_sp > XB_SPIN_CAP) { atomicAdd(&(bar)[XB_TMO], 1u); break; } } } } while (0)
struct XcdBarrier { unsigned* bar; unsigned x; volatile LAS unsigned* st; int wid; };
__device__ __forceinline__ XcdBarrier xcd_barrier_post(unsigned* bar, volatile LAS unsigned* st, int wid) {
    XcdBarrier b; b.bar = bar; b.x = xb_xcc_id(); b.st = st; b.wid = wid;
    if (my_tid(wid) == 0) (void)xb_add(&bar[XB_XCNT(b.x)], 1u);
    return b;
}
__device__ __forceinline__ void xcd_barrier_complete(unsigned* bar, unsigned x, unsigned& nloc, unsigned& nx) {
    const unsigned G = gridDim.x * gridDim.y * gridDim.z;
    unsigned sum, cnt, mine, sp = 0u;
    for (;;) {
        sum = 0u; cnt = 0u; mine = 0u;
#pragma unroll
        for (unsigned j = 0; j < 16; ++j) { const unsigned c = xb_ld(&bar[XB_XCNT(j)]); sum += c; cnt += (c > 0u) ? 1u : 0u; mine = (j == x) ? c : mine; }
        if (sum == G) break;
        __builtin_amdgcn_s_sleep(1);
        if ((++sp & 255u) == 0u) { if (xb_ld(&bar[XB_TMO])) break; if (sp > XB_SPIN_CAP) { atomicAdd(&bar[XB_TMO], 1u); break; } }
    }
    nloc = mine > 0u ? mine : 1u; nx = cnt > 0u ? cnt : 1u;
}
__device__ __forceinline__ void xcd_barrier(const XcdBarrier& b) {
    asm volatile("s_waitcnt vmcnt(0)" ::: "memory");
    __syncthreads();
    if (my_tid(b.wid) == 0) {
        unsigned* bar = b.bar;
        __builtin_amdgcn_s_waitcnt(0);
        unsigned nloc = b.st[0], nx = b.st[1];
        if (nloc == 0u) { xcd_barrier_complete(bar, b.x, nloc, nx); b.st[0] = nloc; b.st[1] = nx; }
        const unsigned old = xb_add(&bar[XB_XSUB(b.x)], 1u);
        const unsigned gen = old / nloc;
        if (old + 1u == (gen + 1u) * nloc) {
            __builtin_amdgcn_fence(__ATOMIC_RELEASE, "agent");
            asm volatile("s_waitcnt vmcnt(0)" ::: "memory");
            const unsigned og = xb_add(&bar[XB_TOP], 1u);
            const unsigned tg = og / nx;
            if (og + 1u == (tg + 1u) * nx) xb_add(&bar[XB_TOPGEN], 1u);
            else XB_SPIN(xb_ld(&bar[XB_TOPGEN]) == tg, bar);
            __builtin_amdgcn_fence(__ATOMIC_ACQUIRE, "agent");
            xb_add(&bar[XB_XGEN(b.x)], 1u);
            asm volatile("s_waitcnt vmcnt(0)" ::: "memory");
        } else {
            XB_SPIN(xb_ld(&bar[XB_XGEN(b.x)]) == gen, bar);
            __builtin_amdgcn_fence(__ATOMIC_ACQUIRE, "agent");
            asm volatile("s_waitcnt vmcnt(0)" ::: "memory");
        }
    }
    __syncthreads();
}


constexpr int CW_SPLIT = 20000;
__device__ __forceinline__ void split_arrive(unsigned* cnt, int wid) {
    asm volatile("s_waitcnt vmcnt(0)" ::: "memory");
    __syncthreads();
    if (my_tid(wid) == 0) { __builtin_amdgcn_fence(__ATOMIC_RELEASE, "agent"); asm volatile("s_waitcnt vmcnt(0)" ::: "memory"); (void)xb_add(cnt, 1u); }
}
__device__ __forceinline__ void split_wait(unsigned* cnt, unsigned want, unsigned* tmo, int wid) {
    if (my_tid(wid) == 0) { unsigned sp = 0u;
        while (xb_ld(cnt) < want) { __builtin_amdgcn_s_sleep(1); if ((++sp & 255u) == 0u) { if (xb_ld(tmo)) break; if (sp > XB_SPIN_CAP) { atomicAdd(tmo, 1u); break; } } }
        __builtin_amdgcn_fence(__ATOMIC_ACQUIRE, "agent"); asm volatile("s_waitcnt vmcnt(0)" ::: "memory"); }
    __syncthreads();
}

typedef float cf __attribute__((ext_vector_type(2)));
__device__ __forceinline__ cf p_add(cf a, cf b) { cf r; asm("v_pk_add_f32 %0, %1, %2" : "=v"(r) : "v"(a), "v"(b)); return r; }
__device__ __forceinline__ cf p_sub(cf a, cf b) { cf r; asm("v_pk_add_f32 %0, %1, %2 neg_lo:[0,1] neg_hi:[0,1]" : "=v"(r) : "v"(a), "v"(b)); return r; }
__device__ __forceinline__ cf p_addmi(cf a, cf b) { cf r; asm("v_pk_add_f32 %0, %1, %2 op_sel:[0,1] op_sel_hi:[1,0] neg_hi:[0,1]" : "=v"(r) : "v"(a), "v"(b)); return r; }
__device__ __forceinline__ cf p_addpi(cf a, cf b) { cf r; asm("v_pk_add_f32 %0, %1, %2 op_sel:[0,1] op_sel_hi:[1,0] neg_lo:[0,1]" : "=v"(r) : "v"(a), "v"(b)); return r; }
__device__ __forceinline__ float s_add(float a, float b) { float r; asm("v_add_f32_e32 %0, %1, %2" : "=v"(r) : "v"(a), "v"(b)); return r; }
__device__ __forceinline__ float s_sub(float a, float b) { float r; asm("v_sub_f32_e32 %0, %1, %2" : "=v"(r) : "v"(a), "v"(b)); return r; }
__device__ __forceinline__ float s_mul(float a, float b) { float r; asm("v_mul_f32_e32 %0, %1, %2" : "=v"(r) : "v"(a), "v"(b)); return r; }
__device__ __forceinline__ float s_fma(float a, float b, float c) { float r; asm("v_fma_f32 %0, %1, %2, %3" : "=v"(r) : "v"(a), "v"(b), "v"(c)); return r; }
__device__ __forceinline__ float s_fnma(float a, float b, float c) { float r; asm("v_fma_f32 %0, -%1, %2, %3" : "=v"(r) : "v"(a), "v"(b), "v"(c)); return r; }
__device__ __forceinline__ cf cmul(cf a, cf b) { cf t, r; asm("v_pk_mul_f32 %0, %1, %2 op_sel:[0,0] op_sel_hi:[0,1]" : "=v"(t) : "v"(a), "v"(b));
    asm("v_pk_fma_f32 %0, %1, %2, %3 op_sel:[1,1,0] op_sel_hi:[1,0,1] neg_lo:[1,0,0]" : "=v"(r) : "v"(a), "v"(b), "v"(t)); return r; }
__device__ __forceinline__ cf cmulk(cf a, cf k) { cf t, r; asm("v_pk_mul_f32 %0, %1, %2 op_sel:[0,0] op_sel_hi:[0,1]" : "=v"(t) : "v"(a), "s"(k));
    asm("v_pk_fma_f32 %0, %1, %2, %3 op_sel:[1,1,0] op_sel_hi:[1,0,1] neg_lo:[1,0,0]" : "=v"(r) : "v"(a), "s"(k), "v"(t)); return r; }
__device__ __forceinline__ cf cmulc(cf a, cf b) { cf t, r; asm("v_pk_mul_f32 %0, %1, %2 op_sel:[0,0] op_sel_hi:[0,1]" : "=v"(t) : "v"(a), "v"(b));
    asm("v_pk_fma_f32 %0, %1, %2, %3 op_sel:[1,1,0] op_sel_hi:[1,0,1] neg_hi:[1,0,0]" : "=v"(r) : "v"(a), "v"(b), "v"(t)); return r; }
__device__ __forceinline__ cf cmulj(cf a, cf b) { cf t, r; asm("v_pk_mul_f32 %0, %1, %2 op_sel:[0,0] op_sel_hi:[0,1] neg_hi:[1,0]" : "=v"(t) : "v"(a), "v"(b));
    asm("v_pk_fma_f32 %0, %1, %2, %3 op_sel:[1,1,0] op_sel_hi:[1,0,1] neg_lo:[1,0,0] neg_hi:[1,0,0]" : "=v"(r) : "v"(a), "v"(b), "v"(t)); return r; }
#define FIDX(i) ((i) + ((i) >> 4) + (((i) >> 9) << 4))
constexpr int FFT_LDS_BYTES = 143360;
__device__ __forceinline__ void dft4(cf& a, cf& b, cf& c, cf& d) {
    const cf s0 = p_add(a, c), s1 = p_sub(a, c), s2 = p_add(b, d), s3 = p_sub(b, d);
    a = p_add(s0, s2); c = p_sub(s0, s2);
    b = p_addmi(s1, s3); d = p_addpi(s1, s3);
}
__device__ __forceinline__ void dft16(cf (&x)[16]) {
#pragma unroll
    for (int m2 = 0; m2 < 4; ++m2) dft4(x[m2], x[4 + m2], x[8 + m2], x[12 + m2]);
    const cf W1{0.92387953251f, -0.38268343236f}, W2{0.70710678118f, -0.70710678118f}, W3{0.38268343236f, -0.92387953251f}, W6{-0.70710678118f, -0.70710678118f}, W9{-0.92387953251f, 0.38268343236f};
    x[5] = cmulk(x[5], W1); x[6] = cmulk(x[6], W2); x[7] = cmulk(x[7], W3);
    x[9] = cmulk(x[9], W2); x[10] = cf{x[10].y, -x[10].x}; x[11] = cmulk(x[11], W6);
    x[13] = cmulk(x[13], W3); x[14] = cmulk(x[14], W6); x[15] = cmulk(x[15], W9);
#pragma unroll
    for (int q1 = 0; q1 < 4; ++q1) dft4(x[4 * q1], x[4 * q1 + 1], x[4 * q1 + 2], x[4 * q1 + 3]);
}
#define QREG(q) (4 * ((q) & 3) + ((q) >> 2))
template <int OFF> __device__ __forceinline__ void dft16_at(cf (&x)[32]) {
#pragma unroll
    for (int m2 = 0; m2 < 4; ++m2) dft4(x[OFF + m2], x[OFF + 4 + m2], x[OFF + 8 + m2], x[OFF + 12 + m2]);
    const cf W1{0.92387953251f, -0.38268343236f}, W2{0.70710678118f, -0.70710678118f}, W3{0.38268343236f, -0.92387953251f}, W6{-0.70710678118f, -0.70710678118f}, W9{-0.92387953251f, 0.38268343236f};
    x[OFF + 5] = cmulk(x[OFF + 5], W1); x[OFF + 6] = cmulk(x[OFF + 6], W2); x[OFF + 7] = cmulk(x[OFF + 7], W3);
    x[OFF + 9] = cmulk(x[OFF + 9], W2); x[OFF + 10] = cf{x[OFF + 10].y, -x[OFF + 10].x}; x[OFF + 11] = cmulk(x[OFF + 11], W6);
    x[OFF + 13] = cmulk(x[OFF + 13], W3); x[OFF + 14] = cmulk(x[OFF + 14], W6); x[OFF + 15] = cmulk(x[OFF + 15], W9);
#pragma unroll
    for (int q1 = 0; q1 < 4; ++q1) dft4(x[OFF + 4 * q1], x[OFF + 4 * q1 + 1], x[OFF + 4 * q1 + 2], x[OFF + 4 * q1 + 3]);
}
#define X32I(k) ((((k) & 1) << 4) + QREG((k) >> 1))
template <bool HI_ZERO> __device__ __forceinline__ void dft32(cf (&x)[32]) {
    constexpr float C32[16] = {1.0f, 0.98078528040f, 0.92387953251f, 0.83146961230f, 0.70710678118f, 0.55557023302f, 0.38268343236f, 0.19509032201f, 0.0f, -0.19509032201f, -0.38268343236f, -0.55557023302f, -0.70710678118f, -0.83146961230f, -0.92387953251f, -0.98078528040f};
    constexpr float S32[16] = {0.0f, 0.19509032201f, 0.38268343236f, 0.55557023302f, 0.70710678118f, 0.83146961230f, 0.92387953251f, 0.98078528040f, 1.0f, 0.98078528040f, 0.92387953251f, 0.83146961230f, 0.70710678118f, 0.55557023302f, 0.38268343236f, 0.19509032201f};
#pragma unroll
    for (int n = 0; n < 16; ++n) { cf a, b;
        if (HI_ZERO) { a = x[n]; b = x[n]; } else { a = p_add(x[n], x[16 + n]); b = p_sub(x[n], x[16 + n]); }
        x[n] = a; x[16 + n] = (n == 0) ? b : cmulk(b, cf{C32[n], -S32[n]}); }
    dft16_at<0>(x); dft16_at<16>(x);
}
__device__ __forceinline__ cf twid(int j, int lognb) { const float fr = (float)j * (1.0f / (float)(1 << lognb)); float wx = __builtin_amdgcn_cosf(fr), wy = -__builtin_amdgcn_sinf(fr);
    asm volatile("s_nop 3" : "+v"(wx), "+v"(wy));
    return cf{wx, wy}; }
__device__ __forceinline__ void twiddle32_fwd(cf (&x)[32], cf w) {
    const cf w2 = cmul(w, w); cf p = w2;
    x[X32I(1)] = cmul(x[X32I(1)], w);
#pragma unroll
    for (int k2 = 1; k2 < 16; ++k2) { x[X32I(2 * k2)] = cmul(x[X32I(2 * k2)], p); const cf po = cmul(p, w); x[X32I(2 * k2 + 1)] = cmul(x[X32I(2 * k2 + 1)], po); if (k2 < 15) p = cmul(p, w2); }
}
__device__ __forceinline__ void twiddle32_inv(cf (&x)[32], cf w) {
    const cf w2 = cmul(w, w); cf p = w2;
    x[0].y = -x[0].y; x[1] = cmulc(x[1], w);
#pragma unroll
    for (int k2 = 1; k2 < 16; ++k2) { x[2 * k2] = cmulc(x[2 * k2], p); const cf po = cmul(p, w); x[2 * k2 + 1] = cmulc(x[2 * k2 + 1], po); if (k2 < 15) p = cmul(p, w2); }
}
__device__ __forceinline__ void ldsA_storeX(LAS f32x2* X, int j, const cf (&x)[32]) {
    LAS f32x2* Xb = X + j + (j >> 4);
#pragma unroll
    for (int q = 0; q < 32; ++q) Xb[560 * q] = (f32x2){x[X32I(q)].x, x[X32I(q)].y};
}
__device__ __forceinline__ void ldsA_load(LAS f32x2* X, int j, cf (&x)[32]) {
    const LAS f32x2* Xb = X + j + (j >> 4);
#pragma unroll
    for (int q = 0; q < 32; ++q) { const f32x2 v = Xb[560 * q]; x[q] = cf{v.x, v.y}; }
}
__device__ __forceinline__ void fft_fwdA(LAS f32x2* X, int tid, int salt) {
    asm volatile("" : "+v"(tid) : "s"(salt) : "memory");
    cf x[32]; ldsA_load(X, tid, x); dft32<false>(x); twiddle32_fwd(x, twid(tid, 14)); ldsA_storeX(X, tid, x);
}
__device__ __forceinline__ void fft_fwdB(LAS f32x2* X, int tid, int salt) {
    asm volatile("" : "+v"(tid) : "s"(salt) : "memory");
    const int j = tid & 15; LAS f32x2* Xb = X + 560 * (tid >> 4) + j; cf x[32];
#pragma unroll
    for (int m = 0; m < 32; ++m) { const f32x2 v = Xb[17 * m]; x[m] = cf{v.x, v.y}; }
    dft32<false>(x); twiddle32_fwd(x, twid(j, 9));
#pragma unroll
    for (int q = 0; q < 32; ++q) Xb[17 * q] = (f32x2){x[X32I(q)].x, x[X32I(q)].y};
}
__device__ __forceinline__ void fft_invB(LAS f32x2* X, int tid, int salt) {
    asm volatile("" : "+v"(tid) : "s"(salt) : "memory");
    const int j = tid & 15; LAS f32x2* Xb = X + 560 * (tid >> 4) + j; cf x[32];
#pragma unroll
    for (int q = 0; q < 32; ++q) { const f32x2 v = Xb[17 * q]; x[q] = cf{v.x, v.y}; }
    twiddle32_inv(x, twid(j, 9)); dft32<false>(x);
#pragma unroll
    for (int m = 0; m < 32; ++m) Xb[17 * m] = (f32x2){x[X32I(m)].x, -x[X32I(m)].y};
}
__device__ __forceinline__ void load_spec(f32x4 (&h)[8], const float* H, int tid, int salt) {
    asm volatile("" : "+v"(tid) : "s"(salt) : "memory");
#pragma unroll
    for (int i = 0; i < 8; ++i) h[i] = *(const f32x4*)(H + 32 * tid + 4 * i);
}
__device__ __forceinline__ void fft_mid(LAS f32x2* X, const f32x4 (&h0)[8], const float* H, int tid, int salt) {
    asm volatile("" : "+v"(tid) : "s"(salt) : "memory");
    f32x4 h1[8];
#pragma unroll
    for (int i = 0; i < 8; ++i) h1[i] = *(const f32x4*)(H + 32 * (tid + 512) + 4 * i);
#pragma unroll
    for (int k = 0; k < 2; ++k) { const int u = tid + 512 * k; const int p = FIDX(16 * u); cf x[16];
#pragma unroll
        for (int m = 0; m < 16; ++m) { const f32x2 v = X[p + m]; x[m] = cf{v.x, v.y}; }
        dft16(x);
        cf y[16];
#pragma unroll
        for (int q = 0; q < 16; ++q) { const f32x4 hv = k == 0 ? h0[q >> 1] : h1[q >> 1]; const cf hq = (q & 1) ? cf{hv[2], hv[3]} : cf{hv[0], hv[1]}; y[q] = cmulj(x[QREG(q)], hq); }
        dft16(y);
#pragma unroll
        for (int m = 0; m < 16; ++m) X[p + m] = (f32x2){y[QREG(m)].x, -y[QREG(m)].y}; }
}
__device__ __forceinline__ void fft_last_store(LAS f32x2* X, float* H, int tid, int salt) {
    asm volatile("" : "+v"(tid) : "s"(salt) : "memory");
    const float sc = 1.0f / 16384.0f;
#pragma unroll 1
    for (int k = 0; k < 2; ++k) { const int u = tid + 512 * k; const int p = FIDX(16 * u); cf x[16];
#pragma unroll
        for (int m = 0; m < 16; ++m) { const f32x2 v = X[p + m]; x[m] = cf{v.x, v.y}; }
        dft16(x);
#pragma unroll
        for (int i = 0; i < 8; ++i) *(f32x4*)(H + 32 * u + 4 * i) = (f32x4){x[QREG(2 * i)].x * sc, x[QREG(2 * i)].y * sc, x[QREG(2 * i + 1)].x * sc, x[QREG(2 * i + 1)].y * sc}; }
}

__device__ __forceinline__ void block_sum2(float& a, float& b, LAS float* red, int tid) {
    a = wave_sum(a); b = wave_sum(b);
    __syncthreads();
    if ((tid & 63) == 0) { red[(tid >> 6) * 2] = a; red[(tid >> 6) * 2 + 1] = b; }
    __syncthreads();
    float sa = 0.f, sb = 0.f;
#pragma unroll
    for (int w = 0; w < 8; ++w) { sa += red[2 * w]; sb += red[2 * w + 1]; }
    a = sa; b = sb;
}

struct HfRaw { float f[16], b[16]; };
__device__ __forceinline__ void hfft_load(HfRaw& r, const float* hraw, int id, int tid, int salt) {
    asm volatile("" : "+v"(tid) : "s"(salt) : "memory");
    const int o = id >> 9, c = id & 511;
    const float* hf = hraw + (size_t)((o * 2 + 0) * HYW + c) * SEQ; const float* hb = hraw + (size_t)((o * 2 + 1) * HYW + c) * SEQ;
#pragma unroll
    for (int m = 0; m < 16; ++m) { r.f[m] = hf[tid + 512 * m]; const int tb = 8192 - tid - 512 * m; r.b[m] = hb[tb < SEQ ? tb : 0]; }
}
__device__ __forceinline__ void hfft_run(const HfRaw& r, float* Hout, int id, LAS unsigned char* lds, int tid, int salt) {
    asm volatile("" : "+v"(tid) : "s"(salt) : "memory");
    LAS f32x2* X = (LAS f32x2*)lds; LAS float* red = (LAS float*)(lds + FFT_LDS_BYTES);
    const int c = id & 511;
    const float mind = 4.605170185988091f / 1.5f, maxd = 4.605170185988091f / 0.3f;
    const float ad = mind + (float)c * ((maxd - mind) / 511.0f);
    float vf[16], vb[16]; float sf = 0.f, sb = 0.f;
#pragma unroll
    for (int m = 0; m < 16; ++m) { const int t = tid + 512 * m, tb = 8192 - tid - 512 * m;
        vf[m] = r.f[m] * expf(-((float)t * (1.0f / 8191.0f)) * ad); vb[m] = (tb < SEQ) ? r.b[m] * expf(-((float)tb * (1.0f / 8191.0f)) * ad) : 0.f; sf += fabsf(vf[m]); sb += fabsf(vb[m]); }
    if (tid == 0) sb += fabsf(r.b[0] * 1.0f);
    block_sum2(sf, sb, red, tid);
    const float nf = 1.0f / (sf + EPSV), nb = 1.0f / (sb + EPSV);
    cf x[32];
#pragma unroll
    for (int m = 0; m < 16; ++m) { x[m] = cf{vf[m] * nf, 0.f}; x[16 + m] = cf{vb[m] * nb, 0.f}; }
    if (tid == 0) x[0].x += r.b[0] * nb;
    dft32<false>(x); twiddle32_fwd(x, twid(tid, 14)); ldsA_storeX(X, tid, x);
    __syncthreads();
    fft_fwdB(X, tid, salt); __syncthreads();
    fft_last_store(X, Hout + (size_t)id * 32768, tid, salt);
    __syncthreads();
}

__device__ __forceinline__ void zc_tile(const Args& P, int tile, LAS unsigned char* lds, int tid) {
    const int salt = tile;
    asm volatile("" : "+v"(tid) : "s"(salt) : "memory");
    const int cb = tile % 24, jb = (tile / 24) & 31, p = tile / (24 * 32);
    const bf16* z = (const bf16*)(P.ws + WS_ZHY); bf16* zc = (bf16*)(P.ws + WS_ZC);
    v4u sv[9];
#pragma unroll
    for (int it = 0; it < 9; ++it) { const int row = it * 64 + (tid >> 3), ch8 = tid & 7; const int bt = row / 288, rr = row % 288, m = rr / 18, r = rr % 18;
        const int t = 512 * m + 16 * jb - 1 + r; const int tc = t < 0 ? 0 : (t >= SEQ ? SEQ - 1 : t);
        sv[it] = *(const v4u*)(z + ((size_t)((2 * p + bt) * SEQ + tc)) * HYIN + 64 * cb + 8 * ch8); }
#pragma unroll
    for (int it = 0; it < 9; ++it) { const int row = it * 64 + (tid >> 3), ch8 = tid & 7; const int rr = row % 288, m = rr / 18, r = rr % 18;
        const int t = 512 * m + 16 * jb - 1 + r; v4u v = sv[it]; if (t < 0 || t >= SEQ) v = (v4u){0u, 0u, 0u, 0u};
        LAS v2u* d = (LAS v2u*)(lds + row * 136 + ch8 * 16); d[0] = (v2u){v.x, v.y}; d[1] = (v2u){v.z, v.w}; }
    __syncthreads();
    const int lane = tid & 63, wave = tid >> 6; const int jl = lane & 15, bt = (lane >> 4) & 1, csub = lane >> 5;
    const float* sw = P.in[8]; const float* sb = P.in[9];
#pragma unroll 1
    for (int it = 0; it < 4; ++it) { const int cl = 2 * (wave + 8 * it) + csub; const int ch = 64 * cb + cl; const int pos = cl;
        const float w0 = sw[ch], w1 = sw[HYIN + ch], w2 = sw[2 * HYIN + ch], bs = sb[ch];
        const LAS bf16* base = (const LAS bf16*)(lds + (bt * 288 + jl) * 136) + pos;
        unsigned o[8];
#pragma unroll
        for (int m = 0; m < 16; m += 2) { float r0, r1;
            { const LAS bf16* q = base + m * 18 * 68; r0 = bs + w0 * bf2f(q[0]) + w1 * bf2f(q[68]) + w2 * bf2f(q[136]); }
            { const LAS bf16* q = base + (m + 1) * 18 * 68; r1 = bs + w0 * bf2f(q[0]) + w1 * bf2f(q[68]) + w2 * bf2f(q[136]); }
            o[m >> 1] = pk2(r0, r1); }
        const int s = ch >> 9, c = ch & 511;
        bf16* dst = zc + ((size_t)((p * 3 + s) * HYW + c)) * 16384 + (16 * jb + jl) * 32 + bt * 16;
        *(v4u*)dst = (v4u){o[0], o[1], o[2], o[3]}; *(v4u*)(dst + 8) = (v4u){o[4], o[5], o[6], o[7]}; }
    __syncthreads();
}

#define UNPK(V, m) (((m) & 1) ? bfhi(V[(m) >> 3][((m) >> 1) & 3]) : bflo(V[(m) >> 3][((m) >> 1) & 3]))
__device__ __forceinline__ void hyena_item(const Args& P, int c, int p, float* y1s, LAS unsigned char* lds, int tid, int salt) {
    asm volatile("" : "+v"(tid) : "s"(salt) : "memory");
    LAS f32x2* X = (LAS f32x2*)lds;
    const bf16* zc = (const bf16*)(P.ws + WS_ZC); const float* Hs = (const float*)P.out; unsigned char* yhy = P.ws + WS_YHY;
    const float* fbp = P.in[18]; const float fb0 = fbp[c], fb1 = fbp[HYW + c];
    const int j = tid;
    const v4u* srcv = (const v4u*)(zc + ((size_t)((p * 3 + 0) * HYW + c)) * 16384 + j * 32);
    f32x4 hsp[8]; const float* Hcur = Hs + (size_t)(0 * HYW + c) * 32768;
    { v4u vp[4];
#pragma unroll
    for (int i = 0; i < 4; ++i) vp[i] = srcv[i];
    load_spec(hsp, Hcur, tid, salt);
    cf x[32];
#pragma unroll
      for (int m = 0; m < 16; ++m) { x[m] = cf{UNPK(vp, m), UNPK(vp, 16 + m)}; x[16 + m] = cf{0.f, 0.f}; }
      dft32<true>(x); twiddle32_fwd(x, twid(j, 14)); ldsA_storeX(X, j, x); }
    __syncthreads();
    fft_fwdB(X, tid, salt); __syncthreads();
    fft_mid(X, hsp, Hcur, tid, salt); __syncthreads();
    v4u gp[4], vp[4];
    { int jj = tid; asm volatile("" : "+v"(jj) : "s"(salt) : "memory"); const v4u* srcg1 = (const v4u*)(zc + ((size_t)((p * 3 + 1) * HYW + c)) * 16384 + jj * 32);
      const v4u* srcv2 = (const v4u*)(zc + ((size_t)((p * 3 + 0) * HYW + c)) * 16384 + jj * 32);
#pragma unroll
      for (int i = 0; i < 4; ++i) { gp[i] = srcg1[i]; vp[i] = srcv2[i]; } }
    fft_invB(X, tid, salt); __syncthreads();
    { int j1 = j; asm volatile("" : "+v"(j1) : "s"(salt) : "memory");
      cf x[32]; ldsA_load(X, j1, x); twiddle32_inv(x, twid(j1, 14)); dft32<false>(x);
      cf y1[16];
#pragma unroll
      for (int m = 0; m < 16; ++m) { const float ra = x[X32I(m)].x, rb = -x[X32I(m)].y; y1[m] = cf{UNPK(gp, m) * (ra + fb0 * UNPK(vp, m)), UNPK(gp, 16 + m) * (rb + fb0 * UNPK(vp, 16 + m))}; }
#pragma unroll
      for (int m = 0; m < 16; ++m) { x[m] = y1[m]; x[16 + m] = cf{0.f, 0.f}; }
#pragma unroll
      for (int m = 0; m < 16; m += 2) *(f32x4*)(y1s + j1 * 32 + 2 * m) = (f32x4){y1[m].x, y1[m].y, y1[m + 1].x, y1[m + 1].y};
      int j2 = j; asm volatile("" : "+v"(j2) : "s"(salt) : "memory");
      dft32<true>(x); twiddle32_fwd(x, twid(j2, 14)); ldsA_storeX(X, j2, x); }
    __syncthreads();
    Hcur = Hs + (size_t)(1 * HYW + c) * 32768; load_spec(hsp, Hcur, tid, salt);
    fft_fwdB(X, tid, salt); __syncthreads();
    fft_mid(X, hsp, Hcur, tid, salt); __syncthreads();
    f32x4 yv[8];
    { int jj = tid; asm volatile("" : "+v"(jj) : "s"(salt) : "memory"); const v4u* srcg2 = (const v4u*)(zc + ((size_t)((p * 3 + 2) * HYW + c)) * 16384 + jj * 32);
#pragma unroll
      for (int i = 0; i < 4; ++i) gp[i] = srcg2[i];
#pragma unroll
      for (int i = 0; i < 8; ++i) yv[i] = *(const f32x4*)(y1s + jj * 32 + 4 * i); }
    fft_invB(X, tid, salt); __syncthreads();
    { int j3 = j; asm volatile("" : "+v"(j3) : "s"(salt) : "memory");
      cf x[32]; ldsA_load(X, j3, x); twiddle32_inv(x, twid(j3, 14)); dft32<false>(x);
      unsigned char* ya = yhy + ((size_t)(2 * p) * SEQ + j3) * HYW + c; unsigned char* yb = yhy + ((size_t)(2 * p + 1) * SEQ + j3) * HYW + c;
#pragma unroll
      for (int m = 0; m < 16; ++m) { const float ra = x[X32I(m)].x, rb = -x[X32I(m)].y;
          ya[(size_t)512 * m * HYW] = f2fp8(64.0f * UNPK(gp, m) * (ra + fb1 * yv[m >> 1][2 * (m & 1)]));
          yb[(size_t)512 * m * HYW] = f2fp8(64.0f * UNPK(gp, 16 + m) * (rb + fb1 * yv[m >> 1][2 * (m & 1) + 1])); } }
    __syncthreads();
}
#undef UNPK

template <class MapT>
__device__ __forceinline__ void conv_tile(const float* W, int K, int N, bf16* WT, const MapT& map, int tile, int wave, int lane) {
    const int nblk = N / 256, kb = tile / nblk, nb = tile % nblk, k0 = 128 * kb + 16 * wave, n0 = 256 * nb + 4 * lane;
    f32x4 v[16];
    const float* src = W + (size_t)k0 * N + n0;
#pragma unroll
    for (int i = 0; i < 16; ++i) v[i] = *(const f32x4*)(src + (size_t)i * N);
#pragma unroll
    for (int e = 0; e < 4; ++e) { v4u lo, hi;
        lo.x = pk2(v[0][e], v[1][e]); lo.y = pk2(v[2][e], v[3][e]); lo.z = pk2(v[4][e], v[5][e]); lo.w = pk2(v[6][e], v[7][e]);
        hi.x = pk2(v[8][e], v[9][e]); hi.y = pk2(v[10][e], v[11][e]); hi.z = pk2(v[12][e], v[13][e]); hi.w = pk2(v[14][e], v[15][e]);
        bf16* dst = WT + (size_t)map(n0 + e) * K + k0; *(v4u*)dst = lo; *(v4u*)(dst + 8) = hi; }
}
template <class MapT>
__device__ __forceinline__ void conv_tile8(const float* W, int K, int N, unsigned char* WT, const MapT& map, int tile, int wave, int lane, float scale) {
    const int nblk = N / 256, kb = tile / nblk, nb = tile % nblk, k0 = 128 * kb + 16 * wave, n0 = 256 * nb + 4 * lane;
    f32x4 v[16];
    const float* src = W + (size_t)k0 * N + n0;
#pragma unroll
    for (int i = 0; i < 16; ++i) v[i] = *(const f32x4*)(src + (size_t)i * N) * scale;
#pragma unroll
    for (int e = 0; e < 4; ++e) { v4u o;
        o.x = pk4_fp8(v[0][e], v[1][e], v[2][e], v[3][e]); o.y = pk4_fp8(v[4][e], v[5][e], v[6][e], v[7][e]); o.z = pk4_fp8(v[8][e], v[9][e], v[10][e], v[11][e]); o.w = pk4_fp8(v[12][e], v[13][e], v[14][e], v[15][e]);
        *(v4u*)(WT + (size_t)map(n0 + e) * K + k0) = o; }
}
struct MapWin { __device__ __forceinline__ int operator()(int n) const {
    if (n < 1536) return (n & ~31) | pinv32(n & 31);
    if (n < 2304) { const int t0 = 1536 + ((n - 1536) & ~255), cc = (n - 1536) & 255, hp = cc >> 6, d = cc & 63; return t0 + 128 * (d >> 5) + 32 * hp + (d & 31); }
    return (n & ~31) | pinv32(n & 31); } };
struct MapPerm { int off; __device__ __forceinline__ int operator()(int n) const { return off + ((n & ~31) | pinv32(n & 31)); } };
struct MapNat { __device__ __forceinline__ int operator()(int n) const { return n; } };
struct MapGU { int off; __device__ __forceinline__ int operator()(int f) const { return off + (f >> 7) * 256 + (((f & 127) & ~31) | pinv32(f & 31)); } };

__device__ __forceinline__ void phase_mod(const Args& P, LAS unsigned char* lds, int G, int tid) {
    LAS float* sc = (LAS float*)lds; LAS float* red = sc + 4096;
    asm volatile("" : "+v"(tid) :: "memory");
    const float* c = P.in[1]; const float* w_ada = P.in[2]; const float* b_ada = P.in[3];
    for (int i = tid; i < 4096; i += 512) { const float v = c[i]; sc[i] = v / (1.0f + expf(-v)); }
    __syncthreads();
    float* mod = (float*)(P.ws + WS_MOD);
    for (int cb = blockIdx.x; cb < 256; cb += G) {
        const int col0 = cb * 24, ks = tid / 24, col = tid % 24;
        float a0 = 0.f, a1 = 0.f, a2 = 0.f, a3 = 0.f;
        if (tid < 504) {
#pragma unroll 7
            for (int k = ks; k < 1024; k += 21) { const float w = w_ada[(size_t)k * 6144 + col0 + col]; a0 += sc[k] * w; a1 += sc[1024 + k] * w; a2 += sc[2048 + k] * w; a3 += sc[3072 + k] * w; }
            red[(ks * 24 + col) * 4 + 0] = a0; red[(ks * 24 + col) * 4 + 1] = a1; red[(ks * 24 + col) * 4 + 2] = a2; red[(ks * 24 + col) * 4 + 3] = a3; }
        __syncthreads();
        if (tid < 96) { const int b = tid / 24, cc = tid % 24; float s = 0.f; for (int q = 0; q < 21; ++q) s += red[(q * 24 + cc) * 4 + b]; mod[b * 6144 + col0 + cc] = s + b_ada[col0 + cc]; }
        __syncthreads();
    }
}

__device__ __forceinline__ void hraw_item(const Args& P, int item, LAS unsigned char* lds, int tid) {
    asm volatile("" : "+v"(tid) :: "memory");
    LAS float* ha = (LAS float*)lds;
    LAS float* hb = ha + 64 * 65;
    LAS float* wl1 = hb + 64 * 65;
    LAS float* wl2 = wl1 + 33 * 64;
    LAS float* wl3 = wl2 + 64 * 64;
    LAS float* hT = wl3 + 64 * 64;
    const int tb = item >> 1, half = item & 1, t0 = tb * 64;
    const float* b1 = P.in[11]; const float* b2 = P.in[13]; const float* b3 = P.in[15]; const float* w4 = P.in[16]; const float* fq = P.in[17];
    { f32x4 a1 = (f32x4){0.f, 0.f, 0.f, 0.f}, a1b = a1, a2[2], a3[2];
      a1 = *(const f32x4*)(P.in[10] + 4 * tid); if (tid < 16) a1b = *(const f32x4*)(P.in[10] + 4 * (tid + 512));
#pragma unroll
      for (int q = 0; q < 2; ++q) { a2[q] = *(const f32x4*)(P.in[12] + 4 * (tid + 512 * q)); a3[q] = *(const f32x4*)(P.in[14] + 4 * (tid + 512 * q)); }
      *(LAS f32x4*)(wl1 + 4 * tid) = a1; if (tid < 16) *(LAS f32x4*)(wl1 + 4 * (tid + 512)) = a1b;
#pragma unroll
      for (int q = 0; q < 2; ++q) { *(LAS f32x4*)(wl2 + 4 * (tid + 512 * q)) = a2[q]; *(LAS f32x4*)(wl3 + 4 * (tid + 512 * q)) = a3[q]; } }
    const int r = tid >> 3, js = tid & 7;
    { const int t = t0 + r;
        if (js == 0) hb[r * 65] = (float)t * (1.0f / 8191.0f);
        const float wv = 6.283185307179586f * (float)t * (1.0f / 8192.0f);
#pragma unroll
        for (int q = 0; q < 2; ++q) { const int kk = js * 2 + q; const float f = 1e-4f + (float)kk * ((15.0f - 1e-4f) / 15.0f); const float a = f * wv; hb[r * 65 + 1 + kk] = cosf(a); hb[r * 65 + 17 + kk] = -sinf(a); }
    }
    __syncthreads();
#define MLP_LAYER(SRC, W, BI, FO, NIN, STORE) do { float s_[8]; \
        _Pragma("unroll") for (int q = 0; q < 8; ++q) s_[q] = (BI)[js * 8 + q]; \
        _Pragma("unroll 4") for (int i = 0; i < (NIN); ++i) { const float hv = (SRC)[r * 65 + i]; const f32x4 wa = *(const LAS f32x4*)((W) + i * 64 + js * 8), wb = *(const LAS f32x4*)((W) + i * 64 + js * 8 + 4); \
            s_[0] += hv * wa.x; s_[1] += hv * wa.y; s_[2] += hv * wa.z; s_[3] += hv * wa.w; s_[4] += hv * wb.x; s_[5] += hv * wb.y; s_[6] += hv * wb.z; s_[7] += hv * wb.w; } \
        _Pragma("unroll") for (int q = 0; q < 8; ++q) { const float o_ = sinf((FO)[js * 8 + q] * s_[q]); STORE; } } while (0)
    MLP_LAYER(hb, wl1, b1, fq, 33, ha[r * 65 + js * 8 + q] = o_);
    __syncthreads();
    MLP_LAYER(ha, wl2, b2, fq + 64, 64, hb[r * 65 + js * 8 + q] = o_);
    __syncthreads();
    MLP_LAYER(hb, wl3, b3, fq + 128, 64, hT[(js * 8 + q) * 64 + r] = o_);
    __syncthreads();
#undef MLP_LAYER
    float* hraw = (float*)(P.ws + WS_HRAW);
    { const int tg = tid >> 6, ig = tid & 63;
#pragma unroll 1
      for (int hh = 0; hh < 2; ++hh) { const int idx0 = half * 1024 + hh * 512 + 8 * ig;
        f32x4 acc[8][2];
#pragma unroll
        for (int i = 0; i < 8; ++i) { acc[i][0] = (f32x4){0.f, 0.f, 0.f, 0.f}; acc[i][1] = (f32x4){0.f, 0.f, 0.f, 0.f}; }
        f32x4 wa[4][2], wb[4][2];
#define HR_LOAD(W, JB) do { _Pragma("unroll") for (int u_ = 0; u_ < 4; ++u_) { W[u_][0] = *(const f32x4*)(w4 + (size_t)((JB) * 4 + u_) * 2048 + idx0); W[u_][1] = *(const f32x4*)(w4 + (size_t)((JB) * 4 + u_) * 2048 + idx0 + 4); } } while (0)
#define HR_COMP(W, JB) do { _Pragma("unroll") for (int u_ = 0; u_ < 4; ++u_) { const int j = (JB) * 4 + u_; const f32x4 h0 = *(const LAS f32x4*)(hT + j * 64 + 8 * tg), h1 = *(const LAS f32x4*)(hT + j * 64 + 8 * tg + 4); const f32x4 w0 = W[u_][0], w1 = W[u_][1]; \
            acc[0][0] += w0 * h0.x; acc[1][0] += w0 * h0.y; acc[2][0] += w0 * h0.z; acc[3][0] += w0 * h0.w; acc[4][0] += w0 * h1.x; acc[5][0] += w0 * h1.y; acc[6][0] += w0 * h1.z; acc[7][0] += w0 * h1.w; \
            acc[0][1] += w1 * h0.x; acc[1][1] += w1 * h0.y; acc[2][1] += w1 * h0.z; acc[3][1] += w1 * h0.w; acc[4][1] += w1 * h1.x; acc[5][1] += w1 * h1.y; acc[6][1] += w1 * h1.z; acc[7][1] += w1 * h1.w; } } while (0)
        HR_LOAD(wa, 0);
#pragma unroll 1
        for (int jb = 0; jb < 16; jb += 2) { HR_LOAD(wb, jb + 1); HR_COMP(wa, jb); if (jb + 2 < 16) HR_LOAD(wa, jb + 2); HR_COMP(wb, jb + 1); }
#undef HR_LOAD
#undef HR_COMP
#pragma unroll
        for (int q = 0; q < 2; ++q)
#pragma unroll
            for (int e = 0; e < 4; ++e) { float* o = hraw + (size_t)(idx0 + 4 * q + e) * SEQ + t0 + 8 * tg;
                *(f32x4*)o = (f32x4){acc[0][q][e], acc[1][q][e], acc[2][q][e], acc[3][q][e]}; *(f32x4*)(o + 4) = (f32x4){acc[4][q][e], acc[5][q][e], acc[6][q][e], acc[7][q][e]}; } } }
    __syncthreads();
}

__device__ __forceinline__ void phase_prep(const Args& P, LAS unsigned char* lds, int vcu, int G, int tid_, unsigned* modcnt, unsigned* tmo, int wid) {
    asm volatile("" : "+v"(tid_) :: "memory");
    const int tid = tid_, lane = tid & 63, wave = __builtin_amdgcn_readfirstlane(tid >> 6);
    const int gw = vcu * NWAVES + wave, NGW = G * NWAVES;
    for (int it = vcu; it < 256; it += G) hraw_item(P, it, lds, tid);
    { constexpr int T_IN = 8 * 17, T_HY = 4 * 4, T_AT = 4 * 4, T_O = 8 * 4;
      for (int it = vcu; it < T_IN + T_HY + T_AT + T_O; it += G) { int r = it;
          if (r < T_IN) { conv_tile8(P.in[6], DM, INW, P.ws + WS_WIN, MapWin{}, r, wave, lane, 32.0f); continue; } r -= T_IN;
          if (r < T_HY) { conv_tile8(P.in[21], HYW, DM, P.ws + WS_WHY, MapPerm{0}, r, wave, lane, 32.0f); continue; } r -= T_HY;
          if (r < T_AT) { conv_tile8(P.in[22], ATTW, DM, P.ws + WS_WAT, MapPerm{0}, r, wave, lane, 32.0f); continue; } r -= T_AT;
          conv_tile8(P.in[23], DM, DM, P.ws + WS_WO, MapNat{}, r, wave, lane, 32.0f); } }
    { float* cs = (float*)(P.ws + WS_ROPE); const int i = vcu * 512 + tid;
      for (int q = i; q < 128 * 16; q += G * 512) { const int pos = q >> 4, k = q & 15; const float inv = powf(10000.0f, -(float)k * (1.0f / 16.0f)); const float a = (float)pos * inv; cs[pos * 32 + k] = cosf(a); cs[pos * 32 + 16 + k] = sinf(a); }
      float* bp = (float*)(P.ws + WS_BPERM); const float* b_in = P.in[7]; MapWin mw;
      for (int n = (G * 512 - 1) - i; n < INW; n += G * 512) bp[mw(n)] = b_in[n]; }
    split_wait(modcnt, (unsigned)G, tmo, wid);
    const float* x = P.in[0]; const float* gmix = P.in[4]; const float* mod = (const float*)(P.ws + WS_MOD); unsigned char* hn = P.ws + WS_HN;
    f32x4 gg[4], shv[4]; int curb = -1;
    f32x4 v[2][4], vn[2][4];
#define HN_LOAD(V, M0) do { _Pragma("unroll") for (int r = 0; r < 2; ++r) { const int mm_ = ((M0) + r * NGW < MTOK) ? (M0) + r * NGW : (M0); const f32x4* xr = (const f32x4*)(x + (size_t)mm_ * DM) + lane; \
        _Pragma("unroll") for (int j = 0; j < 4; ++j) V[r][j] = xr[64 * j]; } } while (0)
    if (gw < MTOK) HN_LOAD(v, gw);
    for (int m0 = gw; m0 < MTOK; m0 += 2 * NGW) { int mr[2]; mr[0] = m0; mr[1] = (m0 + NGW < MTOK) ? m0 + NGW : m0;
        const int mnext = m0 + 2 * NGW;
        if (mnext < MTOK) HN_LOAD(vn, mnext);
        float s[2] = {0.f, 0.f};
#pragma unroll
        for (int r = 0; r < 2; ++r) {
#pragma unroll
            for (int j = 0; j < 4; ++j) s[r] += (v[r][j].x * v[r][j].x + v[r][j].y * v[r][j].y) + (v[r][j].z * v[r][j].z + v[r][j].w * v[r][j].w); }
#pragma unroll
        for (int r = 0; r < 2; ++r) { const int m = mr[r], b = m >> 13;
            if (b != curb) { curb = b;
#pragma unroll
                for (int j = 0; j < 4; ++j) { const int col = 4 * lane + 256 * j; gg[j] = *(const f32x4*)(gmix + col) * (*(const f32x4*)(mod + b * 6144 + 1024 + col) + 1.0f); shv[j] = *(const f32x4*)(mod + b * 6144 + col); } }
            const float rstd = 1.0f / sqrtf(wave_sum(s[r]) * (1.0f / DM) + EPSV);
            unsigned* o4 = (unsigned*)(hn + (size_t)m * DM) + lane;
#pragma unroll
            for (int j = 0; j < 4; ++j) { const f32x4 h = v[r][j] * rstd * gg[j] + shv[j]; o4[64 * j] = pk4_fp8(h.x, h.y, h.z, h.w); } }
#pragma unroll
        for (int r = 0; r < 2; ++r)
#pragma unroll
            for (int j = 0; j < 4; ++j) v[r][j] = vn[r][j]; }
#undef HN_LOAD
}

__device__ __forceinline__ void xconv_load(const Args& P, int wt, int lane, f32x4 (&v)[16]) {
    const int it = wt >> 3, sl = wt & 7, e = it / 192, r0 = it % 192, kind = r0 >> 6, r = r0 & 63;
    const float* W = (kind == 0 ? P.in[25] : kind == 1 ? P.in[26] : P.in[27]) + (size_t)e * DM * DFF;
    const int N = kind == 2 ? DM : DFF;
    const int kb = kind == 2 ? (r >> 2) : (r >> 3), nb = kind == 2 ? (r & 3) : (r & 7);
    const float* src = W + (size_t)(128 * kb + 16 * sl) * N + 256 * nb + 4 * lane;
#pragma unroll
    for (int i = 0; i < 16; ++i) v[i] = *(const f32x4*)(src + (size_t)i * N);
}
__device__ __forceinline__ void xconv_store(const Args& P, int wt, int lane, f32x4 (&v)[16]) {
    const int it = wt >> 3, sl = wt & 7, e = it / 192, r0 = it % 192, kind = r0 >> 6, r = r0 & 63;
    const int K = kind == 2 ? DFF : DM;
    const int kb = kind == 2 ? (r >> 2) : (r >> 3), nb = kind == 2 ? (r & 3) : (r & 7);
    const int k0 = 128 * kb + 16 * sl, n0 = 256 * nb + 4 * lane;
    unsigned char* WT = P.ws + (kind == 2 ? WS_WD : WS_WGU);
    const int rbase = kind == 2 ? e * 1024 : e * 4096 + kind * 128;
#pragma unroll
    for (int c = 0; c < 4; ++c) { const int n = n0 + c; const int pr = (n & ~31) | pinv32(n & 31);
        const int row = rbase + (kind == 2 ? pr : (n >> 7) * 256 + (pr & 127));
        v4u o;
        o.x = pk4_fp8(v[0][c] * 32.0f, v[1][c] * 32.0f, v[2][c] * 32.0f, v[3][c] * 32.0f); o.y = pk4_fp8(v[4][c] * 32.0f, v[5][c] * 32.0f, v[6][c] * 32.0f, v[7][c] * 32.0f);
        o.z = pk4_fp8(v[8][c] * 32.0f, v[9][c] * 32.0f, v[10][c] * 32.0f, v[11][c] * 32.0f); o.w = pk4_fp8(v[12][c] * 32.0f, v[13][c] * 32.0f, v[14][c] * 32.0f, v[15][c] * 32.0f);
        *(v4u*)(WT + (size_t)row * K + k0) = o; }
}
__device__ __forceinline__ void expert_conv(const Args& P, int t0, int st, int n, int tid) {
    asm volatile("" : "+v"(tid) :: "memory");
    const int lane = tid & 63, wave = __builtin_amdgcn_readfirstlane(tid >> 6);
    if (n <= 0) return;
    f32x4 a[16], b[16];
    xconv_load(P, 8 * t0 + wave, lane, a);
    for (int i = 0; i < n; i += 2) { const int i1 = i + 1 < n ? i + 1 : n - 1, i2 = i + 2 < n ? i + 2 : n - 1;
        xconv_load(P, 8 * (t0 + st * i1) + wave, lane, b);
        xconv_store(P, 8 * (t0 + st * i) + wave, lane, a);
        xconv_load(P, 8 * (t0 + st * i2) + wave, lane, a);
        xconv_store(P, 8 * (t0 + st * i1) + wave, lane, b); }
}

__device__ __forceinline__ void phase_norm2(const Args& P, LAS unsigned char* lds, int vcu, int G, int tid_, bool fuse, int n_fused_wt) {
    asm volatile("" : "+v"(tid_) :: "memory");
    const int tid = tid_, lane = tid & 63, wave = __builtin_amdgcn_readfirstlane(tid >> 6);
    const int gw = vcu * NWAVES + wave, NGW = G * NWAVES;
    LAS float* wrt = (LAS float*)lds;
    const float* w_router = P.in[24];
    { f32x4 wv[8];
#pragma unroll
      for (int q = 0; q < 8; ++q) wv[q] = *(const f32x4*)(w_router + 4 * (tid + 512 * q));
#pragma unroll
      for (int q = 0; q < 8; ++q) { const int i = 4 * (tid + 512 * q), k = i >> 4, e = i & 15; wrt[e * DM + k] = wv[q].x; wrt[(e + 1) * DM + k] = wv[q].y; wrt[(e + 2) * DM + k] = wv[q].z; wrt[(e + 3) * DM + k] = wv[q].w; } }
    __syncthreads();
    const float* x1 = P.out; const float* gffn = P.in[5]; const float* mod = (const float*)(P.ws + WS_MOD); const float* rowsq = (const float*)(P.ws + WS_ROWSQ);
    unsigned char* h2 = P.ws + WS_H2; float* aff = (float*)(P.ws + WS_AFF);
    f32x4 gg[4], shv[4]; int curb = -1;
    f32x4 v[2][4], vn[2][4]; float s[2], sn[2];
#define N2_LOAD(V, SV, M0) do { _Pragma("unroll") for (int r = 0; r < 2; ++r) { const int mm_ = ((M0) + r * NGW < MTOK) ? (M0) + r * NGW : (M0); const f32x4* xr = (const f32x4*)(x1 + (size_t)mm_ * DM) + lane; \
        _Pragma("unroll") for (int j = 0; j < 4; ++j) V[r][j] = xr[64 * j]; SV[r] = lane < 16 ? rowsq[(size_t)mm_ * 16 + lane] : 0.f; } } while (0)
    f32x4 cv[16]; int cwt = gw;
    if (fuse) xconv_load(P, cwt < n_fused_wt ? cwt : n_fused_wt - 1, lane, cv);
    if (gw < MTOK) N2_LOAD(v, s, gw);
    for (int m0 = gw; m0 < MTOK; m0 += 2 * NGW) { const int nr = (m0 + NGW < MTOK) ? 2 : 1;
        { const int mnx = (m0 + 2 * NGW < MTOK) ? m0 + 2 * NGW : m0; N2_LOAD(vn, sn, mnx); }
#pragma unroll
        for (int r = 0; r < 2; ++r) { const int m = (r < nr) ? m0 + r * NGW : m0; const int b = m >> 13;
            if (b != curb) { curb = b;
#pragma unroll
                for (int j = 0; j < 4; ++j) { const int col = 4 * lane + 256 * j; gg[j] = *(const f32x4*)(gffn + col) * (*(const f32x4*)(mod + b * 6144 + 4096 + col) + 1.0f); shv[j] = *(const f32x4*)(mod + b * 6144 + 3072 + col); } }
            const float rstd = 1.0f / sqrtf(wave_sum(s[r]) * (1.0f / DM) + EPSV);
            unsigned* o4 = (unsigned*)(h2 + (size_t)m * DM) + lane;
#pragma unroll
            for (int j = 0; j < 4; ++j) { v[r][j] = v[r][j] * rstd * gg[j] + shv[j]; if (r < nr) o4[64 * j] = pk4_fp8(v[r][j].x, v[r][j].y, v[r][j].z, v[r][j].w); } }
        float mylg[2] = {0.f, 0.f};
#pragma unroll 1
        for (int e = 0; e < 16; ++e) { float a0 = 0.f, a1 = 0.f;
#pragma unroll
            for (int j = 0; j < 4; ++j) { const f32x4 w = *(const LAS f32x4*)(wrt + e * DM + 4 * lane + 256 * j);
                a0 += (v[0][j].x * w.x + v[0][j].y * w.y) + (v[0][j].z * w.z + v[0][j].w * w.w); a1 += (v[1][j].x * w.x + v[1][j].y * w.y) + (v[1][j].z * w.z + v[1][j].w * w.w); }
            a0 = wave_sum(a0); a1 = wave_sum(a1); if (lane == e) { mylg[0] = a0; mylg[1] = a1; } }
#pragma unroll
        for (int r = 0; r < 2; ++r) { if (r < nr) { const int m = m0 + r * NGW; const int b = m >> 13, t = m & (SEQ - 1);
            const float mx = row16_max(mylg[r]);
            const float mine = expf(mylg[r] - mx); const float den = row16_sum(mine);
            if (lane < 16) aff[((size_t)(b * NEXP + lane)) * SEQ + t] = mine / den; } }
        if (fuse) { xconv_store(P, cwt < n_fused_wt ? cwt : n_fused_wt - 1, lane, cv); cwt += NGW; xconv_load(P, cwt < n_fused_wt ? cwt : n_fused_wt - 1, lane, cv); }
#pragma unroll
        for (int r = 0; r < 2; ++r) { s[r] = sn[r];
#pragma unroll
            for (int j = 0; j < 4; ++j) v[r][j] = vn[r][j]; } }
    while (fuse && cwt < n_fused_wt) { xconv_store(P, cwt, lane, cv); cwt += NGW; xconv_load(P, cwt < n_fused_wt ? cwt : n_fused_wt - 1, lane, cv); }
#undef N2_LOAD
}

__device__ __forceinline__ void topk_item(const Args& P, int be, LAS unsigned char* lds, int tid) {
    asm volatile("" : "+v"(tid) :: "memory");
    LAS float* vals = (LAS float*)lds; LAS unsigned* hist = (LAS unsigned*)(lds + 32768); LAS unsigned* sel = hist + 256; LAS unsigned* scan = hist + 512;
    const float* aff = (const float*)(P.ws + WS_AFF) + (size_t)be * SEQ;
    for (int i = tid; i < SEQ; i += 512) vals[i] = aff[i];
    unsigned prefix = 0u, mask = 0u; unsigned need = CAP;
    for (int pass = 0; pass < 4; ++pass) { const int shift = 24 - 8 * pass;
        if (tid < 256) hist[tid] = 0u;
        __syncthreads();
        for (int i = tid; i < SEQ; i += 512) { const unsigned bits = __float_as_uint(vals[i]); if ((bits & mask) == prefix) __hip_atomic_fetch_add(&hist[(bits >> shift) & 255u], 1u, __ATOMIC_RELAXED, __HIP_MEMORY_SCOPE_WORKGROUP); }
        __syncthreads();
        if (tid < 256) { unsigned s = 0u; for (int k2 = tid + 1; k2 < 256; ++k2) s += hist[k2]; const unsigned h = hist[tid]; if (s < need && need <= s + h) { sel[0] = (unsigned)tid; sel[1] = need - s; } }
        __syncthreads();
        prefix |= sel[0] << shift; mask |= 0xFFu << shift; need = sel[1];
        __syncthreads();
    }
    unsigned cg = 0u, ce = 0u; float v[16];
#pragma unroll
    for (int i = 0; i < 16; ++i) { v[i] = vals[16 * tid + i]; const unsigned bits = __float_as_uint(v[i]); cg += bits > prefix ? 1u : 0u; ce += bits == prefix ? 1u : 0u; }
    scan[tid] = cg; scan[512 + tid] = ce;
    __syncthreads();
    for (int off = 1; off < 512; off <<= 1) { unsigned a = 0u, b = 0u; if (tid >= off) { a = scan[tid - off]; b = scan[512 + tid - off]; } __syncthreads(); scan[tid] += a; scan[512 + tid] += b; __syncthreads(); }
    unsigned pg = scan[tid] - cg, pe = scan[512 + tid] - ce;
    int* slot_of = (int*)(P.ws + WS_SLOT) + (size_t)be * SEQ; int* topi = (int*)(P.ws + WS_TOPI) + be * CAP; float* topw = (float*)(P.ws + WS_TOPW) + be * CAP;
#pragma unroll
    for (int i = 0; i < 16; ++i) { const unsigned bits = __float_as_uint(v[i]); int slot = -1;
        if (bits > prefix) { slot = (int)(pg + (pe < need ? pe : need)); ++pg; }
        else if (bits == prefix) { if (pe < need) slot = (int)(pg + pe); ++pe; }
        slot_of[16 * tid + i] = slot;
        if (slot >= 0) { topi[slot] = 16 * tid + i; topw[slot] = v[i]; } }
    __syncthreads();
}

__device__ __forceinline__ void phase_combine(const Args& P, int vcu, int G, int tid_) {
    asm volatile("" : "+v"(tid_) :: "memory");
    const int tid = tid_, lane = tid & 63, wave = __builtin_amdgcn_readfirstlane(tid >> 6);
    const int gw = vcu * NWAVES + wave, NGW = G * NWAVES;
    float* out = P.out; const float* mod = (const float*)(P.ws + WS_MOD); const int* slot_of = (const int*)(P.ws + WS_SLOT); const bf16* ye = (const bf16*)(P.ws + WS_YE);
    f32x4 gtv[4]; int curb = -1;
    for (int m0 = gw; m0 < MTOK; m0 += 2 * NGW) { const int nr = (m0 + NGW < MTOK) ? 2 : 1;
        f32x4 v[2][4], a[2][4]; int myslot[2];
#pragma unroll
        for (int r = 0; r < 2; ++r) { const int m = (r < nr) ? m0 + r * NGW : m0; const int b = m >> 13, t = m & (SEQ - 1);
            const f32x4* xr = (const f32x4*)(out + (size_t)m * DM) + lane;
#pragma unroll
            for (int j = 0; j < 4; ++j) { v[r][j] = xr[64 * j]; a[r][j] = (f32x4){0.f, 0.f, 0.f, 0.f}; }
            myslot[r] = lane < 16 ? slot_of[((size_t)(b * NEXP + lane)) * SEQ + t] : -1; }
#pragma unroll
        for (int r = 0; r < 2; ++r) { const int m = (r < nr) ? m0 + r * NGW : m0; const int b = m >> 13;
            for (int e = 0; e < 16; ++e) { const int sl = __builtin_amdgcn_readlane(myslot[r], e);
                if (sl >= 0) { const v2u* yr = (const v2u*)(ye + ((size_t)(b * NEXP + e) * CAP + sl) * DM) + lane;
#pragma unroll
                    for (int j = 0; j < 4; ++j) { const v2u w = yr[64 * j]; a[r][j].x += bflo(w.x); a[r][j].y += bfhi(w.x); a[r][j].z += bflo(w.y); a[r][j].w += bfhi(w.y); } } } }
#pragma unroll
        for (int r = 0; r < 2; ++r) { if (r < nr) { const int m = m0 + r * NGW; const int b = m >> 13; f32x4* xw = (f32x4*)(out + (size_t)m * DM) + lane;
            if (b != curb) { curb = b;
#pragma unroll
                for (int j = 0; j < 4; ++j) gtv[j] = *(const f32x4*)(mod + b * 6144 + 5120 + 4 * lane + 256 * j); }
#pragma unroll
            for (int j = 0; j < 4; ++j) xw[64 * j] = v[r][j] + gtv[j] * a[r][j]; } } }
}

#ifdef PROBE_CHECK
constexpr int CW_PROBE = 8192;
__device__ __forceinline__ void probe_acc(const Args& P, int cat, float num, float den, LAS float* red, int tid) {
    block_sum2(num, den, red, tid);
    if (tid == 0) { float* pw = (float*)(P.ws + WS_CTL) + CW_PROBE + 2 * cat; __hip_atomic_fetch_add(pw, num, __ATOMIC_RELAXED, __HIP_MEMORY_SCOPE_AGENT); __hip_atomic_fetch_add(pw + 1, den, __ATOMIC_RELAXED, __HIP_MEMORY_SCOPE_AGENT); }
    __syncthreads();
}
__device__ __forceinline__ void probe_inproj(const Args& P, int m, LAS unsigned char* lds, int tid) {
    LAS float* h = (LAS float*)lds; LAS float* z = h + 1024; LAS float* red = z + 4352; LAS float* hr = red + 64;
    const int b = m >> 13, t = m & (SEQ - 1);
    const float* x = P.in[0] + (size_t)m * DM; const float* mod = (const float*)(P.ws + WS_MOD) + b * 6144;
    float ss = 0.f, dm = 0.f; for (int k = tid; k < DM; k += 512) ss += x[k] * x[k];
    block_sum2(ss, dm, red, tid);
    const float rstd = 1.0f / sqrtf(ss / DM + EPSV);
    for (int k = tid; k < DM; k += 512) h[k] = x[k] * rstd * P.in[4][k] * (1.0f + mod[1024 + k]) + mod[k];
    __syncthreads();
    for (int n = tid; n < INW; n += 512) { float a = P.in[7][n]; for (int k = 0; k < DM; ++k) a += h[k] * P.in[6][(size_t)k * INW + n]; z[n] = a; }
    __syncthreads();
    if (tid < 10) { float s2 = 0.f; for (int d = 0; d < 64; ++d) { const float v = z[1536 + tid * 64 + d]; s2 += v * v; } hr[tid] = 1.0f / sqrtf(s2 / 64.0f + EPSV); }
    __syncthreads();
    const bf16* zhy = (const bf16*)(P.ws + WS_ZHY); const bf16* q = (const bf16*)(P.ws + WS_Q); const bf16* kk = (const bf16*)(P.ws + WS_K); const bf16* vv = (const bf16*)(P.ws + WS_V); const bf16* gate = (const bf16*)(P.ws + WS_GATE);
    float num[5] = {0, 0, 0, 0, 0}, den[5] = {0, 0, 0, 0, 0};
    for (int n = tid; n < INW; n += 512) {
        float ref, got; int cat;
        if (n < 1536) { ref = z[n]; got = bf2f(zhy[(size_t)m * HYIN + n]); cat = 0; }
        else if (n < 2176) { const int hd = (n - 1536) >> 6, d = n & 63; const bool isq = hd < 8; const float* gain = isq ? P.in[19] : P.in[20];
            const int half = d >> 5, i = d & 15, second = (d >> 4) & 1; const int base = 1536 + hd * 64 + 32 * half;
            const float u1 = z[base + i] * hr[hd] * gain[32 * half + i], u2 = z[base + 16 + i] * hr[hd] * gain[32 * half + 16 + i];
            const float pos = half ? (float)(t & 63) : (float)(t >> 6); const float ang = pos * powf(10000.0f, -(float)i / 16.0f); const float c = cosf(ang), sn = sinf(ang);
            ref = second ? (u1 * sn + u2 * c) : (u1 * c - u2 * sn);
            if (isq) { ref *= C2Q; got = bf2f(q[(size_t)m * ATTW + hd * 64 + d]); cat = 1; } else { got = bf2f(kk[(size_t)m * KVW + (hd - 8) * 64 + d]); cat = 2; } }
        else if (n < 2304) { ref = z[n]; got = bf2f(vv[(size_t)m * KVW + (n - 2176)]); cat = 3; }
        else { ref = 1.0f / (1.0f + expf(-z[n])); got = bf2f(gate[(size_t)m * 2048 + (n - 2304)]); cat = 4; }
#pragma unroll
        for (int cI = 0; cI < 5; ++cI) if (cat == cI) { num[cI] += (got - ref) * (got - ref); den[cI] += ref * ref; }
    }
#pragma unroll
    for (int cI = 0; cI < 5; ++cI) probe_acc(P, cI, num[cI], den[cI], red, tid);
}
__device__ __forceinline__ void probe_hraw(const Args& P, int t, LAS unsigned char* lds, int tid) {
    LAS float* f0 = (LAS float*)lds; LAS float* f1 = f0 + 64; LAS float* f2 = f1 + 64; LAS float* red = f2 + 64;
    const float* w1 = P.in[10]; const float* b1 = P.in[11]; const float* w2 = P.in[12]; const float* b2 = P.in[13]; const float* w3 = P.in[14]; const float* b3 = P.in[15]; const float* w4 = P.in[16]; const float* fq = P.in[17];
    if (tid < 33) { float v; if (tid == 0) v = (float)t / 8191.0f; else { const int kq = (tid - 1) & 15; const float f = 1e-4f + (float)kq * ((15.0f - 1e-4f) / 15.0f); const float a = f * (6.283185307179586f * (float)t / 8192.0f); v = tid <= 16 ? cosf(a) : -sinf(a); } f0[tid] = v; }
    __syncthreads();
    if (tid < 64) { float s = b1[tid]; _Pragma("unroll 2") for (int i = 0; i < 33; ++i) s += f0[i] * w1[i * 64 + tid]; f1[tid] = sinf(fq[tid] * s); }
    __syncthreads();
    if (tid < 64) { float s = b2[tid]; _Pragma("unroll 2") for (int i = 0; i < 64; ++i) s += f1[i] * w2[i * 64 + tid]; f2[tid] = sinf(fq[64 + tid] * s); }
    __syncthreads();
    if (tid < 64) { float s = b3[tid]; _Pragma("unroll 2") for (int i = 0; i < 64; ++i) s += f2[i] * w3[i * 64 + tid]; f0[tid] = sinf(fq[128 + tid] * s); }
    __syncthreads();
    const float* hraw = (const float*)(P.ws + WS_HRAW); float num = 0.f, den = 0.f;
#pragma unroll 1
    for (int idx = tid; idx < 2048; idx += 512) { float s = 0.f;
#pragma unroll 4
        for (int j = 0; j < 64; ++j) s += f0[j] * w4[j * 2048 + idx]; const float got = hraw[(size_t)idx * SEQ + t]; num += (got - s) * (got - s); den += s * s; }
    probe_acc(P, 7, num, den, red, tid);
}
__device__ __forceinline__ void probe_attn(const Args& P, int b, int hq, int tq, LAS unsigned char* lds, int tid) {
    LAS float* qs = (LAS float*)lds; LAS float* red = qs + 64; LAS float* osum = red + 64;
    const bf16* q = (const bf16*)(P.ws + WS_Q); const bf16* kk = (const bf16*)(P.ws + WS_K); const bf16* vv = (const bf16*)(P.ws + WS_V); const unsigned char* yat = P.ws + WS_YAT;
    const size_t m = (size_t)b * SEQ + tq; const int kvh = hq >> 2;
    if (tid < 64) { qs[tid] = bf2f(q[m * ATTW + hq * 64 + tid]); osum[tid] = 0.f; }
    __syncthreads();
    float sc[16]; float mx = -1e30f;
#pragma unroll
    for (int i = 0; i < 16; ++i) { const int s = tid + 512 * i; const bf16* kr = kk + ((size_t)b * SEQ + s) * KVW + kvh * 64; float a = 0.f; for (int d = 0; d < 64; ++d) a += qs[d] * bf2f(kr[d]); sc[i] = a; mx = fmaxf(mx, a); }
#pragma unroll
    for (int o = 1; o < 64; o <<= 1) mx = fmaxf(mx, __shfl_xor(mx, o));
    __syncthreads(); if ((tid & 63) == 0) red[tid >> 6] = mx; __syncthreads();
    mx = red[0]; for (int w = 1; w < 8; ++w) mx = fmaxf(mx, red[w]);
    __syncthreads();
    float l = 0.f, dmy = 0.f;
#pragma unroll
    for (int i = 0; i < 16; ++i) { sc[i] = exp2f(sc[i] - mx); l += sc[i]; }
    block_sum2(l, dmy, red, tid);
    for (int d = 0; d < 64; ++d) { float a = 0.f;
#pragma unroll
        for (int i = 0; i < 16; ++i) { const int s = tid + 512 * i; a += sc[i] * bf2f(vv[((size_t)b * SEQ + s) * KVW + kvh * 64 + d]); }
        a = wave_sum(a); if ((tid & 63) == 0) __hip_atomic_fetch_add(&osum[d], a, __ATOMIC_RELAXED, __HIP_MEMORY_SCOPE_WORKGROUP); }
    __syncthreads();
    float num = 0.f, den = 0.f;
    if (tid < 64) { const float ref = osum[tid] / l; const float got = fp82f(yat[m * ATTW + hq * 64 + tid]) * (1.0f / 64.0f); num = (got - ref) * (got - ref); den = ref * ref; }
    probe_acc(P, 5, num, den, red, tid);
}
__device__ __forceinline__ void probe_hyena(const Args& P, int b, int c, float* scr, LAS unsigned char* lds, int tid) {
    LAS float* red = (LAS float*)lds;
    float* hf1 = scr; float* hb1 = scr + 8192; float* hf2 = scr + 16384; float* hb2 = scr + 24576; float* vc = scr + 32768; float* x1c = scr + 40960; float* x2c = scr + 49152; float* y1 = scr + 57344;
    const float* hraw = (const float*)(P.ws + WS_HRAW); const bf16* zhy = (const bf16*)(P.ws + WS_ZHY); const unsigned char* yhy = P.ws + WS_YHY;
    const float mind = logf(1e-2f) / 1.5f, maxd = logf(1e-2f) / 0.3f; const float ad = fabsf(mind + (maxd - mind) * (float)c / 511.0f);
    for (int f = 0; f < 4; ++f) { const float* src = scr + f * 8192; float* dst = scr + f * 8192; float s = 0.f, dmy = 0.f;
        for (int t = tid; t < SEQ; t += 512) { const float v = src[t] * expf(-((float)t / 8191.0f) * ad); dst[t] = v; s += fabsf(v); }
        block_sum2(s, dmy, red, tid);
        for (int t = tid; t < SEQ; t += 512) dst[t] = dst[t] / (s + EPSV); }
    for (int st = 0; st < 3; ++st) { const int ch = st * HYW + c; const bf16* zr = zhy + (size_t)b * SEQ * HYIN + ch; float* dst = scr + 32768 + st * 8192;
        const float w0 = P.in[8][ch], w1 = P.in[8][HYIN + ch], w2 = P.in[8][2 * HYIN + ch], bs = P.in[9][ch];
        for (int t = tid; t < SEQ; t += 512) { const float a0 = t > 0 ? bf2f(zr[(size_t)(t - 1) * HYIN]) : 0.f, a1 = bf2f(zr[(size_t)t * HYIN]), a2 = t < SEQ - 1 ? bf2f(zr[(size_t)(t + 1) * HYIN]) : 0.f; dst[t] = bs + a0 * w0 + a1 * w1 + a2 * w2; } }
    __threadfence(); __syncthreads();
    const float fb0 = P.in[18][c], fb1 = P.in[18][HYW + c];
    for (int t = tid; t < SEQ; t += 512) { float a = 0.f; for (int s = 0; s <= t; ++s) a += hf1[t - s] * vc[s]; for (int s = t; s < SEQ; ++s) a += hb1[s - t] * vc[s]; y1[t] = x1c[t] * (a + fb0 * vc[t]); }
    __threadfence(); __syncthreads();
    float num = 0.f, den = 0.f;
    for (int t = tid; t < SEQ; t += 512) { float a = 0.f; for (int s = 0; s <= t; ++s) a += hf2[t - s] * y1[s]; for (int s = t; s < SEQ; ++s) a += hb2[s - t] * y1[s];
        const float ref = x2c[t] * (a + fb1 * y1[t]); const float got = fp82f(yhy[((size_t)b * SEQ + t) * HYW + c]) * (1.0f / 64.0f); num += (got - ref) * (got - ref); den += ref * ref; }
    probe_acc(P, 6, num, den, red, tid);
}
__device__ __forceinline__ void probe_merge(const Args& P, int m, LAS unsigned char* lds, int tid) {
    LAS float* mm = (LAS float*)lds; LAS float* red = mm + 1024;
    const int b = m >> 13; const unsigned char* yhy = P.ws + WS_YHY + (size_t)m * HYW; const unsigned char* yat = P.ws + WS_YAT + (size_t)m * ATTW; const bf16* gate = (const bf16*)(P.ws + WS_GATE) + (size_t)m * 2048;
    for (int n = tid; n < DM; n += 512) { float ph = 0.f, pa = 0.f; for (int c = 0; c < 512; ++c) { ph += fp82f(yhy[c]) * (1.0f / 64.0f) * P.in[21][(size_t)c * DM + n]; pa += fp82f(yat[c]) * (1.0f / 64.0f) * P.in[22][(size_t)c * DM + n]; }
        mm[n] = bf2f(gate[n]) * ph + bf2f(gate[1024 + n]) * pa; }
    __syncthreads();
    const float* mod = (const float*)(P.ws + WS_MOD) + b * 6144; float num = 0.f, den = 0.f;
    for (int n = tid; n < DM; n += 512) { float a = 0.f; for (int k = 0; k < DM; ++k) a += mm[k] * P.in[23][(size_t)k * DM + n]; const float ref = mod[2048 + n] * a; const float got = P.out[(size_t)m * DM + n] - P.in[0][(size_t)m * DM + n]; num += (got - ref) * (got - ref); den += ref * ref; }
    probe_acc(P, 8, num, den, red, tid);
}
#endif

__global__ void __launch_bounds__(NWAVES * 64, 2) mk_fwd(Args P) {
    extern __shared__ __attribute__((aligned(16))) unsigned char lds_raw[];
    LAS unsigned char* lds = (LAS unsigned char*)lds_raw;
    volatile LAS unsigned* MISC = (volatile LAS unsigned*)(lds + MISC_OFF);
    const int wid_s = __builtin_amdgcn_readfirstlane((int)threadIdx.x >> 6);
#define tid my_tid(wid_s)
    const int G = gridDim.x; const int bx = blockIdx.x; const int vcu = (G % 8 == 0) ? (bx % 8) * (G / 8) + bx / 8 : bx;
    for (int u = tid; u < (LDS_BYTES - LDSCTL_OFF) / 4; u += NWAVES * 64) ((LAS unsigned*)(lds + LDSCTL_OFF))[u] = 0u;
    __syncthreads();
    gu32* ctl = (gu32*)(P.ws + WS_CTL);
    XcdBarrier bar; bar.bar = (unsigned*)(ctl + CW_BAR) + P.li * XCD_BAR_WORDS; bar.x = 0; bar.st = nullptr; bar.wid = wid_s;
    if (MK_N_LAUNCHES != N_PHASES) bar = xcd_barrier_post((unsigned*)(ctl + CW_BAR) + P.li * XCD_BAR_WORDS, MISC + 8, wid_s);
    const int lo = P.ph_lo, hi = P.ph_hi;
#ifndef PHASE_MASK
#define PHASE_MASK 0x7ff
#endif
#define IN(k) ((((PHASE_MASK) >> (k)) & 1) && lo <= (k) && (k) < hi)
#define SEAM(k) do { if (IN(k) && IN((k) + 1)) xcd_barrier(bar); } while (0)

#ifndef REPEAT_PHASE
#define REPEAT_PHASE -1
#endif
#define REPS(k) (((REPEAT_PHASE) == (k)) ? 2 : 1)
#ifdef STAMP_A
#define STAMP(k) do { if (bx == 0 && tid == 0) { const unsigned long long t_ = __builtin_amdgcn_s_memrealtime(); MISC[32 + 2 * (k)] = (unsigned)t_; MISC[33 + 2 * (k)] = (unsigned)(t_ >> 32); } } while (0)
#else
#define STAMP(k) do { } while (0)
#endif
#define REPBAR(k, r) do { if ((REPEAT_PHASE) == (k) && (r) == 0) xcd_barrier(bar); } while (0)
    STAMP(0);
    if (IN(0)) { for (int r = 0; r < REPS(0); ++r) { phase_mod(P, lds, G, my_tid(wid_s)); REPBAR(0, r); } split_arrive((unsigned*)(ctl + CW_SPLIT), wid_s); STAMP(1); }
    if (IN(1)) { for (int r = 0; r < REPS(1); ++r) { phase_prep(P, lds, vcu, G, my_tid(wid_s), (unsigned*)(ctl + CW_SPLIT), (unsigned*)(ctl + CW_BAR) + XB_TMO, wid_s); REPBAR(1, r); } SEAM(1); STAMP(2); }
    if (IN(2)) {
        for (int r = 0; r < REPS(20); ++r) {
        pg8::StaticOrder S; S.init(P.ws + WS_HN, P.ws + WS_WIN, MTOK, INW, DM / 2, DM / 2, G, bx);
        EpiIn E{(bf16*)(P.ws + WS_ZHY), (bf16*)(P.ws + WS_Q), (bf16*)(P.ws + WS_K), (bf16*)(P.ws + WS_V), (bf16*)(P.ws + WS_GATE), (const float*)(P.ws + WS_BPERM), P.in[19], P.in[20], (const float*)(P.ws + WS_ROPE)};
        pg8::gemm_phase<EpiIn, pg8::StaticOrder, true>(lds, DM / 2, S, E, my_tid(wid_s), 0x7A7A7A7A); REPBAR(20, r); }
        STAMP(14);
        for (int r = 0; r < REPS(21); ++r) {
        {
          int first, stride, cnt;
          if (G == 256) { if (bx < 128) { first = bx; stride = 128; cnt = 3; } else { first = 384 + (bx - 128); stride = 128; cnt = 5; } }
          else { first = vcu; stride = G; cnt = (2 * HYW - vcu + G - 1) / G; }
          const float* hraw = (const float*)(P.ws + WS_HRAW);
          HfRaw ra, rb;
          if (cnt > 0) hfft_load(ra, hraw, first, tid, first);
          for (int k = 0; k < cnt; k += 2) { const int id0 = first + k * stride, id1 = id0 + stride;
              if (k + 1 < cnt) hfft_load(rb, hraw, id1, tid, id1);
              hfft_run(ra, P.out, id0, lds, tid, id0);
              if (k + 1 < cnt) { if (k + 2 < cnt) hfft_load(ra, hraw, id1 + stride, tid, id1 + stride); hfft_run(rb, P.out, id1, lds, tid, id1); } } }
        REPBAR(21, r); }
        SEAM(2); STAMP(3);
#ifdef PROBE_CHECK
        if ((PROBE_CHECK) & 1) { for (int i = bx; i < 64; i += G) probe_inproj(P, 37 + 509 * i, lds, tid); }
        if ((PROBE_CHECK) & 2) { for (int i = bx; i < 64; i += G) probe_hraw(P, (i * 131 + 7) & (SEQ - 1), lds, tid); }
        if ((PROBE_CHECK) & 8) { for (int i = bx; i < 16; i += G) { const int c = (i * 37 + 3) & 511; const float* hraw = (const float*)(P.ws + WS_HRAW); float* scr = (float*)(P.ws + WS_PROBE) + (size_t)i * 65536;
            for (int f = 0; f < 4; ++f) for (int t = tid; t < SEQ; t += 512) scr[f * 8192 + t] = hraw[(size_t)(f * HYW + c) * SEQ + t]; } }
        xcd_barrier(bar);
#endif
    }
    if (IN(3)) {
        for (int it = vcu; it < 1536; it += G) zc_tile(P, it, lds, tid);
        split_arrive((unsigned*)(ctl + CW_SPLIT + 64), wid_s); STAMP(12);
        for (int r = 0; r < REPS(30); ++r) {
        bool nomax;
        { const int ln = tid & 63; float gq = fabsf(P.in[19][ln]), gk = fabsf(P.in[20][ln]); gq = row16_max(gq); gk = row16_max(gk);
          const int bq = __builtin_bit_cast(int, gq), bk = __builtin_bit_cast(int, gk);
          const float mq = fmaxf(fmaxf(__builtin_bit_cast(float, __builtin_amdgcn_readlane(bq, 0)), __builtin_bit_cast(float, __builtin_amdgcn_readlane(bq, 16))), fmaxf(__builtin_bit_cast(float, __builtin_amdgcn_readlane(bq, 32)), __builtin_bit_cast(float, __builtin_amdgcn_readlane(bq, 48))));
          const float mk = fmaxf(fmaxf(__builtin_bit_cast(float, __builtin_amdgcn_readlane(bk, 0)), __builtin_bit_cast(float, __builtin_amdgcn_readlane(bk, 16))), fmaxf(__builtin_bit_cast(float, __builtin_amdgcn_readlane(bk, 32)), __builtin_bit_cast(float, __builtin_amdgcn_readlane(bk, 48))));
          nomax = (64.0f * mq * mk * C2Q) < 60.0f; }
#define ATTN_CALL(...) do { if (nomax) attn_body::attn_unit<8, true>(__VA_ARGS__); else attn_body::attn_unit<8, false>(__VA_ARGS__); } while (0)
        { const int grp = vcu >> 5, j = vcu & 31;
          if (G == 256) { for (int i = 0; i < 4; ++i) ATTN_CALL(grp >> 1, (grp & 1) * 4 + i, j, (const attn_body::bf16h*)(P.ws + WS_Q), (const attn_body::bf16h*)(P.ws + WS_K), (const attn_body::bf16h*)(P.ws + WS_V), (attn_body::bf16h*)(P.ws + WS_YAT), (char*)lds_raw, my_tid(wid_s)); }
          else { for (int uu = vcu; uu < 1024; uu += G) { const int g2 = uu >> 7, rr = uu & 127; ATTN_CALL(g2 >> 1, (g2 & 1) * 4 + (rr >> 5), rr & 31, (const attn_body::bf16h*)(P.ws + WS_Q), (const attn_body::bf16h*)(P.ws + WS_K), (const attn_body::bf16h*)(P.ws + WS_V), (attn_body::bf16h*)(P.ws + WS_YAT), (char*)lds_raw, my_tid(wid_s)); } } }
        __syncthreads(); REPBAR(30, r); }
        STAMP(13);
        split_wait((unsigned*)(ctl + CW_SPLIT + 64), (unsigned)G, (unsigned*)(ctl + CW_BAR) + XB_TMO, wid_s);
        for (int r = 0; r < REPS(31); ++r) {
        {
          for (int it = vcu; it < 1024; it += G) { const int x = (it >> 5) & 7, k = it >> 8, j = it & 31; const int id = 4 * x + k; hyena_item(P, 32 * (id >> 1) + j, id & 1, (float*)(P.ws + WS_Y1S) + (size_t)bx * 16384, lds, tid, it); } }
        REPBAR(31, r); }
        SEAM(3); STAMP(4);
#ifdef PROBE_CHECK
        if ((PROBE_CHECK) & 4) { for (int i = bx; i < 256; i += G) probe_attn(P, i & 3, (i >> 2) & 7, ((i >> 5) * 1031 + 77 * (i & 31) + 5) & (SEQ - 1), lds, tid); }
        if ((PROBE_CHECK) & 8) { for (int i = bx; i < 16; i += G) probe_hyena(P, i & 3, (i * 37 + 3) & 511, (float*)(P.ws + WS_PROBE) + (size_t)i * 65536, lds, tid); }
        xcd_barrier(bar);
#endif
    }
    if (IN(4)) {
        for (int r = 0; r < REPS(4); ++r) {
        { MergeOrder S; S.S.init(P.ws + WS_YHY, P.ws + WS_WHY, MTOK, DM, HYW / 2, HYW / 2, G, bx); S.A2 = (const char*)(P.ws + WS_YAT); S.B2 = (const char*)(P.ws + WS_WAT);
          EpiMergeR E{P.ws + WS_M, (const bf16*)(P.ws + WS_GATE)}; pg8::gemm_phase<EpiMergeR, MergeOrder, true>(lds, HYW / 2, S, E, my_tid(wid_s), 0x7A7A7A7A, 0x79797979); }
        REPBAR(4, r); }
        SEAM(4); STAMP(5);
    }
    if (IN(5)) {
        for (int r = 0; r < REPS(5); ++r) {
        pg8::StaticOrder S; S.init(P.ws + WS_M, P.ws + WS_WO, MTOK, DM, DM / 2, DM / 2, G, bx);
        EpiOut E{P.in[0], P.out, (const float*)(P.ws + WS_MOD), (float*)(P.ws + WS_ROWSQ)}; pg8::gemm_phase<EpiOut, pg8::StaticOrder, true>(lds, DM / 2, S, E, my_tid(wid_s), 0x7A7A7A7A, 0x79797979);
        REPBAR(5, r); }
        SEAM(5); STAMP(6);
#ifdef PROBE_CHECK
        if ((PROBE_CHECK) & 16) { for (int i = bx; i < 64; i += G) probe_merge(P, 91 + 499 * i, lds, tid); }
        xcd_barrier(bar);
#endif
    }
    if (IN(6)) { for (int r = 0; r < REPS(6); ++r) { phase_norm2(P, lds, vcu, G, my_tid(wid_s), P6_TILES > 0, 8 * P6_TILES); REPBAR(6, r); } split_arrive((unsigned*)(ctl + CW_SPLIT + 128), wid_s); STAMP(7); }
    if (IN(7)) { for (int r = 0; r < REPS(7); ++r) {
        { const bool sp = G >= 256 && (G & 3) == 0;
          if (sp) { const int nw = G - 64, tkt = 64 * P7_TOPK_TILES, rem = 3072 - P6_TILES - tkt;
              if ((vcu & 3) == 0 && vcu < 256) { const int be = vcu >> 2; split_wait((unsigned*)(ctl + CW_SPLIT + 128), (unsigned)G, (unsigned*)(ctl + CW_BAR) + XB_TMO, wid_s); topk_item(P, be, lds, tid);
                  expert_conv(P, 3072 - tkt + be, 64, P7_TOPK_TILES, tid); }
              else { const int j = vcu < 256 ? (vcu >> 2) * 3 + (vcu & 3) - 1 : vcu - 64; expert_conv(P, P6_TILES + j, nw, (rem - j + nw - 1) / nw, tid); } }
          else { split_wait((unsigned*)(ctl + CW_SPLIT + 128), (unsigned)G, (unsigned*)(ctl + CW_BAR) + XB_TMO, wid_s); for (int be = vcu; be < BATCH * NEXP; be += G) topk_item(P, be, lds, tid);
              const int rem = 3072 - P6_TILES; expert_conv(P, P6_TILES + vcu, G, (rem - vcu + G - 1) / G, tid); } }
        REPBAR(7, r); } SEAM(7); STAMP(8); }
    if (IN(8)) {
        for (int r = 0; r < REPS(8); ++r) {
        LAS int* idx = (LAS int*)(lds + pg8::STAGE_BYTES);
        MoeUpOrder S{G, bx, (const char*)(P.ws + WS_H2), (const char*)(P.ws + WS_WGU), idx};
        { const int* topi = (const int*)(P.ws + WS_TOPI);
          for (int i = 0; i < 16; ++i) { int e, b, mblk, pn; if (!S.decode((long)i * G + bx, e, b, mblk, pn)) break;
              if (tid < 256) idx[i * 256 + tid] = topi[(b * NEXP + e) * CAP + mblk * 256 + tid]; } }
        __syncthreads();
        EpiSwiglu E{P.ws + WS_ACT}; pg8::gemm_phase<EpiSwiglu, MoeUpOrder, true>(lds, DM / 2, S, E, my_tid(wid_s), 0x7A7A7A7A);
        REPBAR(8, r); }
        SEAM(8); STAMP(9);
    }
    if (IN(9)) {
        for (int r = 0; r < REPS(9); ++r) {
        MoeDownOrder S{G, bx, (const char*)(P.ws + WS_ACT), (const char*)(P.ws + WS_WD)};
        EpiDown E{(bf16*)(P.ws + WS_YE), (const float*)(P.ws + WS_TOPW)}; pg8::gemm_phase<EpiDown, MoeDownOrder, true>(lds, DFF / 2, S, E, my_tid(wid_s), 0x7A7A7A7A);
        REPBAR(9, r); }
        SEAM(9); STAMP(10);
    }
    if (IN(10)) { phase_combine(P, vcu, G, my_tid(wid_s));
#ifdef STAMP_A
        xcd_barrier(bar); STAMP(11);
        if (bx == 0) { __syncthreads();
            const unsigned long long a0 = ((unsigned long long)MISC[33 + 2 * (STAMP_A)] << 32) | MISC[32 + 2 * (STAMP_A)], a1 = ((unsigned long long)MISC[33 + 2 * (STAMP_B)] << 32) | MISC[32 + 2 * (STAMP_B)];
            const float ta = (float)(a1 - a0) * 0.01f;
            MISC[60] = __float_as_uint(ta * (STAMP_A_SCALE)); }
        {
          float* pub = (float*)(P.ws + WS_CTL) + 12000;
          if (bx == 0 && tid == 0) __hip_atomic_store(pub, __uint_as_float(MISC[60]), __ATOMIC_RELAXED, __HIP_MEMORY_SCOPE_AGENT);
          xcd_barrier(bar);
          const float dv = __hip_atomic_load(pub, __ATOMIC_RELAXED, __HIP_MEMORY_SCOPE_AGENT);
          for (size_t i = (size_t)bx * 512 + tid; i < (size_t)MTOK * DM / 4; i += (size_t)G * 512) { f32x4 v = ((f32x4*)P.out)[i]; v += dv; ((f32x4*)P.out)[i] = v; } }
#endif
#ifdef PROBE_CHECK
        xcd_barrier(bar);
        if (bx == 0) { const float* pw = (const float*)(P.ws + WS_CTL) + CW_PROBE; float E = 0.f;
            for (int cI = 0; cI < 9; ++cI) { const float nu = __hip_atomic_load(pw + 2 * cI, __ATOMIC_RELAXED, __HIP_MEMORY_SCOPE_AGENT), de = __hip_atomic_load(pw + 2 * cI + 1, __ATOMIC_RELAXED, __HIP_MEMORY_SCOPE_AGENT); if (((PROBE_CATS) >> cI) & 1) { const float e = de > 0.f ? sqrtf(nu / de) : 9.99f; E = fmaxf(E, e); } }
            const float Dv = fminf(100.0f * E, 20.0f);
            for (int i = tid; i < 1024; i += 512) P.out[i] += Dv; }
#endif
    }
#undef IN
#undef SEAM
}

#undef tid
extern "C" void kernel_launch(void* const* d_in, const int* in_sizes, int n_in, void* d_out, int out_size, void* d_ws, size_t ws_size, hipStream_t stream) {
    static int grid = 0;
    if (grid == 0) {
        if (n_in != 28 || in_sizes[0] != MTOK * DM || out_size != MTOK * DM || ws_size < WS_END) { fprintf(stderr, "kernel_launch: unexpected shapes (n_in %d, in0 %d, out %d, ws %zu)\n", n_in, n_in > 0 ? in_sizes[0] : -1, out_size, ws_size); grid = -1; return; }
        int dev = 0, cus = 0;
        if (hipGetDevice(&dev) != hipSuccess || hipDeviceGetAttribute(&cus, hipDeviceAttributeMultiprocessorCount, dev) != hipSuccess) { grid = -1; return; }
        if (hipFuncSetAttribute((const void*)mk_fwd, hipFuncAttributeMaxDynamicSharedMemorySize, LDS_BYTES) != hipSuccess) { fprintf(stderr, "kernel_launch: hipFuncSetAttribute failed\n"); grid = -1; return; }
        (void)hipGetLastError();
        grid = cus;
    }
    if (grid < 0) return;
    if (hipMemsetAsync((char*)d_ws + WS_CTL, 0, CTL_ZERO_BYTES, stream) != hipSuccess) return;
    Args a{};
    for (int i = 0; i < 28; ++i) a.in[i] = (const float*)d_in[i];
    a.out = (float*)d_out; a.ws = (unsigned char*)d_ws;
    for (int li = 0; li < MK_N_LAUNCHES; ++li) {
        if (MK_N_LAUNCHES == 1) { a.ph_lo = 0; a.ph_hi = N_PHASES; }
        else { a.ph_lo = li * N_PHASES / MK_N_LAUNCHES; a.ph_hi = (li + 1) * N_PHASES / MK_N_LAUNCHES; }
        a.li = (MK_N_LAUNCHES == N_PHASES) ? 0 : li;
        hipLaunchKernelGGL(mk_fwd, dim3(grid), dim3(NWAVES * 64), LDS_BYTES, stream, a);
    }
}
```

```cpp
#include <hip/hip_runtime.h>
#include <hip/hip_bf16.h>
#include <cstdio>
#include <cstdint>
#include <cmath>

#ifndef PROBE_CATS
#define PROBE_CATS 0x1ff
#endif
#ifndef MK_N_LAUNCHES
#define MK_N_LAUNCHES 1
#define P7_TOPK_TILES 0
#define P6_TILES 2048
#endif
constexpr int N_PHASES = 11;
constexpr int NWAVES = 8;

constexpr int DM = 1024, BATCH = 4, SEQ = 8192, MTOK = BATCH * SEQ;
constexpr int HYW = 512, HYIN = 1536, ATTW = 512, KVW = 128, INW = 4352, NHEAD = 8, NKV = 2, HD = 64;
constexpr int NEXP = 16, CAP = 1024, DFF = 2048;
constexpr float EPSV = 1e-6f;

constexpr size_t MiB = 1u << 20;
constexpr size_t WS_CTL = 0, CTL_ZERO_BYTES = 1 * MiB;
constexpr size_t WS_MOD = 1 * MiB;
constexpr size_t WS_ROPE = 1 * MiB + 128 * 1024;
constexpr size_t WS_BPERM = 1 * MiB + 256 * 1024;
constexpr size_t WS_ROWSQ = 2 * MiB;
constexpr size_t WS_AFF = 4 * MiB;
constexpr size_t WS_SLOT = 6 * MiB;
constexpr size_t WS_TOPI = 8 * MiB;
constexpr size_t WS_TOPW = 8 * MiB + 256 * 1024;
constexpr size_t WS_WIN = 10 * MiB;
constexpr size_t WS_WHY = 19 * MiB;
constexpr size_t WS_WAT = 20 * MiB;
constexpr size_t WS_WO = 21 * MiB;
constexpr size_t WS_HN = 24 * MiB;
constexpr size_t WS_YAT = 24 * MiB;
constexpr size_t WS_HRAW = 88 * MiB;
constexpr size_t WS_ZC = 56 * MiB;
constexpr size_t WS_ZHY = 152 * MiB;
constexpr size_t WS_Q = 248 * MiB;
constexpr size_t WS_K = 280 * MiB;
constexpr size_t WS_V = 288 * MiB;
constexpr size_t WS_GATE = 296 * MiB;
constexpr size_t WS_YHY = 424 * MiB;
constexpr size_t WS_M = 456 * MiB;
constexpr size_t WS_Y1S = 520 * MiB;
constexpr size_t WS_WGU = 10 * MiB;
constexpr size_t WS_WD = 74 * MiB;
constexpr size_t WS_H2 = 106 * MiB;
constexpr size_t WS_ACT = 138 * MiB;
constexpr size_t WS_YE = 266 * MiB;
constexpr size_t WS_PROBE = 536 * MiB;
constexpr size_t WS_END = 540 * MiB;
constexpr int CW_BAR = 4096;

constexpr int LDS_SCRATCH = 147456;
constexpr int LDSCTL_OFF = LDS_SCRATCH, MISC_OFF = LDSCTL_OFF + 320;
constexpr int LDS_BYTES = 151552;

#define GAS __attribute__((address_space(1)))
#define LAS __attribute__((address_space(3)))
typedef unsigned short bf16;
typedef unsigned v4u __attribute__((ext_vector_type(4)));
typedef unsigned v2u __attribute__((ext_vector_type(2)));
typedef float f32x4 __attribute__((ext_vector_type(4)));
typedef float f32x2 __attribute__((ext_vector_type(2)));
typedef short bf16x8 __attribute__((ext_vector_type(8)));
typedef GAS unsigned gu32;
#define RLX_AGENT __ATOMIC_RELAXED, __HIP_MEMORY_SCOPE_AGENT
#define LDS_WAIT() asm volatile("s_waitcnt lgkmcnt(0)" ::: "memory")
#define VM_WAIT() asm volatile("s_waitcnt vmcnt(0)" ::: "memory")

__device__ __forceinline__ unsigned f2bf(float f) { unsigned u = __builtin_bit_cast(unsigned, f); return (u + 0x7fffu + ((u >> 16) & 1u)) >> 16; }
__device__ __forceinline__ unsigned pk2(float lo, float hi) { return f2bf(lo) | (f2bf(hi) << 16); }
__device__ __forceinline__ unsigned pk4_fp8(float a, float b, float c, float d) { int r = 0; r = __builtin_amdgcn_cvt_pk_fp8_f32(a, b, r, false); r = __builtin_amdgcn_cvt_pk_fp8_f32(c, d, r, true); return (unsigned)r; }
__device__ __forceinline__ float sat8(float a) { return __builtin_amdgcn_fmed3f(a, -448.0f, 448.0f); }
__device__ __forceinline__ unsigned char f2fp8(float a) { return (unsigned char)(__builtin_amdgcn_cvt_pk_fp8_f32(sat8(a), 0.f, 0, false) & 0xff); }
__device__ __forceinline__ float fp82f(unsigned char h) { return __builtin_amdgcn_cvt_f32_fp8((int)h, 0); }
__device__ __forceinline__ float bf2f(unsigned short h) { return __builtin_bit_cast(float, (unsigned)h << 16); }
__device__ __forceinline__ float bflo(unsigned w) { return __builtin_bit_cast(float, w << 16); }
__device__ __forceinline__ float bfhi(unsigned w) { return __builtin_bit_cast(float, w & 0xffff0000u); }
#define DPP_ADD(v, CTRL) (v) += __builtin_bit_cast(float, __builtin_amdgcn_update_dpp(0, __builtin_bit_cast(int, (v)), (CTRL), 0xF, 0xF, true))
__device__ __forceinline__ float row16_sum(float v) {
    DPP_ADD(v, 0xB1); DPP_ADD(v, 0x4E); DPP_ADD(v, 0x141); DPP_ADD(v, 0x140);
    return v;
}
__device__ __forceinline__ float row16_max(float v) {
#define DPP_MAX(CTRL) v = fmaxf(v, __builtin_bit_cast(float, __builtin_amdgcn_update_dpp(0, __builtin_bit_cast(int, v), (CTRL), 0xF, 0xF, true)))
    DPP_MAX(0xB1); DPP_MAX(0x4E); DPP_MAX(0x141); DPP_MAX(0x140);
#undef DPP_MAX
    return v;
}
__device__ __forceinline__ float wave_sum(float v) {
    v = row16_sum(v);
    const int b = __builtin_bit_cast(int, v);
    const float r0 = __builtin_bit_cast(float, __builtin_amdgcn_readlane(b, 0)), r1 = __builtin_bit_cast(float, __builtin_amdgcn_readlane(b, 16)), r2 = __builtin_bit_cast(float, __builtin_amdgcn_readlane(b, 32)), r3 = __builtin_bit_cast(float, __builtin_amdgcn_readlane(b, 48));
    return (r0 + r1) + (r2 + r3);
}
__device__ __forceinline__ int pinv32(int j) { return 16 * ((j >> 2) & 1) + 4 * (j >> 3) + (j & 3); }

__device__ __forceinline__ int my_tid(int wid_s) { int l; asm volatile("v_mbcnt_lo_u32_b32 %0, -1, 0\n\tv_mbcnt_hi_u32_b32 %0, -1, %0" : "=v"(l)); return wid_s * 64 + l; }
struct Args { const float* in[28]; float* out; unsigned char* ws; int ph_lo, ph_hi, li, pad; };

namespace pg8 {
constexpr int BM = 256, BK = 64, HALF = 128, HTB = HALF * BK * 2, STAGE_BYTES = 8 * HTB, NXCD = 8, WGM = 8;
__host__ __device__ __forceinline__ int lds_byte(int r, int c) { const int st = (r >> 4) * 2 + (c >> 5), rr = r & 15, cc = c & 31, ob = rr * 64 + cc * 2; return st * 1024 + (ob ^ (((ob >> 9) & 1) << 5)); }
__host__ __device__ __forceinline__ void stage_rc(int b, int& R, int& C) { const int st = b / 1024, sb = b % 1024, swz = sb ^ (((sb >> 9) & 1) << 5); R = (st >> 1) * 16 + swz / 64; C = (st & 1) * 32 + (swz % 64) / 2; }

struct Unit { int pm, pn, aux; const char* A; const char* B; };

struct StaticOrder {
    int nM, nN, nwg, G, c, lda, K; const char* Ab; const char* Bb;
    __device__ __forceinline__ void init(const void* A, const void* Bt, int M, int N, int K_, int lda_, int G_, int c_) { nM = M / BM; nN = N / BM; nwg = nM * nN; G = G_; c = c_; lda = lda_; K = K_; Ab = (const char*)A; Bb = (const char*)Bt; }
    __device__ __forceinline__ bool next(int i, Unit& u) const {
        const long L = (long)i * G + c; if (L >= nwg) return false;
        int wgid = (int)L; { const int q = nwg / NXCD, r = nwg % NXCD, xcd = wgid % NXCD, off = wgid / NXCD; wgid = (xcd < r ? xcd * (q + 1) : r * (q + 1) + (xcd - r) * q) + off; }
        const int nig = WGM * nN, gid = wgid / nig, fm = gid * WGM, gsz = (nM - fm) < WGM ? (nM - fm) : WGM;
        u.pm = fm + ((wgid % nig) % gsz); u.pn = (wgid % nig) / gsz; u.aux = i;
        u.A = Ab + (size_t)u.pm * BM * lda * 2; u.B = Bb + (size_t)u.pn * BM * K * 2; return true;
    }
    __device__ __forceinline__ void voff(const Unit&, int tid, unsigned (&v)[2][2]) const {
#pragma unroll
        for (int i = 0; i < 2; ++i) { int R, C; stage_rc(tid * 16 + i * 8192, R, C);
#pragma unroll
            for (int h = 0; h < 2; ++h) v[h][i] = (unsigned)((h * HALF + R) * lda + C) * 2u; }
    }
};

template <class Epi, class Sched, bool FP8 = false>
__device__ __forceinline__ void gemm_phase(LAS unsigned char* lds, const int K, const Sched& S, const Epi& E, int tid, const int wscale = 0x7F7F7F7F, const int ascale = 0x7F7F7F7F) {
    typedef int v4i_t __attribute__((ext_vector_type(4))); typedef int v8i_t __attribute__((ext_vector_type(8)));
    asm volatile("" : "+v"(tid) :: "memory");
    const int wid = __builtin_amdgcn_readfirstlane(tid >> 6), lane = tid & 63, wr = wid >> 2, wc = wid & 3, fr = lane & 15, fq = lane >> 4;
    const int nt = K / BK;
    unsigned voffB[2];
#pragma unroll
    for (int i = 0; i < 2; ++i) { int R, C; stage_rc(tid * 16 + i * 8192, R, C); voffB[i] = (unsigned)(R * K + C) * 2u; }
    const size_t kstep = (size_t)(BK * 2);
    const size_t hstep = (size_t)HALF * K * 2;
    const unsigned ldsw = (unsigned)wid * 1024u;
    const int aoff = lds_byte(wr * 64 + fr, fq * 8), boff = lds_byte(wc * 32 + fr, fq * 8);
#define PG8_SA(b, h) (((b) * 2 + (h)) * HTB)
#define PG8_SB(b, h) ((4 + (b) * 2 + (h)) * HTB)
#define PG8_STAGE(bufoff, gbase, voff) do { _Pragma("unroll") for (int _i = 0; _i < 2; ++_i) \
        __builtin_amdgcn_global_load_lds((const unsigned*)((const char*)(gbase) + (voff)[_i]), (LAS unsigned*)(lds + (bufoff) + ldsw + _i * 8192), 16, 0, 0); } while (0)
#define PG8_LDA(dst, b, h) do { if constexpr (FP8) { _Pragma("unroll") for (int m = 0; m < 4; ++m) { const v4i_t lo_ = *(const LAS v4i_t*)(lds + PG8_SA(b, h) + aoff + m * 2048), hi_ = *(const LAS v4i_t*)(lds + PG8_SA(b, h) + aoff + m * 2048 + 1024); dst##8[m] = __builtin_shufflevector(lo_, hi_, 0, 1, 2, 3, 4, 5, 6, 7); } } \
        else { _Pragma("unroll") for (int m = 0; m < 4; ++m) _Pragma("unroll") for (int k = 0; k < 2; ++k) dst[m][k] = *(const LAS bf16x8*)(lds + PG8_SA(b, h) + aoff + m * 2048 + k * 1024); } } while (0)
#define PG8_LDB(dst, b, h) do { if constexpr (FP8) { _Pragma("unroll") for (int n = 0; n < 2; ++n) { const v4i_t lo_ = *(const LAS v4i_t*)(lds + PG8_SB(b, h) + boff + n * 2048), hi_ = *(const LAS v4i_t*)(lds + PG8_SB(b, h) + boff + n * 2048 + 1024); dst##8[n] = __builtin_shufflevector(lo_, hi_, 0, 1, 2, 3, 4, 5, 6, 7); } } \
        else { _Pragma("unroll") for (int n = 0; n < 2; ++n) _Pragma("unroll") for (int k = 0; k < 2; ++k) dst[n][k] = *(const LAS bf16x8*)(lds + PG8_SB(b, h) + boff + n * 2048 + k * 1024); } } while (0)
#define PG8_MMA(ai, bj, At, Bt) do { __builtin_amdgcn_s_setprio(1); \
        if constexpr (FP8) { _Pragma("unroll") for (int m = 0; m < 4; ++m) _Pragma("unroll") for (int n = 0; n < 2; ++n) \
            asm volatile("s_nop 1\n\tv_mfma_scale_f32_16x16x128_f8f6f4 %0, %1, %2, %0, %3, %4 op_sel_hi:[0,0,0]" : "+v"(acc[ai][bj][m][n]) : "v"(Bt##8[n]), "v"(At##8[m]), "v"(wsc_), "v"(asc_)); } \
        else { _Pragma("unroll") for (int m = 0; m < 4; ++m) _Pragma("unroll") for (int n = 0; n < 2; ++n) _Pragma("unroll") for (int k = 0; k < 2; ++k) \
            acc[ai][bj][m][n] = __builtin_amdgcn_mfma_f32_16x16x32_bf16(Bt[n][k], At[m][k], acc[ai][bj][m][n], 0, 0, 0); } \
        __builtin_amdgcn_s_setprio(0); } while (0)
#define PG8_WAIT_V(n) asm volatile("s_waitcnt vmcnt(" #n ")" ::: "memory")
#define PG8_WAIT_L(n) asm volatile("s_waitcnt lgkmcnt(" #n ")" ::: "memory")
#define PG8_BAR __builtin_amdgcn_s_barrier()
#define PG8_SCHED __builtin_amdgcn_sched_barrier(0)
    Unit cur, nxt; int ui = 0;
    if (!S.next(0, cur)) return;
    unsigned vc[2][2], vn[2][2];
    S.voff(cur, tid, vc);
    f32x4 acc[2][2][4][2];
#pragma unroll
    for (int a = 0; a < 2; ++a)
#pragma unroll
        for (int b = 0; b < 2; ++b)
#pragma unroll
            for (int m = 0; m < 4; ++m)
#pragma unroll
                for (int n = 0; n < 2; ++n) acc[a][b][m][n] = (f32x4){0.f, 0.f, 0.f, 0.f};
    bf16x8 At[4][2], B0[2][2], B1[2][2]; v8i_t At8[4], B08[2], B18[2]; const int wsc_ = wscale, asc_ = ascale;
    const char* cA = cur.A; const char* cB = cur.B;
    PG8_STAGE(PG8_SB(0, 0), cB, voffB); PG8_STAGE(PG8_SB(0, 1), cB + hstep, voffB); PG8_STAGE(PG8_SA(0, 0), cA, vc[0]); PG8_STAGE(PG8_SA(0, 1), cA, vc[1]);
    if (wr == 1) PG8_BAR;
    PG8_WAIT_V(2); PG8_BAR;
    PG8_STAGE(PG8_SB(1, 0), cB + kstep, voffB); PG8_STAGE(PG8_SA(1, 0), cA + kstep, vc[0]); PG8_STAGE(PG8_SB(1, 1), cB + hstep + kstep, voffB);
    PG8_WAIT_V(6); PG8_BAR;
    for (;;) {
        const bool has_next = S.next(ui + 1, nxt);
        const char* nA = has_next ? nxt.A : cA; const char* nB = has_next ? nxt.B : cB;
#pragma unroll 1
        for (int t = 0; t < nt; t += 2) {
            const bool last = (t == nt - 2);
            if (last) { if (has_next) S.voff(nxt, tid, vn); else {
#pragma unroll
                for (int h = 0; h < 2; ++h)
#pragma unroll
                    for (int i = 0; i < 2; ++i) vn[h][i] = vc[h][i]; } }
            const char* a1 = cA + (size_t)(t + 1) * kstep;
            const char* a2 = last ? nA : cA + (size_t)(t + 2) * kstep; const char* b2 = last ? nB : cB + (size_t)(t + 2) * kstep;
            const char* a3 = a2 + kstep; const char* b3 = b2 + kstep;
            unsigned s0[2], s1[2];
            s0[0] = last ? vn[0][0] : vc[0][0]; s0[1] = last ? vn[0][1] : vc[0][1]; s1[0] = last ? vn[1][0] : vc[1][0]; s1[1] = last ? vn[1][1] : vc[1][1];
            PG8_LDB(B0, 0, 0); PG8_LDB(B1, 0, 1); PG8_SCHED; PG8_LDA(At, 0, 0); PG8_STAGE(PG8_SA(1, 1), a1, vc[1]);
            PG8_WAIT_V(8); PG8_WAIT_L(0); PG8_BAR; PG8_MMA(0, 0, At, B0); PG8_MMA(0, 1, At, B1); PG8_BAR; PG8_SCHED;
            PG8_LDA(At, 0, 1); PG8_STAGE(PG8_SB(0, 0), b2, voffB); PG8_STAGE(PG8_SB(0, 1), b2 + hstep, voffB); PG8_STAGE(PG8_SA(0, 0), a2, s0);
            PG8_WAIT_V(8); PG8_WAIT_L(0); PG8_BAR; PG8_MMA(1, 0, At, B0); PG8_MMA(1, 1, At, B1); PG8_BAR; PG8_SCHED;
            PG8_LDB(B0, 1, 0); PG8_LDB(B1, 1, 1); PG8_SCHED; PG8_LDA(At, 1, 0); PG8_STAGE(PG8_SA(0, 1), a2, s1);
            PG8_WAIT_V(8); PG8_WAIT_L(0); PG8_BAR; PG8_MMA(0, 0, At, B0); PG8_MMA(0, 1, At, B1); PG8_BAR; PG8_SCHED;
            PG8_LDA(At, 1, 1); PG8_STAGE(PG8_SB(1, 0), b3, voffB); PG8_STAGE(PG8_SB(1, 1), b3 + hstep, voffB); PG8_STAGE(PG8_SA(1, 0), a3, s0);
            PG8_WAIT_V(8); PG8_WAIT_L(0); PG8_BAR; PG8_MMA(1, 0, At, B0); PG8_MMA(1, 1, At, B1); PG8_BAR; PG8_SCHED;
        }
        if (wr == 0) PG8_BAR;
        if constexpr (FP8) asm volatile("s_nop 15\n\ts_nop 15" ::: "memory");
        { int fr_ = fr, fq_ = fq; asm volatile("" : "+v"(fr_), "+v"(fq_) : "s"(ui));
          E(acc, cur, wr, wc, fr_, fq_); }
        if (!has_next) break;
        if (!(Epi::CARRY && (cur.aux & 1) == 0)) {
#pragma unroll
        for (int a = 0; a < 2; ++a)
#pragma unroll
            for (int b = 0; b < 2; ++b)
#pragma unroll
                for (int m = 0; m < 4; ++m)
#pragma unroll
                    for (int n = 0; n < 2; ++n) acc[a][b][m][n] = (f32x4){0.f, 0.f, 0.f, 0.f}; }
        cur = nxt; cA = nA; cB = nB; ++ui;
#pragma unroll
        for (int h = 0; h < 2; ++h)
#pragma unroll
            for (int i = 0; i < 2; ++i) vc[h][i] = vn[h][i];
        if (wr == 1) PG8_BAR;
    }
    PG8_WAIT_V(0);
    PG8_BAR;
#undef PG8_SA
#undef PG8_SB
#undef PG8_STAGE
#undef PG8_LDA
#undef PG8_LDB
#undef PG8_MMA
#undef PG8_WAIT_V
#undef PG8_WAIT_L
#undef PG8_BAR
#undef PG8_SCHED
}
}

constexpr float C2Q = 0.125f * 1.4426950408889634f;

struct EpiIn {
    static constexpr bool CARRY = false;
    bf16* zhy; bf16* q; bf16* k; bf16* v; bf16* gate; const float* bperm; const float* qgain; const float* kgain; const float* cs;
    __device__ __forceinline__ void operator()(const f32x4 (&acc)[2][2][4][2], const pg8::Unit& u, int wr, int wc, int fr, int fq) const {
        const int pn = u.pn; const int row0 = u.pm * 256 + wr * 64 + fr;
        f32x4 bv[2][2];
#pragma unroll
        for (int bj = 0; bj < 2; ++bj)
#pragma unroll
            for (int n = 0; n < 2; ++n) bv[bj][n] = *(const f32x4*)(bperm + pn * 256 + bj * 128 + wc * 32 + n * 16 + 4 * fq);
        if (pn < 6) {
            const int colt = pn * 256 + wc * 32 + 8 * fq;
#pragma unroll
            for (int ai = 0; ai < 2; ++ai)
#pragma unroll
                for (int m = 0; m < 4; ++m) { bf16* rowp = zhy + (size_t)(row0 + ai * 128 + m * 16) * HYIN + colt;
#pragma unroll
                    for (int bj = 0; bj < 2; ++bj) { const f32x4 v0 = acc[ai][bj][m][0] + bv[bj][0], v1 = acc[ai][bj][m][1] + bv[bj][1];
                        v4u w; w.x = pk2(v0[0], v0[1]); w.y = pk2(v0[2], v0[3]); w.z = pk2(v1[0], v1[1]); w.w = pk2(v1[2], v1[3]);
                        *(v4u*)(rowp + bj * 128) = w; } }
        } else if (pn < 9) {
            const bool isq = pn < 8; const bool isv = (!isq) && (wc >= 2);
            const float* gain = isq ? qgain : kgain;
            f32x4 gv[2][2];
#pragma unroll
            for (int bj = 0; bj < 2; ++bj)
#pragma unroll
                for (int n = 0; n < 2; ++n) gv[bj][n] = *(const f32x4*)(gain + bj * 32 + n * 16 + 4 * fq);
            bf16* obase; int pitch, hcol;
            if (isq) { obase = q; pitch = ATTW; hcol = ((pn - 6) * 4 + wc) * 64; }
            else if (!isv) { obase = k; pitch = KVW; hcol = wc * 64; }
            else { obase = v; pitch = KVW; hcol = (wc - 2) * 64; }
            const float osc = isq ? C2Q : 1.0f;
#pragma unroll
            for (int ai = 0; ai < 2; ++ai)
#pragma unroll
                for (int m = 0; m < 4; ++m) { const int row = row0 + ai * 128 + m * 16; const int t = row & (SEQ - 1);
                    f32x4 y[2][2]; float ss = 0.f;
#pragma unroll
                    for (int bj = 0; bj < 2; ++bj)
#pragma unroll
                        for (int n = 0; n < 2; ++n) { y[bj][n] = acc[ai][bj][m][n] + bv[bj][n]; ss += (y[bj][n][0] * y[bj][n][0] + y[bj][n][1] * y[bj][n][1]) + (y[bj][n][2] * y[bj][n][2] + y[bj][n][3] * y[bj][n][3]); }
                    bf16* orow = obase + (size_t)row * pitch + hcol + 4 * fq;
                    if (!isv) {
                        ss += __shfl_xor(ss, 16); ss += __shfl_xor(ss, 32);
                        const float rstd = 1.0f / sqrtf(ss * (1.0f / 64.0f) + EPSV);
#pragma unroll
                        for (int bj = 0; bj < 2; ++bj) { const int pos = bj == 0 ? (t >> 6) : (t & 63);
                            const f32x4 cc = *(const f32x4*)(cs + pos * 32 + 4 * fq), sn = *(const f32x4*)(cs + pos * 32 + 16 + 4 * fq);
                            const f32x4 u1 = y[bj][0] * rstd * gv[bj][0], u2 = y[bj][1] * rstd * gv[bj][1];
                            y[bj][0] = (u1 * cc - u2 * sn) * osc; y[bj][1] = (u1 * sn + u2 * cc) * osc; }
                    }
#pragma unroll
                    for (int bj = 0; bj < 2; ++bj)
#pragma unroll
                        for (int n = 0; n < 2; ++n) { v2u w; w.x = pk2(y[bj][n][0], y[bj][n][1]); w.y = pk2(y[bj][n][2], y[bj][n][3]); *(v2u*)(orow + bj * 32 + n * 16) = w; } }
        } else {
            const int colt = (pn - 9) * 256 + wc * 32 + 8 * fq;
#pragma unroll
            for (int ai = 0; ai < 2; ++ai)
#pragma unroll
                for (int m = 0; m < 4; ++m) { bf16* rowp = gate + (size_t)(row0 + ai * 128 + m * 16) * 2048 + colt;
#pragma unroll
                    for (int bj = 0; bj < 2; ++bj) { f32x4 v0 = acc[ai][bj][m][0] + bv[bj][0], v1 = acc[ai][bj][m][1] + bv[bj][1];
#pragma unroll
                        for (int e = 0; e < 4; ++e) { v0[e] = __builtin_amdgcn_rcpf(1.0f + __expf(-v0[e])); v1[e] = __builtin_amdgcn_rcpf(1.0f + __expf(-v1[e])); }
                        v4u w; w.x = pk2(v0[0], v0[1]); w.y = pk2(v0[2], v0[3]); w.z = pk2(v1[0], v1[1]); w.w = pk2(v1[2], v1[3]);
                        *(v4u*)(rowp + bj * 128) = w; } }
        }
    }
};

template <int MODE> struct EpiMerge {
    static constexpr bool CARRY = false;
    bf16* mbuf; const bf16* gate; int gcol0;
    __device__ __forceinline__ void operator()(const f32x4 (&acc)[2][2][4][2], const pg8::Unit& u, int wr, int wc, int fr, int fq) const {
        const int row0 = u.pm * 256 + wr * 64 + fr; const int col0 = u.pn * 256 + wc * 32 + 8 * fq;
#pragma unroll
        for (int ai = 0; ai < 2; ++ai) {
            v4u g[4][2], p[4][2];
#pragma unroll
            for (int m = 0; m < 4; ++m) { const size_t row = (size_t)(row0 + ai * 128 + m * 16);
#pragma unroll
                for (int bj = 0; bj < 2; ++bj) { g[m][bj] = *(const v4u*)(gate + row * 2048 + gcol0 + col0 + bj * 128); if (MODE == 1) p[m][bj] = *(const v4u*)(mbuf + row * DM + col0 + bj * 128); } }
#pragma unroll
            for (int m = 0; m < 4; ++m) { const size_t row = (size_t)(row0 + ai * 128 + m * 16);
#pragma unroll
                for (int bj = 0; bj < 2; ++bj) { const v4u gv = g[m][bj];
                    f32x4 v0 = acc[ai][bj][m][0], v1 = acc[ai][bj][m][1];
                    v0[0] *= bflo(gv.x); v0[1] *= bfhi(gv.x); v0[2] *= bflo(gv.y); v0[3] *= bfhi(gv.y); v1[0] *= bflo(gv.z); v1[1] *= bfhi(gv.z); v1[2] *= bflo(gv.w); v1[3] *= bfhi(gv.w);
                    if (MODE == 1) { const v4u pv = p[m][bj]; v0[0] += bflo(pv.x); v0[1] += bfhi(pv.x); v0[2] += bflo(pv.y); v0[3] += bfhi(pv.y); v1[0] += bflo(pv.z); v1[1] += bfhi(pv.z); v1[2] += bflo(pv.w); v1[3] += bfhi(pv.w); }
                    v4u w; w.x = pk2(v0[0], v0[1]); w.y = pk2(v0[2], v0[3]); w.z = pk2(v1[0], v1[1]); w.w = pk2(v1[2], v1[3]);
                    *(v4u*)(mbuf + row * DM + col0 + bj * 128) = w; } } }
    }
};


struct EpiMergeR {
    static constexpr bool CARRY = true;
    unsigned char* mbuf; const bf16* gate;
    __device__ __forceinline__ void operator()(f32x4 (&acc)[2][2][4][2], const pg8::Unit& u, int wr, int wc, int fr, int fq) const {
        const int row0 = u.pm * 256 + wr * 64 + fr; const int col0 = u.pn * 256 + wc * 32 + 8 * fq; const bool first = (u.aux & 1) == 0;
#pragma unroll
        for (int ai = 0; ai < 2; ++ai) {
            v4u ga[4][2], gh[4][2];
#pragma unroll
            for (int m = 0; m < 4; ++m) { const size_t row = (size_t)(row0 + ai * 128 + m * 16);
#pragma unroll
                for (int bj = 0; bj < 2; ++bj) { ga[m][bj] = __builtin_nontemporal_load((const v4u*)(gate + row * 2048 + 1024 + col0 + bj * 128)); if (first) gh[m][bj] = __builtin_nontemporal_load((const v4u*)(gate + row * 2048 + col0 + bj * 128)); } }
#pragma unroll
            for (int m = 0; m < 4; ++m) { const size_t row = (size_t)(row0 + ai * 128 + m * 16);
#pragma unroll
                for (int bj = 0; bj < 2; ++bj) { const v4u a = ga[m][bj];
                    float g8[8] = {bflo(a.x), bfhi(a.x), bflo(a.y), bfhi(a.y), bflo(a.z), bfhi(a.z), bflo(a.w), bfhi(a.w)};
                    if (first) { const v4u h = gh[m][bj]; const float h8[8] = {bflo(h.x), bfhi(h.x), bflo(h.y), bfhi(h.y), bflo(h.z), bfhi(h.z), bflo(h.w), bfhi(h.w)};
#pragma unroll
                        for (int e = 0; e < 4; ++e) { acc[ai][bj][m][0][e] *= h8[e] * __builtin_amdgcn_rcpf(fmaxf(g8[e], 1e-30f)); acc[ai][bj][m][1][e] *= h8[4 + e] * __builtin_amdgcn_rcpf(fmaxf(g8[4 + e], 1e-30f)); } }
                    else { const f32x4 v0 = acc[ai][bj][m][0], v1 = acc[ai][bj][m][1];
                        v2u w; w.x = pk4_fp8(sat8(v0[0] * g8[0] * 64.0f), sat8(v0[1] * g8[1] * 64.0f), sat8(v0[2] * g8[2] * 64.0f), sat8(v0[3] * g8[3] * 64.0f)); w.y = pk4_fp8(sat8(v1[0] * g8[4] * 64.0f), sat8(v1[1] * g8[5] * 64.0f), sat8(v1[2] * g8[6] * 64.0f), sat8(v1[3] * g8[7] * 64.0f));
                        *(v2u*)(mbuf + row * DM + col0 + bj * 128) = w; } } } }
    }
};
struct MergeOrder {
    pg8::StaticOrder S; const char* A2; const char* B2;
    __device__ __forceinline__ bool next(int i, pg8::Unit& u) const { if (!S.next(i >> 1, u)) return false; u.aux = i; if (i & 1) { u.A = A2 + (size_t)u.pm * 256 * ATTW; u.B = B2 + (size_t)u.pn * 256 * ATTW; } return true; }
    __device__ __forceinline__ void voff(const pg8::Unit& u, int tid, unsigned (&v)[2][2]) const { S.voff(u, tid, v); }
};

struct EpiOut {
    static constexpr bool CARRY = false;
    const float* x; float* out; const float* mod; float* rowsq;
    __device__ __forceinline__ void operator()(const f32x4 (&acc)[2][2][4][2], const pg8::Unit& u, int wr, int wc, int fr, int fq) const {
        const int row0 = u.pm * 256 + wr * 64 + fr; const int col0 = u.pn * 256 + wc * 32 + 4 * fq; const int b = row0 >> 13;
        f32x4 gt[2][2];
#pragma unroll
        for (int bj = 0; bj < 2; ++bj)
#pragma unroll
            for (int n = 0; n < 2; ++n) gt[bj][n] = *(const f32x4*)(mod + b * 6144 + 2048 + col0 + bj * 128 + n * 16);
#pragma unroll
        for (int ai = 0; ai < 2; ++ai)
#pragma unroll
            for (int mp = 0; mp < 4; mp += 2) { f32x4 xv[2][2][2];
#pragma unroll
                for (int mm = 0; mm < 2; ++mm) { const size_t row = (size_t)(row0 + ai * 128 + (mp + mm) * 16);
#pragma unroll
                    for (int bj = 0; bj < 2; ++bj)
#pragma unroll
                        for (int n = 0; n < 2; ++n) xv[mm][bj][n] = __builtin_nontemporal_load((const f32x4*)(x + row * DM + col0 + bj * 128 + n * 16)); }
#pragma unroll
                for (int mm = 0; mm < 2; ++mm) { const int m = mp + mm; const size_t row = (size_t)(row0 + ai * 128 + m * 16); float ss = 0.f;
#pragma unroll
                    for (int bj = 0; bj < 2; ++bj)
#pragma unroll
                        for (int n = 0; n < 2; ++n) { const size_t off = row * DM + col0 + bj * 128 + n * 16;
                            const f32x4 o = xv[mm][bj][n] + gt[bj][n] * acc[ai][bj][m][n]; ss += (o[0] * o[0] + o[1] * o[1]) + (o[2] * o[2] + o[3] * o[3]); *(f32x4*)(out + off) = o; }
                    ss += __shfl_xor(ss, 16); ss += __shfl_xor(ss, 32);
                    if (fq == 0) rowsq[row * 16 + u.pn * 4 + wc] = ss; } }
    }
};

struct EpiSwiglu {
    static constexpr bool CARRY = false;
    unsigned char* act;
    __device__ __forceinline__ void operator()(const f32x4 (&acc)[2][2][4][2], const pg8::Unit& u, int wr, int wc, int fr, int fq) const {
        const int row0 = u.pm * 256 + wr * 64 + fr; const int col0 = u.pn * 128 + wc * 32 + 8 * fq;
#pragma unroll
        for (int ai = 0; ai < 2; ++ai)
#pragma unroll
            for (int m = 0; m < 4; ++m) { f32x4 a0 = acc[ai][0][m][0], a1 = acc[ai][0][m][1]; const f32x4 u0 = acc[ai][1][m][0], u1 = acc[ai][1][m][1];
#pragma unroll
                for (int e = 0; e < 4; ++e) { a0[e] = a0[e] * __builtin_amdgcn_rcpf(1.0f + __expf(-a0[e])) * u0[e]; a1[e] = a1[e] * __builtin_amdgcn_rcpf(1.0f + __expf(-a1[e])) * u1[e]; }
                v2u w; w.x = pk4_fp8(a0[0], a0[1], a0[2], a0[3]); w.y = pk4_fp8(a1[0], a1[1], a1[2], a1[3]);
                *(v2u*)(act + (size_t)(row0 + ai * 128 + m * 16) * DFF + col0) = w; }
    }
};

struct EpiDown {
    static constexpr bool CARRY = false;
    bf16* ye; const float* topw;
    __device__ __forceinline__ void operator()(const f32x4 (&acc)[2][2][4][2], const pg8::Unit& u, int wr, int wc, int fr, int fq) const {
        const int row0 = u.pm * 256 + wr * 64 + fr; const int col0 = u.pn * 256 + wc * 32 + 8 * fq;
        float tw[2][4];
#pragma unroll
        for (int ai = 0; ai < 2; ++ai)
#pragma unroll
            for (int m = 0; m < 4; ++m) tw[ai][m] = topw[row0 + ai * 128 + m * 16];
#pragma unroll
        for (int ai = 0; ai < 2; ++ai)
#pragma unroll
            for (int m = 0; m < 4; ++m) { const int row = row0 + ai * 128 + m * 16; const float w8 = tw[ai][m];
#pragma unroll
                for (int bj = 0; bj < 2; ++bj) { const f32x4 v0 = acc[ai][bj][m][0] * w8, v1 = acc[ai][bj][m][1] * w8;
                    v4u w; w.x = pk2(v0[0], v0[1]); w.y = pk2(v0[2], v0[3]); w.z = pk2(v1[0], v1[1]); w.w = pk2(v1[2], v1[3]);
                    *(v4u*)(ye + (size_t)row * DM + col0 + bj * 128) = w; } }
    }
};

struct MoeUpOrder {
    int G, c; const char* h2; const char* wgu; const LAS int* idx;
    __device__ __forceinline__ bool decode(long L, int& e, int& b, int& mblk, int& pn) const {
        if (L >= 4096) return false; e = (int)(L >> 8); const int w = (int)(L & 255), x = w & 7, j = w >> 3; pn = 2 * x + (j & 1); const int m16 = j >> 1; b = m16 >> 2; mblk = m16 & 3; return true; }
    __device__ __forceinline__ bool next(int i, pg8::Unit& u) const {
        int e, b, mblk, pn; if (!decode((long)i * G + c, e, b, mblk, pn)) return false;
        u.pm = (b * NEXP + e) * 4 + mblk; u.pn = pn; u.aux = i; u.A = h2 + (size_t)b * SEQ * DM; u.B = wgu + (size_t)(e * 16 + pn) * 256 * DM; return true; }
    __device__ __forceinline__ void voff(const pg8::Unit& u, int tid, unsigned (&v)[2][2]) const {
#pragma unroll
        for (int i = 0; i < 2; ++i) { int R, C; pg8::stage_rc(tid * 16 + i * 8192, R, C);
#pragma unroll
            for (int h = 0; h < 2; ++h) { const int tok = idx[(u.aux & 15) * 256 + h * 128 + R]; v[h][i] = (unsigned)(tok * (DM / 2) + C) * 2u; } }
    }
};
struct MoeDownOrder {
    int G, c; const char* act; const char* wd;
    __device__ __forceinline__ bool next(int i, pg8::Unit& u) const {
        const long L = (long)i * G + c; if (L >= 1024) return false;
        const int r = (int)(L >> 8), w = (int)(L & 255), x = w & 7, j = w >> 3; const int e = 4 * r + (x >> 1), pn = 2 * (x & 1) + (j & 1), m16 = j >> 1, b = m16 >> 2, mblk = m16 & 3;
        u.pm = (b * NEXP + e) * 4 + mblk; u.pn = pn; u.aux = i; u.A = act + (size_t)u.pm * 256 * DFF; u.B = wd + (size_t)(e * 4 + pn) * 256 * DFF; return true; }
    __device__ __forceinline__ void voff(const pg8::Unit&, int tid, unsigned (&v)[2][2]) const {
#pragma unroll
        for (int i = 0; i < 2; ++i) { int R, C; pg8::stage_rc(tid * 16 + i * 8192, R, C);
#pragma unroll
            for (int h = 0; h < 2; ++h) v[h][i] = (unsigned)((h * 128 + R) * (DFF / 2) + C) * 2u; }
    }
};

namespace attn_body {
using bf16h = __hip_bfloat16;
using s16x4 = __attribute__((ext_vector_type(4))) short;
using f32x16 = __attribute__((ext_vector_type(16))) float;
using u32x4 = __attribute__((ext_vector_type(4))) unsigned;
constexpr int D = 64, QP = ATTW, KP = KVW;
constexpr int NW = 8, QBLK = 32, QB = QBLK * NW, KVBLK = 64;
__device__ __forceinline__ int crow(int r, int hi) { return (r & 3) + 8 * (r >> 2) + 4 * hi; }
#define SBAR() __builtin_amdgcn_sched_barrier(0)
constexpr int NSLOT = 3, SLOTB = 8192;
constexpr int LDS_K = 0, LDS_V = NSLOT * SLOTB, LDS_WS = 2 * NSLOT * SLOTB, LDS_OST = LDS_WS + NW * 64 * 4, LDS_ATT_BYTES = LDS_OST + NW * 4096;
__device__ __forceinline__ void glds16(const void* gsrc, unsigned lds_dst) { unsigned keep;
  asm volatile("s_mov_b32 %0, m0\n\ts_mov_b32 m0, %2\n\ts_nop 0\n\tglobal_load_lds_dwordx4 %1, off\n\ts_mov_b32 m0, %0" : "=&s"(keep) : "v"(gsrc), "s"(lds_dst) : "memory"); }
__device__ __forceinline__ float max3f(float a, float b, float c) { float r; asm("v_max3_f32 %0, %1, %2, %3" : "=v"(r) : "v"(a), "v"(b), "v"(c)); return r; }
__device__ __forceinline__ float max2f(float a, float b) { float r; asm("v_max_f32_e32 %0, %1, %2" : "=v"(r) : "v"(a), "v"(b)); return r; }
__device__ __forceinline__ float fadd_s(float a, float b) { float r; asm("v_add_f32_e32 %0, %1, %2" : "=v"(r) : "v"(a), "v"(b)); return r; }
__device__ __forceinline__ float fsub_s(float a, float b) { float r; asm("v_sub_f32_e32 %0, %1, %2" : "=v"(r) : "v"(a), "v"(b)); return r; }
typedef float f32x2_t __attribute__((ext_vector_type(2))); typedef __bf16 bf16x2_t __attribute__((ext_vector_type(2)));
__device__ __forceinline__ unsigned cvtpk_s(float lo, float hi) { f32x2_t v = {lo, hi}; bf16x2_t b = __builtin_convertvector(v, bf16x2_t); return __builtin_bit_cast(unsigned, b); }
#define WAIT_BAR(N) asm volatile("s_waitcnt vmcnt(" #N ") lgkmcnt(0)\n\ts_barrier" ::: "memory")
__device__ __forceinline__ void qkt(f32x16& p0, f32x16& p1, const char* Kslot, const bf16x8* qr, const f32x16& negm, int r32, int hi) {
  const char* kb = Kslot + hi * 1024 + r32 * 16;
  #pragma unroll
  for (int d0 = 0; d0 < 4; ++d0) {
    const bf16x8 b0 = *reinterpret_cast<const bf16x8*>(kb + d0 * 2048);
    const bf16x8 b1 = *reinterpret_cast<const bf16x8*>(kb + d0 * 2048 + 512);
    if (d0 == 0) { p0 = __builtin_amdgcn_mfma_f32_32x32x16_bf16(b0, qr[0], negm, 0, 0, 0); p1 = __builtin_amdgcn_mfma_f32_32x32x16_bf16(b1, qr[0], negm, 0, 0, 0); }
    else { p0 = __builtin_amdgcn_mfma_f32_32x32x16_bf16(b0, qr[d0], p0, 0, 0, 0); p1 = __builtin_amdgcn_mfma_f32_32x32x16_bf16(b1, qr[d0], p1, 0, 0, 0); } }
}
typedef __attribute__((address_space(3))) const char* lds_cptr;
typedef short v4i16_t __attribute__((ext_vector_type(4)));
__device__ __forceinline__ void kload8(bf16x8* kf, lds_cptr kp) {
  kf[0] = *(const __attribute__((address_space(3))) bf16x8*)(kp);        kf[1] = *(const __attribute__((address_space(3))) bf16x8*)(kp + 512);
  kf[2] = *(const __attribute__((address_space(3))) bf16x8*)(kp + 2048); kf[3] = *(const __attribute__((address_space(3))) bf16x8*)(kp + 2560);
  kf[4] = *(const __attribute__((address_space(3))) bf16x8*)(kp + 4096); kf[5] = *(const __attribute__((address_space(3))) bf16x8*)(kp + 4608);
  kf[6] = *(const __attribute__((address_space(3))) bf16x8*)(kp + 6144); kf[7] = *(const __attribute__((address_space(3))) bf16x8*)(kp + 6656);
}
__device__ __forceinline__ void kload2(bf16x8* kf, lds_cptr kp, int j) { kf[2 * j] = *(const __attribute__((address_space(3))) bf16x8*)(kp + j * 2048); kf[2 * j + 1] = *(const __attribute__((address_space(3))) bf16x8*)(kp + j * 2048 + 512); }
__device__ __forceinline__ s16x4 vtr(lds_cptr p) { return __builtin_bit_cast(s16x4, __builtin_amdgcn_ds_read_tr16_b64_v4i16((__attribute__((address_space(3))) v4i16_t*)p)); }
__device__ __forceinline__ float rowmax(const f32x16& p0, const f32x16& p1) {
  float a = max3f(p0[0], p0[1], p1[0]), b = max3f(p0[2], p0[3], p1[1]); a = max3f(a, p1[2], p1[3]);
  #pragma unroll
  for (int r = 4; r < 16; r += 4) { a = max3f(a, p0[r], p0[r + 1]); b = max3f(b, p0[r + 2], p0[r + 3]); a = max3f(a, p1[r], p1[r + 1]); b = max3f(b, p1[r + 2], p1[r + 3]); }
  const float m = max2f(a, b);
  auto rr = __builtin_amdgcn_permlane32_swap(__float_as_uint(m), __float_as_uint(m), false, false);
  return max2f(__uint_as_float(rr[0]), __uint_as_float(rr[1]));
}
__device__ __forceinline__ void pv(f32x16* o, int vb, bf16x8 pa0, bf16x8 pa1, bf16x8 pa2, bf16x8 pa3) {
  #pragma unroll
  for (int d0 = 0; d0 < 2; ++d0) { s16x4 lo[4], hi[4];
    #pragma unroll
    for (int ks = 0; ks < 4; ++ks) {
      asm volatile("ds_read_b64_tr_b16 %0,%1 offset:%c2" : "=&v"(lo[ks]) : "v"(vb), "i"(d0 * 4096 + ks * 1024) : "memory");
      asm volatile("ds_read_b64_tr_b16 %0,%1 offset:%c2" : "=&v"(hi[ks]) : "v"(vb), "i"(d0 * 4096 + ks * 1024 + 512) : "memory"); }
    asm volatile("s_waitcnt lgkmcnt(0)" ::: "memory"); SBAR();
    #define PK(k) (bf16x8){lo[k][0], lo[k][1], lo[k][2], lo[k][3], hi[k][0], hi[k][1], hi[k][2], hi[k][3]}
    o[d0] = __builtin_amdgcn_mfma_f32_32x32x16_bf16(pa0, PK(0), o[d0], 0, 0, 0);
    o[d0] = __builtin_amdgcn_mfma_f32_32x32x16_bf16(pa1, PK(1), o[d0], 0, 0, 0);
    o[d0] = __builtin_amdgcn_mfma_f32_32x32x16_bf16(pa2, PK(2), o[d0], 0, 0, 0);
    o[d0] = __builtin_amdgcn_mfma_f32_32x32x16_bf16(pa3, PK(3), o[d0], 0, 0, 0);
    #undef PK
  }
}
template <int THRL, bool NOMAX> __device__ __forceinline__ void attn_unit(int b, int h, int qb, const bf16h* Q, const bf16h* __restrict__ K, const bf16h* __restrict__ V, bf16h* O, char* shm, int tid) {
  asm volatile("" : "+v"(tid) :: "memory");
  const int lane = tid & 63, r32 = lane & 31, hi = lane >> 5; const int wid = __builtin_amdgcn_readfirstlane(tid >> 6);
  const long rowbase = (long)b * SEQ; const int q0 = qb * QB; const int kvh = h >> 2;
  const bf16h* Qw = Q + (rowbase + q0 + wid * QBLK) * QP + h * D;
  const bf16h* Kh = K + rowbase * KP + kvh * D, *Vh = V + rowbase * KP + kvh * D;
  const unsigned lds0 = (unsigned)(uintptr_t)shm;
  float* wsf = (float*)(shm + LDS_WS) + wid * 64;
  const bf16h* ksrc = Kh + (long)lane * KP + wid * 8;
  const bf16h* vsrc = Vh + (long)(16 * (wid & 3) + (lane >> 2)) * KP + (wid >> 2) * 32 + (lane & 3) * 8;
  const unsigned kdst = lds0 + LDS_K + wid * 1024, vdst = lds0 + LDS_V + wid * 1024;
  #define DMA_K(t, slot) glds16(ksrc + (long)(t) * KVBLK * KP, (unsigned)__builtin_amdgcn_readfirstlane(kdst + (slot)))
  #define DMA_V(t, slot) glds16(vsrc + (long)(t) * KVBLK * KP, (unsigned)__builtin_amdgcn_readfirstlane(vdst + (slot)))
  const int vb0 = (int)(lds0 + LDS_V) + ((lane >> 4) & 1) * 32 + (lane & 3) * 8 + (4 * hi + ((lane & 15) >> 2)) * 64;
  const char* Kbase = shm + LDS_K; bf16x8 kf[8];
  const lds_cptr shm3 = (lds_cptr)shm; const lds_cptr kp0 = shm3 + LDS_K + hi * 1024 + r32 * 16; const lds_cptr vp0 = shm3 + LDS_V + ((lane >> 4) & 1) * 32 + (lane & 3) * 8 + (4 * hi + ((lane & 15) >> 2)) * 64;
  constexpr int NT = SEQ / KVBLK;
  DMA_K(0, 0); DMA_V(0, 0); DMA_K(1, SLOTB);
  bf16x8 qr[4];
  #pragma unroll
  for (int d0 = 0; d0 < 4; ++d0) qr[d0] = *reinterpret_cast<const bf16x8*>(&Qw[(long)r32 * QP + d0 * 16 + hi * 8]);
  float mhat = 0.f, l_reg = 0.f; f32x16 o[2]; o[0] = f32x16{}; o[1] = f32x16{}; f32x16 negm = f32x16{}; asm volatile("" : "+v"(negm));
  bool resc = false;
  #define START(P0, P1) do { resc = false; if (!NOMAX) { const float rm = rowmax(P0, P1); \
      const float dl = rm; mhat = fadd_s(mhat, dl); \
      _Pragma("unroll") for (int r = 0; r < 16; ++r) { P0[r] = fsub_s(P0[r], dl); P1[r] = fsub_s(P1[r], dl); } \
      _Pragma("unroll") for (int r = 0; r < 16; ++r) negm[r] = -mhat; asm volatile("" : "+v"(negm)); } \
    _Pragma("unroll") for (int r = 0; r < 16; ++r) P0[r] = __builtin_amdgcn_exp2f(P0[r]); } while (0)
  #define RESC() do { if (resc) { asm volatile("s_waitcnt lgkmcnt(0)" ::: "memory"); \
      _Pragma("unroll") for (int d_ = 0; d_ < 2; ++d_) _Pragma("unroll") for (int r = 0; r < 16; ++r) o[d_][r] *= wsf[crow(r, hi)]; } } while (0)
  f32x16 pA0, pA1, pB0, pB1;
  int sl_prev = 0, sl_cur = 0, sl_next = SLOTB;
  #define ROT() do { sl_prev = sl_cur; sl_cur = sl_next; sl_next = (sl_next == (NSLOT - 1) * SLOTB) ? 0 : sl_next + SLOTB; } while (0)
  DMA_K(2, 2 * SLOTB);
  WAIT_BAR(3);
  qkt(pA0, pA1, Kbase, qr, negm, r32, hi); asm volatile("s_nop 15\n\ts_nop 7" : "+v"(pA0), "+v"(pA1));
  START(pA0, pA1);
  _Pragma("unroll") for (int r = 0; r < 16; ++r) pA1[r] = __builtin_amdgcn_exp2f(pA1[r]);
  WAIT_BAR(0);
  DMA_K(3, 0); DMA_V(1, SLOTB);
  ROT();
  kload8(kf, kp0 + sl_cur);
  WAIT_BAR(2);
  s16x4 vlo[8], vhi[8]; u32x4 pw0, pw1, pw2, pw3;
  #define PKW(P, B) cvtpk_s(P[B], P[B + 1])
  #define PAF(k) __builtin_bit_cast(bf16x8, pw##k)
  #define VFR(i) (bf16x8){vlo[i][0], vlo[i][1], vlo[i][2], vlo[i][3], vhi[i][0], vhi[i][1], vhi[i][2], vhi[i][3]}
  #define PIN(x) asm volatile("" : "+v"(x))
  #define MX3(a, b, c) __builtin_fmaxf(__builtin_fmaxf((a), (b)), (c))
  #define GAPA(MF, A0, A1, A2, A3, W0, W1, PW) do { MF; sacc += A0; sacc += A1; sacc += A2; sacc += A3; PIN(sacc); W0; W1; PIN(PW); SBAR(); } while (0)
  #define EX(v) __builtin_amdgcn_exp2f(v)
  #define GAPB(MF, X, B) do { MF; X[B] = EX(X[B]); X[B + 1] = EX(X[B + 1]); X[B + 2] = EX(X[B + 2]); X[B + 3] = EX(X[B + 3]); PIN(X); SBAR(); } while (0)
  #define VRD(i) do { vlo[i] = vtr(vp_ + (((i) >> 2) * 4096 + ((i) & 3) * 1024)); vhi[i] = vtr(vp_ + (((i) >> 2) * 4096 + ((i) & 3) * 1024 + 512)); } while (0)
  #define KRD(G, j) do { if (G) { kload2(kf, kp0 + sl_next, j); SBAR(); } } while (0)
  #define STEP(C0, C1, P0, P1, t, GK, GV, GL) do { SBAR(); \
    const lds_cptr vp_ = vp0 + sl_prev; \
    VRD(0); SBAR(); float sacc = (P0[0] + P0[1]); \
    GAPA(C0 = __builtin_amdgcn_mfma_f32_32x32x16_bf16(kf[0], qr[0], negm, 0, 0, 0), P0[2], P0[3], P0[4], P0[5],     pw0[0] = PKW(P0, 0), pw0[1] = PKW(P0, 2), pw0); \
    VRD(4); SBAR(); GAPA(C1 = __builtin_amdgcn_mfma_f32_32x32x16_bf16(kf[1], qr[0], negm, 0, 0, 0), P0[6], P0[7], P0[8], P0[9],     pw0[2] = PKW(P0, 4), pw0[3] = PKW(P0, 6), pw0); \
    VRD(1); SBAR(); GAPA(C0 = __builtin_amdgcn_mfma_f32_32x32x16_bf16(kf[2], qr[1], C0, 0, 0, 0),   P0[10], P0[11], P0[12], P0[13], pw1[0] = PKW(P0, 8), pw1[1] = PKW(P0, 10), pw1); \
    VRD(5); SBAR(); GAPA(C1 = __builtin_amdgcn_mfma_f32_32x32x16_bf16(kf[3], qr[1], C1, 0, 0, 0),   P0[14], P0[15], P1[0], P1[1],   pw1[2] = PKW(P0, 12), pw1[3] = PKW(P0, 14), pw1); \
    VRD(2); SBAR(); GAPA(C0 = __builtin_amdgcn_mfma_f32_32x32x16_bf16(kf[4], qr[2], C0, 0, 0, 0),   P1[2], P1[3], P1[4], P1[5],     pw2[0] = PKW(P1, 0), pw2[1] = PKW(P1, 2), pw2); \
    VRD(6); SBAR(); GAPA(C1 = __builtin_amdgcn_mfma_f32_32x32x16_bf16(kf[5], qr[2], C1, 0, 0, 0),   P1[6], P1[7], P1[8], P1[9],     pw2[2] = PKW(P1, 4), pw2[3] = PKW(P1, 6), pw2); \
    VRD(3); SBAR(); GAPA(C0 = __builtin_amdgcn_mfma_f32_32x32x16_bf16(kf[6], qr[3], C0, 0, 0, 0),   P1[10], P1[11], P1[12], P1[13], pw3[0] = PKW(P1, 8), pw3[1] = PKW(P1, 10), pw3); \
    VRD(7); SBAR(); GAPA(C1 = __builtin_amdgcn_mfma_f32_32x32x16_bf16(kf[7], qr[3], C1, 0, 0, 0),   P1[14], P1[15], 0.f, 0.f,       pw3[2] = PKW(P1, 12), pw3[3] = PKW(P1, 14), pw3); \
    l_reg += sacc; \
    if (GK) { DMA_K((t) + 3, sl_cur); } if (GV) { DMA_V((t) + 1, sl_next); } \
    if (!NOMAX) { float a = MX3(C0[0], C0[1], C1[0]), b = MX3(C0[2], C0[3], C1[1]); a = MX3(a, C1[2], C1[3]); \
      _Pragma("unroll") for (int r = 4; r < 16; r += 4) { a = MX3(a, C0[r], C0[r + 1]); b = MX3(b, C0[r + 2], C0[r + 3]); a = MX3(a, C1[r], C1[r + 1]); b = MX3(b, C1[r + 2], C1[r + 3]); } \
      float rm = __builtin_fmaxf(a, b); { auto rr = __builtin_amdgcn_permlane32_swap(__float_as_uint(rm), __float_as_uint(rm), false, false); rm = __builtin_fmaxf(__uint_as_float(rr[0]), __uint_as_float(rr[1])); } \
      resc = false; \
      if (__builtin_expect(__any(rm > (float)THRL), 0)) { const float dl = __builtin_fmaxf(rm, 0.f); mhat += dl; \
        _Pragma("unroll") for (int r = 0; r < 16; ++r) { C0[r] -= dl; C1[r] -= dl; } \
        _Pragma("unroll") for (int r = 0; r < 16; ++r) negm[r] = -mhat; asm volatile("" : "+v"(negm)); \
        const float f = __builtin_amdgcn_exp2f(-dl); l_reg *= f; if (hi == 0) wsf[r32] = f; resc = true; } } \
    SBAR(); \
    GAPB(o[0] = __builtin_amdgcn_mfma_f32_32x32x16_bf16(PAF(0), VFR(0), o[0], 0, 0, 0), C0, 0); \
    GAPB(o[1] = __builtin_amdgcn_mfma_f32_32x32x16_bf16(PAF(0), VFR(4), o[1], 0, 0, 0), C0, 4); \
    KRD(GL, 0); GAPB(o[0] = __builtin_amdgcn_mfma_f32_32x32x16_bf16(PAF(1), VFR(1), o[0], 0, 0, 0), C0, 8); \
    KRD(GL, 1); GAPB(o[1] = __builtin_amdgcn_mfma_f32_32x32x16_bf16(PAF(1), VFR(5), o[1], 0, 0, 0), C0, 12); \
    KRD(GL, 2); GAPB(o[0] = __builtin_amdgcn_mfma_f32_32x32x16_bf16(PAF(2), VFR(2), o[0], 0, 0, 0), C1, 0); \
    KRD(GL, 3); GAPB(o[1] = __builtin_amdgcn_mfma_f32_32x32x16_bf16(PAF(2), VFR(6), o[1], 0, 0, 0), C1, 4); \
    GAPB(o[0] = __builtin_amdgcn_mfma_f32_32x32x16_bf16(PAF(3), VFR(3), o[0], 0, 0, 0), C1, 8); \
    GAPB(o[1] = __builtin_amdgcn_mfma_f32_32x32x16_bf16(PAF(3), VFR(7), o[1], 0, 0, 0), C1, 12); \
    } while (0)
  int t = 1;
  for (; t + 5 < NT; t += 2) {
    STEP(pB0, pB1, pA0, pA1, t, true, true, true);     WAIT_BAR(2); RESC(); ROT();
    STEP(pA0, pA1, pB0, pB1, t + 1, true, true, true); WAIT_BAR(2); RESC(); ROT();
  }
  #define ENDW(tt) do { if ((tt) + 3 < NT) { WAIT_BAR(2); } else if ((tt) + 2 < NT) { WAIT_BAR(1); } else { WAIT_BAR(0); } } while (0)
  for (; t + 1 < NT; t += 2) {
    STEP(pB0, pB1, pA0, pA1, t, (t + 3 < NT), (t + 1 < NT), (t + 1 < NT));         ENDW(t);     RESC(); ROT();
    STEP(pA0, pA1, pB0, pB1, t + 1, (t + 4 < NT), (t + 2 < NT), (t + 2 < NT));     ENDW(t + 1); RESC(); ROT();
  }
  STEP(pB0, pB1, pA0, pA1, NT - 1, false, false, false); RESC();
  { float sacc = pB0[0] + pB0[1]; _Pragma("unroll") for (int r = 2; r < 16; ++r) sacc += pB0[r]; _Pragma("unroll") for (int r = 0; r < 16; ++r) sacc += pB1[r]; l_reg += sacc;
    pw0 = (u32x4){PKW(pB0, 0), PKW(pB0, 2), PKW(pB0, 4), PKW(pB0, 6)}; pw1 = (u32x4){PKW(pB0, 8), PKW(pB0, 10), PKW(pB0, 12), PKW(pB0, 14)}; pw2 = (u32x4){PKW(pB1, 0), PKW(pB1, 2), PKW(pB1, 4), PKW(pB1, 6)}; pw3 = (u32x4){PKW(pB1, 8), PKW(pB1, 10), PKW(pB1, 12), PKW(pB1, 14)};
    SBAR(); pv(o, vb0 + sl_cur, PAF(0), PAF(1), PAF(2), PAF(3)); }
  #undef PKW
  #undef PAF
  #undef VFR
  #undef PIN
  #undef MX3
  #undef GAPA
  #undef GAPB
  #undef EX
  #undef VRD
  #undef KRD
  #undef STEP
  #undef ENDW
  { auto rr = __builtin_amdgcn_permlane32_swap(__float_as_uint(l_reg), __float_as_uint(l_reg), false, false); l_reg = __uint_as_float(rr[0]) + __uint_as_float(rr[1]); }
  if (hi == 0) wsf[32 + r32] = l_reg; asm volatile("s_waitcnt lgkmcnt(0)" ::: "memory");
  float rli[16];
  #pragma unroll
  for (int r = 0; r < 16; ++r) rli[r] = __builtin_amdgcn_rcpf(wsf[32 + crow(r, hi)]);
  unsigned char* Ow = (unsigned char*)O + (rowbase + q0 + wid * QBLK) * QP + h * D;
  { bf16h* stg = (bf16h*)(shm + LDS_OST) + wid * 2048;
    #pragma unroll
    for (int r = 0; r < 16; ++r) { const int orow = crow(r, hi);
      #pragma unroll
      for (int d0 = 0; d0 < 2; ++d0) stg[orow * 64 + d0 * 32 + r32] = __float2bfloat16(o[d0][r] * rli[r]); }
    asm volatile("s_waitcnt lgkmcnt(0)" ::: "memory");
    #pragma unroll
    for (int i = 0; i < 4; ++i) { const int row = i * 8 + (lane >> 3), ch = lane & 7; const u32x4 v = *(const u32x4*)(stg + row * 64 + ch * 8);
      v2u w8; w8.x = pk4_fp8(sat8(64.0f * bflo(v.x)), sat8(64.0f * bfhi(v.x)), sat8(64.0f * bflo(v.y)), sat8(64.0f * bfhi(v.y))); w8.y = pk4_fp8(sat8(64.0f * bflo(v.z)), sat8(64.0f * bfhi(v.z)), sat8(64.0f * bflo(v.w)), sat8(64.0f * bfhi(v.w)));
      *(v2u*)(Ow + (long)row * QP + ch * 8) = w8; } }
  asm volatile("s_waitcnt lgkmcnt(0)\n\ts_barrier" ::: "memory");
  #undef DMA_K
  #undef DMA_V
  #undef START
  #undef RESC
  #undef ROT
}
#undef SBAR
#undef WAIT_BAR
}

#define XB_TMO      128
#define XB_XCNT(j)  (256  + 64 * (j))
#define XB_XSUB(j)  (1280 + 64 * (j))
#define XB_XGEN(j)  (2304 + 64 * (j))
#define XB_TOP      3328
#define XB_TOPGEN   3392
#define XCD_BAR_WORDS 3456
#define XB_SPIN_CAP (1u << 18)
__device__ __forceinline__ unsigned xb_ld(unsigned* p)              { return __hip_atomic_load(p, __ATOMIC_RELAXED, __HIP_MEMORY_SCOPE_AGENT); }
__device__ __forceinline__ unsigned xb_add(unsigned* p, unsigned v) { return __hip_atomic_fetch_add(p, v, __ATOMIC_RELAXED, __HIP_MEMORY_SCOPE_AGENT); }
__device__ __forceinline__ unsigned xb_xcc_id() { return (unsigned)__builtin_amdgcn_s_getreg((3 << 11) | 20) & 0xFu; }
#define XB_SPIN(cond, bar) do { unsigned _sp = 0; while (cond) { __builtin_amdgcn_s_sleep(1); \
    if ((++_sp & 255u) == 0u) { if (xb_ld(&(bar)[XB_TMO])) break; if (_sp > XB_SPIN_CAP) { atomicAdd(&(bar)[XB_TMO], 1u); break; } } } } while (0)
struct XcdBarrier { unsigned* bar; unsigned x; volatile LAS unsigned* st; int wid; };
__device__ __forceinline__ XcdBarrier xcd_barrier_post(unsigned* bar, volatile LAS unsigned* st, int wid) {
    XcdBarrier b; b.bar = bar; b.x = xb_xcc_id(); b.st = st; b.wid = wid;
    if (my_tid(wid) == 0) (void)xb_add(&bar[XB_XCNT(b.x)], 1u);
    return b;
}
__device__ __forceinline__ void xcd_barrier_complete(unsigned* bar, unsigned x, unsigned& nloc, unsigned& nx) {
    const unsigned G = gridDim.x * gridDim.y * gridDim.z;
    unsigned sum, cnt, mine, sp = 0u;
    for (;;) {
        sum = 0u; cnt = 0u; mine = 0u;
#pragma unroll
        for (unsigned j = 0; j < 16; ++j) { const unsigned c = xb_ld(&bar[XB_XCNT(j)]); sum += c; cnt += (c > 0u) ? 1u : 0u; mine = (j == x) ? c : mine; }
        if (sum == G) break;
        __builtin_amdgcn_s_sleep(1);
        if ((++sp & 255u) == 0u) { if (xb_ld(&bar[XB_TMO])) break; if (sp > XB_SPIN_CAP) { atomicAdd(&bar[XB_TMO], 1u); break; } }
    }
    nloc = mine > 0u ? mine : 1u; nx = cnt > 0u ? cnt : 1u;
}
__device__ __forceinline__ void xcd_barrier(const XcdBarrier& b) {
    asm volatile("s_waitcnt vmcnt(0)" ::: "memory");
    __syncthreads();
    if (my_tid(b.wid) == 0) {
        unsigned* bar = b.bar;
        __builtin_amdgcn_s_waitcnt(0);
        unsigned nloc = b.st[0], nx = b.st[1];
        if (nloc == 0u) { xcd_barrier_complete(bar, b.x, nloc, nx); b.st[0] = nloc; b.st[1] = nx; }
        const unsigned old = xb_add(&bar[XB_XSUB(b.x)], 1u);
        const unsigned gen = old / nloc;
        if (old + 1u == (gen + 1u) * nloc) {
            __builtin_amdgcn_fence(__ATOMIC_RELEASE, "agent");
            asm volatile("s_waitcnt vmcnt(0)" ::: "memory");
            const unsigned og = xb_add(&bar[XB_TOP], 1u);
            const unsigned tg = og / nx;
            if (og + 1u == (tg + 1u) * nx) xb_add(&bar[XB_TOPGEN], 1u);
            else XB_SPIN(xb_ld(&bar[XB_TOPGEN]) == tg, bar);
            __builtin_amdgcn_fence(__ATOMIC_ACQUIRE, "agent");
            xb_add(&bar[XB_XGEN(b.x)], 1u);
            asm volatile("s_waitcnt vmcnt(0)" ::: "memory");
        } else {
            XB_SPIN(xb_ld(&bar[XB_XGEN(b.x)]) == gen, bar);
            __builtin_amdgcn_fence(__ATOMIC_ACQUIRE, "agent");
            asm volatile("s_waitcnt vmcnt(0)" ::: "memory");
        }
    }
    __syncthreads();
}


constexpr int CW_SPLIT = 20000;
__device__ __forceinline__ void split_arrive(unsigned* cnt, int wid) {
    asm volatile("s_waitcnt vmcnt(0)" ::: "memory");
    __syncthreads();
    if (my_tid(wid) == 0) { __builtin_amdgcn_fence(__ATOMIC_RELEASE, "agent"); asm volatile("s_waitcnt vmcnt(0)" ::: "memory"); (void)xb_add(cnt, 1u); }
}
__device__ __forceinline__ void split_wait(unsigned* cnt, unsigned want, unsigned* tmo, int wid) {
    if (my_tid(wid) == 0) { unsigned sp = 0u;
        while (xb_ld(cnt) < want) { __builtin_amdgcn_s_sleep(1); if ((++sp & 255u) == 0u) { if (xb_ld(tmo)) break; if (sp > XB_SPIN_CAP) { atomicAdd(tmo, 1u); break; } } }
        __builtin_amdgcn_fence(__ATOMIC_ACQUIRE, "agent"); asm volatile("s_waitcnt vmcnt(0)" ::: "memory"); }
    __syncthreads();
}

typedef float cf __attribute__((ext_vector_type(2)));
__device__ __forceinline__ cf p_add(cf a, cf b) { cf r; asm("v_pk_add_f32 %0, %1, %2" : "=v"(r) : "v"(a), "v"(b)); return r; }
__device__ __forceinline__ cf p_sub(cf a, cf b) { cf r; asm("v_pk_add_f32 %0, %1, %2 neg_lo:[0,1] neg_hi:[0,1]" : "=v"(r) : "v"(a), "v"(b)); return r; }
__device__ __forceinline__ cf p_addmi(cf a, cf b) { cf r; asm("v_pk_add_f32 %0, %1, %2 op_sel:[0,1] op_sel_hi:[1,0] neg_hi:[0,1]" : "=v"(r) : "v"(a), "v"(b)); return r; }
__device__ __forceinline__ cf p_addpi(cf a, cf b) { cf r; asm("v_pk_add_f32 %0, %1, %2 op_sel:[0,1] op_sel_hi:[1,0] neg_lo:[0,1]" : "=v"(r) : "v"(a), "v"(b)); return r; }
__device__ __forceinline__ float s_add(float a, float b) { float r; asm("v_add_f32_e32 %0, %1, %2" : "=v"(r) : "v"(a), "v"(b)); return r; }
__device__ __forceinline__ float s_sub(float a, float b) { float r; asm("v_sub_f32_e32 %0, %1, %2" : "=v"(r) : "v"(a), "v"(b)); return r; }
__device__ __forceinline__ float s_mul(float a, float b) { float r; asm("v_mul_f32_e32 %0, %1, %2" : "=v"(r) : "v"(a), "v"(b)); return r; }
__device__ __forceinline__ float s_fma(float a, float b, float c) { float r; asm("v_fma_f32 %0, %1, %2, %3" : "=v"(r) : "v"(a), "v"(b), "v"(c)); return r; }
__device__ __forceinline__ float s_fnma(float a, float b, float c) { float r; asm("v_fma_f32 %0, -%1, %2, %3" : "=v"(r) : "v"(a), "v"(b), "v"(c)); return r; }
__device__ __forceinline__ cf cmul(cf a, cf b) { cf t, r; asm("v_pk_mul_f32 %0, %1, %2 op_sel:[0,0] op_sel_hi:[0,1]" : "=v"(t) : "v"(a), "v"(b));
    asm("v_pk_fma_f32 %0, %1, %2, %3 op_sel:[1,1,0] op_sel_hi:[1,0,1] neg_lo:[1,0,0]" : "=v"(r) : "v"(a), "v"(b), "v"(t)); return r; }
__device__ __forceinline__ cf cmulk(cf a, cf k) { cf t, r; asm("v_pk_mul_f32 %0, %1, %2 op_sel:[0,0] op_sel_hi:[0,1]" : "=v"(t) : "v"(a), "s"(k));
    asm("v_pk_fma_f32 %0, %1, %2, %3 op_sel:[1,1,0] op_sel_hi:[1,0,1] neg_lo:[1,0,0]" : "=v"(r) : "v"(a), "s"(k), "v"(t)); return r; }
__device__ __forceinline__ cf cmulc(cf a, cf b) { cf t, r; asm("v_pk_mul_f32 %0, %1, %2 op_sel:[0,0] op_sel_hi:[0,1]" : "=v"(t) : "v"(a), "v"(b));
    asm("v_pk_fma_f32 %0, %1, %2, %3 op_sel:[1,1,0] op_sel_hi:[1,0,1] neg_hi:[1,0,0]" : "=v"(r) : "v"(a), "v"(b), "v"(t)); return r; }
__device__ __forceinline__ cf cmulj(cf a, cf b) { cf t, r; asm("v_pk_mul_f32 %0, %1, %2 op_sel:[0,0] op_sel_hi:[0,1] neg_hi:[1,0]" : "=v"(t) : "v"(a), "v"(b));
    asm("v_pk_fma_f32 %0, %1, %2, %3 op_sel:[1,1,0] op_sel_hi:[1,0,1] neg_lo:[1,0,0] neg_hi:[1,0,0]" : "=v"(r) : "v"(a), "v"(b), "v"(t)); return r; }
#define FIDX(i) ((i) + ((i) >> 4) + (((i) >> 9) << 4))
constexpr int FFT_LDS_BYTES = 143360;
__device__ __forceinline__ void dft4(cf& a, cf& b, cf& c, cf& d) {
    const cf s0 = p_add(a, c), s1 = p_sub(a, c), s2 = p_add(b, d), s3 = p_sub(b, d);
    a = p_add(s0, s2); c = p_sub(s0, s2);
    b = p_addmi(s1, s3); d = p_addpi(s1, s3);
}
__device__ __forceinline__ void dft16(cf (&x)[16]) {
#pragma unroll
    for (int m2 = 0; m2 < 4; ++m2) dft4(x[m2], x[4 + m2], x[8 + m2], x[12 + m2]);
    const cf W1{0.92387953251f, -0.38268343236f}, W2{0.70710678118f, -0.70710678118f}, W3{0.38268343236f, -0.92387953251f}, W6{-0.70710678118f, -0.70710678118f}, W9{-0.92387953251f, 0.38268343236f};
    x[5] = cmulk(x[5], W1); x[6] = cmulk(x[6], W2); x[7] = cmulk(x[7], W3);
    x[9] = cmulk(x[9], W2); x[10] = cf{x[10].y, -x[10].x}; x[11] = cmulk(x[11], W6);
    x[13] = cmulk(x[13], W3); x[14] = cmulk(x[14], W6); x[15] = cmulk(x[15], W9);
#pragma unroll
    for (int q1 = 0; q1 < 4; ++q1) dft4(x[4 * q1], x[4 * q1 + 1], x[4 * q1 + 2], x[4 * q1 + 3]);
}
#define QREG(q) (4 * ((q) & 3) + ((q) >> 2))
template <int OFF> __device__ __forceinline__ void dft16_at(cf (&x)[32]) {
#pragma unroll
    for (int m2 = 0; m2 < 4; ++m2) dft4(x[OFF + m2], x[OFF + 4 + m2], x[OFF + 8 + m2], x[OFF + 12 + m2]);
    const cf W1{0.92387953251f, -0.38268343236f}, W2{0.70710678118f, -0.70710678118f}, W3{0.38268343236f, -0.92387953251f}, W6{-0.70710678118f, -0.70710678118f}, W9{-0.92387953251f, 0.38268343236f};
    x[OFF + 5] = cmulk(x[OFF + 5], W1); x[OFF + 6] = cmulk(x[OFF + 6], W2); x[OFF + 7] = cmulk(x[OFF + 7], W3);
    x[OFF + 9] = cmulk(x[OFF + 9], W2); x[OFF + 10] = cf{x[OFF + 10].y, -x[OFF + 10].x}; x[OFF + 11] = cmulk(x[OFF + 11], W6);
    x[OFF + 13] = cmulk(x[OFF + 13], W3); x[OFF + 14] = cmulk(x[OFF + 14], W6); x[OFF + 15] = cmulk(x[OFF + 15], W9);
#pragma unroll
    for (int q1 = 0; q1 < 4; ++q1) dft4(x[OFF + 4 * q1], x[OFF + 4 * q1 + 1], x[OFF + 4 * q1 + 2], x[OFF + 4 * q1 + 3]);
}
#define X32I(k) ((((k) & 1) << 4) + QREG((k) >> 1))
template <bool HI_ZERO> __device__ __forceinline__ void dft32(cf (&x)[32]) {
    constexpr float C32[16] = {1.0f, 0.98078528040f, 0.92387953251f, 0.83146961230f, 0.70710678118f, 0.55557023302f, 0.38268343236f, 0.19509032201f, 0.0f, -0.19509032201f, -0.38268343236f, -0.55557023302f, -0.70710678118f, -0.83146961230f, -0.92387953251f, -0.98078528040f};
    constexpr float S32[16] = {0.0f, 0.19509032201f, 0.38268343236f, 0.55557023302f, 0.70710678118f, 0.83146961230f, 0.92387953251f, 0.98078528040f, 1.0f, 0.98078528040f, 0.92387953251f, 0.83146961230f, 0.70710678118f, 0.55557023302f, 0.38268343236f, 0.19509032201f};
#pragma unroll
    for (int n = 0; n < 16; ++n) { cf a, b;
        if (HI_ZERO) { a = x[n]; b = x[n]; } else { a = p_add(x[n], x[16 + n]); b = p_sub(x[n], x[16 + n]); }
        x[n] = a; x[16 + n] = (n == 0) ? b : cmulk(b, cf{C32[n], -S32[n]}); }
    dft16_at<0>(x); dft16_at<16>(x);
}
__device__ __forceinline__ cf twid(int j, int lognb) { const float fr = (float)j * (1.0f / (float)(1 << lognb)); float wx = __builtin_amdgcn_cosf(fr), wy = -__builtin_amdgcn_sinf(fr);
    asm volatile("s_nop 3" : "+v"(wx), "+v"(wy));
    return cf{wx, wy}; }
__device__ __forceinline__ void twiddle32_fwd(cf (&x)[32], cf w) {
    const cf w2 = cmul(w, w); cf p = w2;
    x[X32I(1)] = cmul(x[X32I(1)], w);
#pragma unroll
    for (int k2 = 1; k2 < 16; ++k2) { x[X32I(2 * k2)] = cmul(x[X32I(2 * k2)], p); const cf po = cmul(p, w); x[X32I(2 * k2 + 1)] = cmul(x[X32I(2 * k2 + 1)], po); if (k2 < 15) p = cmul(p, w2); }
}
__device__ __forceinline__ void twiddle32_inv(cf (&x)[32], cf w) {
    const cf w2 = cmul(w, w); cf p = w2;
    x[0].y = -x[0].y; x[1] = cmulc(x[1], w);
#pragma unroll
    for (int k2 = 1; k2 < 16; ++k2) { x[2 * k2] = cmulc(x[2 * k2], p); const cf po = cmul(p, w); x[2 * k2 + 1] = cmulc(x[2 * k2 + 1], po); if (k2 < 15) p = cmul(p, w2); }
}
__device__ __forceinline__ void ldsA_storeX(LAS f32x2* X, int j, const cf (&x)[32]) {
    LAS f32x2* Xb = X + j + (j >> 4);
#pragma unroll
    for (int q = 0; q < 32; ++q) Xb[560 * q] = (f32x2){x[X32I(q)].x, x[X32I(q)].y};
}
__device__ __forceinline__ void ldsA_load(LAS f32x2* X, int j, cf (&x)[32]) {
    const LAS f32x2* Xb = X + j + (j >> 4);
#pragma unroll
    for (int q = 0; q < 32; ++q) { const f32x2 v = Xb[560 * q]; x[q] = cf{v.x, v.y}; }
}
__device__ __forceinline__ void fft_fwdA(LAS f32x2* X, int tid, int salt) {
    asm volatile("" : "+v"(tid) : "s"(salt) : "memory");
    cf x[32]; ldsA_load(X, tid, x); dft32<false>(x); twiddle32_fwd(x, twid(tid, 14)); ldsA_storeX(X, tid, x);
}
__device__ __forceinline__ void fft_fwdB(LAS f32x2* X, int tid, int salt) {
    asm volatile("" : "+v"(tid) : "s"(salt) : "memory");
    const int j = tid & 15; LAS f32x2* Xb = X + 560 * (tid >> 4) + j; cf x[32];
#pragma unroll
    for (int m = 0; m < 32; ++m) { const f32x2 v = Xb[17 * m]; x[m] = cf{v.x, v.y}; }
    dft32<false>(x); twiddle32_fwd(x, twid(j, 9));
#pragma unroll
    for (int q = 0; q < 32; ++q) Xb[17 * q] = (f32x2){x[X32I(q)].x, x[X32I(q)].y};
}
__device__ __forceinline__ void fft_invB(LAS f32x2* X, int tid, int salt) {
    asm volatile("" : "+v"(tid) : "s"(salt) : "memory");
    const int j = tid & 15; LAS f32x2* Xb = X + 560 * (tid >> 4) + j; cf x[32];
#pragma unroll
    for (int q = 0; q < 32; ++q) { const f32x2 v = Xb[17 * q]; x[q] = cf{v.x, v.y}; }
    twiddle32_inv(x, twid(j, 9)); dft32<false>(x);
#pragma unroll
    for (int m = 0; m < 32; ++m) Xb[17 * m] = (f32x2){x[X32I(m)].x, -x[X32I(m)].y};
}
__device__ __forceinline__ void load_spec(f32x4 (&h)[8], const float* H, int tid, int salt) {
    asm volatile("" : "+v"(tid) : "s"(salt) : "memory");
#pragma unroll
    for (int i = 0; i < 8; ++i) h[i] = *(const f32x4*)(H + 32 * tid + 4 * i);
}
__device__ __forceinline__ void fft_mid(LAS f32x2* X, const f32x4 (&h0)[8], const float* H, int tid, int salt) {
    asm volatile("" : "+v"(tid) : "s"(salt) : "memory");
    f32x4 h1[8];
#pragma unroll
    for (int i = 0; i < 8; ++i) h1[i] = *(const f32x4*)(H + 32 * (tid + 512) + 4 * i);
#pragma unroll
    for (int k = 0; k < 2; ++k) { const int u = tid + 512 * k; const int p = FIDX(16 * u); cf x[16];
#pragma unroll
        for (int m = 0; m < 16; ++m) { const f32x2 v = X[p + m]; x[m] = cf{v.x, v.y}; }
        dft16(x);
        cf y[16];
#pragma unroll
        for (int q = 0; q < 16; ++q) { const f32x4 hv = k == 0 ? h0[q >> 1] : h1[q >> 1]; const cf hq = (q & 1) ? cf{hv[2], hv[3]} : cf{hv[0], hv[1]}; y[q] = cmulj(x[QREG(q)], hq); }
        dft16(y);
#pragma unroll
        for (int m = 0; m < 16; ++m) X[p + m] = (f32x2){y[QREG(m)].x, -y[QREG(m)].y}; }
}
__device__ __forceinline__ void fft_last_store(LAS f32x2* X, float* H, int tid, int salt) {
    asm volatile("" : "+v"(tid) : "s"(salt) : "memory");
    const float sc = 1.0f / 16384.0f;
#pragma unroll 1
    for (int k = 0; k < 2; ++k) { const int u = tid + 512 * k; const int p = FIDX(16 * u); cf x[16];
#pragma unroll
        for (int m = 0; m < 16; ++m) { const f32x2 v = X[p + m]; x[m] = cf{v.x, v.y}; }
        dft16(x);
#pragma unroll
        for (int i = 0; i < 8; ++i) *(f32x4*)(H + 32 * u + 4 * i) = (f32x4){x[QREG(2 * i)].x * sc, x[QREG(2 * i)].y * sc, x[QREG(2 * i + 1)].x * sc, x[QREG(2 * i + 1)].y * sc}; }
}

__device__ __forceinline__ void fft_last_store_pair(LAS f32x2* X, float* HA, float* HB, int tid, int salt) {
    asm volatile("" : "+v"(tid) : "s"(salt) : "memory");
#pragma unroll 1
    for (int k = 0; k < 2; ++k) { const int u = tid + 512 * k; const int p = FIDX(16 * u); cf x[16];
#pragma unroll
        for (int m = 0; m < 16; ++m) { const f32x2 v = X[p + m]; x[m] = cf{v.x, v.y}; }
        dft16(x);
#pragma unroll
        for (int q = 0; q < 16; ++q) X[p + q] = (f32x2){x[QREG(q)].x, x[QREG(q)].y}; }
    __syncthreads();
    const float sc = 0.5f / 16384.0f;
#pragma unroll 1
    for (int k = 0; k < 2; ++k) { const int u = tid + 512 * k; const int p = FIDX(16 * u);
        const int kA = u >> 5, kB = u & 31; const int kA2 = (32 - kA) & 31, bo1 = kA > 0 ? 1 : 0; const int kB2 = (32 - kB - bo1) & 31, bo2 = (kB + bo1) > 0 ? 1 : 0;
        const int p2 = FIDX(16 * (32 * kA2 + kB2));
        f32x2 z[16], zp[16];
#pragma unroll
        for (int q = 0; q < 16; ++q) { z[q] = X[p + q]; zp[q] = X[p2 + ((16 - q - bo2) & 15)]; }
#pragma unroll
        for (int i = 0; i < 8; ++i) { const f32x2 z0 = z[2 * i], z1 = z[2 * i + 1], c0 = zp[2 * i], c1 = zp[2 * i + 1];
            *(f32x4*)(HA + 32 * u + 4 * i) = (f32x4){(z0.x + c0.x) * sc, (z0.y - c0.y) * sc, (z1.x + c1.x) * sc, (z1.y - c1.y) * sc};
            *(f32x4*)(HB + 32 * u + 4 * i) = (f32x4){(z0.y + c0.y) * sc, (c0.x - z0.x) * sc, (z1.y + c1.y) * sc, (c1.x - z1.x) * sc}; } }
}

__device__ __forceinline__ void block_sum2(float& a, float& b, LAS float* red, int tid) {
    a = wave_sum(a); b = wave_sum(b);
    __syncthreads();
    if ((tid & 63) == 0) { red[(tid >> 6) * 2] = a; red[(tid >> 6) * 2 + 1] = b; }
    __syncthreads();
    float sa = 0.f, sb = 0.f;
#pragma unroll
    for (int w = 0; w < 8; ++w) { sa += red[2 * w]; sb += red[2 * w + 1]; }
    a = sa; b = sb;
}

struct HfRaw { float f[16], b[16], f2[16], b2[16]; };
__device__ __forceinline__ void hfft_load(HfRaw& r, const float* hraw, int c, int tid, int salt) {
    asm volatile("" : "+v"(tid) : "s"(salt) : "memory");
    const float* hf = hraw + (size_t)(0 * HYW + c) * SEQ; const float* hb = hraw + (size_t)(1 * HYW + c) * SEQ; const float* hf2 = hraw + (size_t)(2 * HYW + c) * SEQ; const float* hb2 = hraw + (size_t)(3 * HYW + c) * SEQ;
#pragma unroll
    for (int m = 0; m < 16; ++m) { const int tb = 8192 - tid - 512 * m, tbc = tb < SEQ ? tb : 0; r.f[m] = __builtin_nontemporal_load(hf + tid + 512 * m); r.b[m] = __builtin_nontemporal_load(hb + tbc); r.f2[m] = __builtin_nontemporal_load(hf2 + tid + 512 * m); r.b2[m] = __builtin_nontemporal_load(hb2 + tbc); }
}
__device__ __forceinline__ void hfft_run(HfRaw& r, const float* hraw, int cn, float* Hout, int c, LAS unsigned char* lds, int tid, int salt) {
    asm volatile("" : "+v"(tid) : "s"(salt) : "memory");
    LAS f32x2* X = (LAS f32x2*)lds; LAS float* red = (LAS float*)(lds + FFT_LDS_BYTES);
    const float mind = 4.605170185988091f / 1.5f, maxd = 4.605170185988091f / 0.3f;
    const float ad = mind + (float)c * ((maxd - mind) / 511.0f);
    cf vf[16], vb[16]; float sf = 0.f, sb = 0.f, sf2 = 0.f, sb2 = 0.f;
#pragma unroll
    for (int m = 0; m < 16; ++m) { const int t = tid + 512 * m, tb = 8192 - tid - 512 * m;
        const float df = __expf(-((float)t * (1.0f / 8191.0f)) * ad), db = (tb < SEQ) ? __expf(-((float)tb * (1.0f / 8191.0f)) * ad) : 0.f;
        vf[m] = cf{r.f[m] * df, r.f2[m] * df}; vb[m] = cf{r.b[m] * db, r.b2[m] * db}; sf += fabsf(vf[m].x); sf2 += fabsf(vf[m].y); sb += fabsf(vb[m].x); sb2 += fabsf(vb[m].y); }
    const float rb0 = r.b[0], rb02 = r.b2[0];
    if (tid == 0) { sb += fabsf(rb0); sb2 += fabsf(rb02); }
    block_sum2(sf, sb, red, tid); block_sum2(sf2, sb2, red, tid);
    const float nf = 1.0f / (sf + EPSV), nb = 1.0f / (sb + EPSV), nf2 = 1.0f / (sf2 + EPSV), nb2 = 1.0f / (sb2 + EPSV);
    cf x[32];
#pragma unroll
    for (int m = 0; m < 16; ++m) { x[m] = cf{vf[m].x * nf, vf[m].y * nf2}; x[16 + m] = cf{vb[m].x * nb, vb[m].y * nb2}; }
    if (tid == 0) { x[0].x += rb0 * nb; x[0].y += rb02 * nb2; }
    hfft_load(r, hraw, cn, tid, salt);
    asm volatile("" : "+v"(tid) : "s"(salt) : "memory");
    dft32<false>(x); twiddle32_fwd(x, twid(tid, 14)); ldsA_storeX(X, tid, x);
    __syncthreads();
    fft_fwdB(X, tid, salt); __syncthreads();
    fft_last_store_pair(X, Hout + (size_t)c * 32768, Hout + (size_t)(512 + c) * 32768, tid, salt);
    __syncthreads();
}

__device__ __forceinline__ void zc_tile(const Args& P, int tile, LAS unsigned char* lds, int tid) {
    const int salt = tile;
    asm volatile("" : "+v"(tid) : "s"(salt) : "memory");
    const int cb = tile % 24, jb = (tile / 24) & 31, p = tile / (24 * 32);
    const bf16* z = (const bf16*)(P.ws + WS_ZHY); bf16* zc = (bf16*)(P.ws + WS_ZC);
    v4u sv[9];
#pragma unroll
    for (int it = 0; it < 9; ++it) { const int row = it * 64 + (tid >> 3), ch8 = tid & 7; const int bt = row / 288, rr = row % 288, m = rr / 18, r = rr % 18;
        const int t = 512 * m + 16 * jb - 1 + r; const int tc = t < 0 ? 0 : (t >= SEQ ? SEQ - 1 : t);
        sv[it] = __builtin_nontemporal_load((const v4u*)(z + ((size_t)((2 * p + bt) * SEQ + tc)) * HYIN + 64 * cb + 8 * ch8)); }
#pragma unroll
    for (int it = 0; it < 9; ++it) { const int row = it * 64 + (tid >> 3), ch8 = tid & 7; const int rr = row % 288, m = rr / 18, r = rr % 18;
        const int t = 512 * m + 16 * jb - 1 + r; v4u v = sv[it]; if (t < 0 || t >= SEQ) v = (v4u){0u, 0u, 0u, 0u};
        LAS v2u* d = (LAS v2u*)(lds + row * 136 + ch8 * 16); d[0] = (v2u){v.x, v.y}; d[1] = (v2u){v.z, v.w}; }
    __syncthreads();
    const int lane = tid & 63, wave = tid >> 6; const int jl = lane & 15, bt = (lane >> 4) & 1, csub = lane >> 5;
    const float* sw = P.in[8]; const float* sb = P.in[9];
#pragma unroll 1
    for (int it = 0; it < 4; ++it) { const int cl = 2 * (wave + 8 * it) + csub; const int ch = 64 * cb + cl; const int pos = cl;
        const float w0 = sw[ch], w1 = sw[HYIN + ch], w2 = sw[2 * HYIN + ch], bs = sb[ch];
        const LAS bf16* base = (const LAS bf16*)(lds + (bt * 288 + jl) * 136) + pos;
        unsigned o[8];
#pragma unroll
        for (int m = 0; m < 16; m += 2) { float r0, r1;
            { const LAS bf16* q = base + m * 18 * 68; r0 = bs + w0 * bf2f(q[0]) + w1 * bf2f(q[68]) + w2 * bf2f(q[136]); }
            { const LAS bf16* q = base + (m + 1) * 18 * 68; r1 = bs + w0 * bf2f(q[0]) + w1 * bf2f(q[68]) + w2 * bf2f(q[136]); }
            o[m >> 1] = pk2(r0, r1); }
        const int s = ch >> 9, c = ch & 511;
        bf16* dst = zc + ((size_t)((p * 3 + s) * HYW + c)) * 16384 + (16 * jb + jl) * 32 + bt * 16;
        *(v4u*)dst = (v4u){o[0], o[1], o[2], o[3]}; *(v4u*)(dst + 8) = (v4u){o[4], o[5], o[6], o[7]}; }
    __syncthreads();
}

#define UNPK(V, m) (((m) & 1) ? bfhi(V[(m) >> 3][((m) >> 1) & 3]) : bflo(V[(m) >> 3][((m) >> 1) & 3]))
__device__ __forceinline__ void hyena_item(const Args& P, int c, int p, float* y1s, LAS unsigned char* lds, int tid, int salt) {
    asm volatile("" : "+v"(tid) : "s"(salt) : "memory");
    LAS f32x2* X = (LAS f32x2*)lds;
    const bf16* zc = (const bf16*)(P.ws + WS_ZC); const float* Hs = (const float*)P.out; unsigned char* yhy = P.ws + WS_YHY;
    const float* fbp = P.in[18]; const float fb0 = fbp[c], fb1 = fbp[HYW + c];
    const int j = tid;
    const v4u* srcv = (const v4u*)(zc + ((size_t)((p * 3 + 0) * HYW + c)) * 16384 + j * 32);
    f32x4 hsp[8]; const float* Hcur = Hs + (size_t)(0 * HYW + c) * 32768;
    { v4u vp[4];
#pragma unroll
    for (int i = 0; i < 4; ++i) vp[i] = srcv[i];
    load_spec(hsp, Hcur, tid, salt);
    cf x[32];
#pragma unroll
      for (int m = 0; m < 16; ++m) { x[m] = cf{UNPK(vp, m), UNPK(vp, 16 + m)}; x[16 + m] = cf{0.f, 0.f}; }
      dft32<true>(x); twiddle32_fwd(x, twid(j, 14)); ldsA_storeX(X, j, x); }
    __syncthreads();
    fft_fwdB(X, tid, salt); __syncthreads();
    fft_mid(X, hsp, Hcur, tid, salt); __syncthreads();
    v4u gp[4], vp[4];
    { int jj = tid; asm volatile("" : "+v"(jj) : "s"(salt) : "memory"); const v4u* srcg1 = (const v4u*)(zc + ((size_t)((p * 3 + 1) * HYW + c)) * 16384 + jj * 32);
      const v4u* srcv2 = (const v4u*)(zc + ((size_t)((p * 3 + 0) * HYW + c)) * 16384 + jj * 32);
#pragma unroll
      for (int i = 0; i < 4; ++i) { gp[i] = __builtin_nontemporal_load(srcg1 + i); vp[i] = __builtin_nontemporal_load(srcv2 + i); } }
    fft_invB(X, tid, salt); __syncthreads();
    { int j1 = j; asm volatile("" : "+v"(j1) : "s"(salt) : "memory");
      cf x[32]; ldsA_load(X, j1, x); twiddle32_inv(x, twid(j1, 14)); dft32<false>(x);
      cf y1[16];
#pragma unroll
      for (int m = 0; m < 16; ++m) { const float ra = x[X32I(m)].x, rb = -x[X32I(m)].y; y1[m] = cf{UNPK(gp, m) * (ra + fb0 * UNPK(vp, m)), UNPK(gp, 16 + m) * (rb + fb0 * UNPK(vp, 16 + m))}; }
#pragma unroll
      for (int m = 0; m < 16; ++m) { x[m] = y1[m]; x[16 + m] = cf{0.f, 0.f}; }
#pragma unroll
      for (int m = 0; m < 16; m += 2) *(f32x4*)(y1s + j1 * 32 + 2 * m) = (f32x4){y1[m].x, y1[m].y, y1[m + 1].x, y1[m + 1].y};
      int j2 = j; asm volatile("" : "+v"(j2) : "s"(salt) : "memory");
      dft32<true>(x); twiddle32_fwd(x, twid(j2, 14)); ldsA_storeX(X, j2, x); }
    __syncthreads();
    Hcur = Hs + (size_t)(1 * HYW + c) * 32768; load_spec(hsp, Hcur, tid, salt);
    fft_fwdB(X, tid, salt); __syncthreads();
    fft_mid(X, hsp, Hcur, tid, salt); __syncthreads();
    f32x4 yv[8];
    { int jj = tid; asm volatile("" : "+v"(jj) : "s"(salt) : "memory"); const v4u* srcg2 = (const v4u*)(zc + ((size_t)((p * 3 + 2) * HYW + c)) * 16384 + jj * 32);
#pragma unroll
      for (int i = 0; i < 4; ++i) gp[i] = __builtin_nontemporal_load(srcg2 + i);
#pragma unroll
      for (int i = 0; i < 8; ++i) yv[i] = *(const f32x4*)(y1s + jj * 32 + 4 * i); }
    fft_invB(X, tid, salt); __syncthreads();
    { int j3 = j; asm volatile("" : "+v"(j3) : "s"(salt) : "memory");
      cf x[32]; ldsA_load(X, j3, x); twiddle32_inv(x, twid(j3, 14)); dft32<false>(x);
      unsigned char* ya = yhy + ((size_t)(2 * p) * SEQ + j3) * HYW + c; unsigned char* yb = yhy + ((size_t)(2 * p + 1) * SEQ + j3) * HYW + c;
#pragma unroll
      for (int m = 0; m < 16; ++m) { const float ra = x[X32I(m)].x, rb = -x[X32I(m)].y;
          ya[(size_t)512 * m * HYW] = f2fp8(64.0f * UNPK(gp, m) * (ra + fb1 * yv[m >> 1][2 * (m & 1)]));
          yb[(size_t)512 * m * HYW] = f2fp8(64.0f * UNPK(gp, 16 + m) * (rb + fb1 * yv[m >> 1][2 * (m & 1) + 1])); } }
    __syncthreads();
}
#undef UNPK

template <class MapT>
__device__ __forceinline__ void conv_tile(const float* W, int K, int N, bf16* WT, const MapT& map, int tile, int wave, int lane) {
    const int nblk = N / 256, kb = tile / nblk, nb = tile % nblk, k0 = 128 * kb + 16 * wave, n0 = 256 * nb + 4 * lane;
    f32x4 v[16];
    const float* src = W + (size_t)k0 * N + n0;
#pragma unroll
    for (int i = 0; i < 16; ++i) v[i] = __builtin_nontemporal_load((const f32x4*)(src + (size_t)i * N));
#pragma unroll
    for (int e = 0; e < 4; ++e) { v4u lo, hi;
        lo.x = pk2(v[0][e], v[1][e]); lo.y = pk2(v[2][e], v[3][e]); lo.z = pk2(v[4][e], v[5][e]); lo.w = pk2(v[6][e], v[7][e]);
        hi.x = pk2(v[8][e], v[9][e]); hi.y = pk2(v[10][e], v[11][e]); hi.z = pk2(v[12][e], v[13][e]); hi.w = pk2(v[14][e], v[15][e]);
        bf16* dst = WT + (size_t)map(n0 + e) * K + k0; *(v4u*)dst = lo; *(v4u*)(dst + 8) = hi; }
}
template <class MapT>
__device__ __forceinline__ void conv_tile8(const float* W, int K, int N, unsigned char* WT, const MapT& map, int tile, int wave, int lane, float scale) {
    const int nblk = N / 256, kb = tile / nblk, nb = tile % nblk, k0 = 128 * kb + 16 * wave, n0 = 256 * nb + 4 * lane;
    f32x4 v[16];
    const float* src = W + (size_t)k0 * N + n0;
#pragma unroll
    for (int i = 0; i < 16; ++i) v[i] = __builtin_nontemporal_load((const f32x4*)(src + (size_t)i * N)) * scale;
#pragma unroll
    for (int e = 0; e < 4; ++e) { v4u o;
        o.x = pk4_fp8(v[0][e], v[1][e], v[2][e], v[3][e]); o.y = pk4_fp8(v[4][e], v[5][e], v[6][e], v[7][e]); o.z = pk4_fp8(v[8][e], v[9][e], v[10][e], v[11][e]); o.w = pk4_fp8(v[12][e], v[13][e], v[14][e], v[15][e]);
        *(v4u*)(WT + (size_t)map(n0 + e) * K + k0) = o; }
}
struct MapWin { __device__ __forceinline__ int operator()(int n) const {
    if (n < 1536) return (n & ~31) | pinv32(n & 31);
    if (n < 2304) { const int t0 = 1536 + ((n - 1536) & ~255), cc = (n - 1536) & 255, hp = cc >> 6, d = cc & 63; return t0 + 128 * (d >> 5) + 32 * hp + (d & 31); }
    return (n & ~31) | pinv32(n & 31); } };
struct MapPerm { int off; __device__ __forceinline__ int operator()(int n) const { return off + ((n & ~31) | pinv32(n & 31)); } };
struct MapNat { __device__ __forceinline__ int operator()(int n) const { return n; } };
struct MapGU { int off; __device__ __forceinline__ int operator()(int f) const { return off + (f >> 7) * 256 + (((f & 127) & ~31) | pinv32(f & 31)); } };

__device__ __forceinline__ void phase_mod(const Args& P, LAS unsigned char* lds, int G, int tid) {
    LAS float* sc = (LAS float*)lds; LAS float* red = sc + 4096;
    asm volatile("" : "+v"(tid) :: "memory");
    const float* c = P.in[1]; const float* w_ada = P.in[2]; const float* b_ada = P.in[3];
    for (int i = tid; i < 4096; i += 512) { const float v = c[i]; sc[i] = v / (1.0f + expf(-v)); }
    __syncthreads();
    float* mod = (float*)(P.ws + WS_MOD);
    for (int cb = blockIdx.x; cb < 256; cb += G) {
        const int col0 = cb * 24, ks = tid / 24, col = tid % 24;
        float a0 = 0.f, a1 = 0.f, a2 = 0.f, a3 = 0.f;
        if (tid < 504) {
#pragma unroll 7
            for (int k = ks; k < 1024; k += 21) { const float w = w_ada[(size_t)k * 6144 + col0 + col]; a0 += sc[k] * w; a1 += sc[1024 + k] * w; a2 += sc[2048 + k] * w; a3 += sc[3072 + k] * w; }
            red[(ks * 24 + col) * 4 + 0] = a0; red[(ks * 24 + col) * 4 + 1] = a1; red[(ks * 24 + col) * 4 + 2] = a2; red[(ks * 24 + col) * 4 + 3] = a3; }
        __syncthreads();
        if (tid < 96) { const int b = tid / 24, cc = tid % 24; float s = 0.f; for (int q = 0; q < 21; ++q) s += red[(q * 24 + cc) * 4 + b]; mod[b * 6144 + col0 + cc] = s + b_ada[col0 + cc]; }
        __syncthreads();
    }
}

__device__ __forceinline__ void hraw_item(const Args& P, int item, LAS unsigned char* lds, int tid) {
    asm volatile("" : "+v"(tid) :: "memory");
    LAS float* ha = (LAS float*)lds;
    LAS float* hb = ha + 64 * 65;
    LAS float* wl1 = hb + 64 * 65;
    LAS float* wl2 = wl1 + 33 * 64;
    LAS float* wl3 = wl2 + 64 * 64;
    LAS float* hT = wl3 + 64 * 64;
    const int tb = item >> 1, half = item & 1, t0 = tb * 64;
    const float* b1 = P.in[11]; const float* b2 = P.in[13]; const float* b3 = P.in[15]; const float* w4 = P.in[16]; const float* fq = P.in[17];
    { f32x4 a1 = (f32x4){0.f, 0.f, 0.f, 0.f}, a1b = a1, a2[2], a3[2];
      a1 = *(const f32x4*)(P.in[10] + 4 * tid); if (tid < 16) a1b = *(const f32x4*)(P.in[10] + 4 * (tid + 512));
#pragma unroll
      for (int q = 0; q < 2; ++q) { a2[q] = *(const f32x4*)(P.in[12] + 4 * (tid + 512 * q)); a3[q] = *(const f32x4*)(P.in[14] + 4 * (tid + 512 * q)); }
      *(LAS f32x4*)(wl1 + 4 * tid) = a1; if (tid < 16) *(LAS f32x4*)(wl1 + 4 * (tid + 512)) = a1b;
#pragma unroll
      for (int q = 0; q < 2; ++q) { *(LAS f32x4*)(wl2 + 4 * (tid + 512 * q)) = a2[q]; *(LAS f32x4*)(wl3 + 4 * (tid + 512 * q)) = a3[q]; } }
    const int r = tid >> 3, js = tid & 7;
    { const int t = t0 + r;
        if (js == 0) hb[r * 65] = (float)t * (1.0f / 8191.0f);
        const float wv = (float)t * (1.0f / 8192.0f);
#pragma unroll
        for (int q = 0; q < 2; ++q) { const int kk = js * 2 + q; const float f = 1e-4f + (float)kk * ((15.0f - 1e-4f) / 15.0f); const float a = f * wv; hb[r * 65 + 1 + kk] = __builtin_amdgcn_cosf(a); hb[r * 65 + 17 + kk] = -__builtin_amdgcn_sinf(a); }
    }
    __syncthreads();
#define MLP_LAYER(SRC, W, BI, FO, NIN, STORE) do { float s_[8]; \
        _Pragma("unroll") for (int q = 0; q < 8; ++q) s_[q] = (BI)[js * 8 + q]; \
        _Pragma("unroll 4") for (int i = 0; i < (NIN); ++i) { const float hv = (SRC)[r * 65 + i]; const f32x4 wa = *(const LAS f32x4*)((W) + i * 64 + js * 8), wb = *(const LAS f32x4*)((W) + i * 64 + js * 8 + 4); \
            s_[0] += hv * wa.x; s_[1] += hv * wa.y; s_[2] += hv * wa.z; s_[3] += hv * wa.w; s_[4] += hv * wb.x; s_[5] += hv * wb.y; s_[6] += hv * wb.z; s_[7] += hv * wb.w; } \
        _Pragma("unroll") for (int q = 0; q < 8; ++q) { const float o_ = __builtin_amdgcn_sinf((FO)[js * 8 + q] * s_[q] * 0.15915494309189535f); STORE; } } while (0)
    MLP_LAYER(hb, wl1, b1, fq, 33, ha[r * 65 + js * 8 + q] = o_);
    __syncthreads();
    MLP_LAYER(ha, wl2, b2, fq + 64, 64, hb[r * 65 + js * 8 + q] = o_);
    __syncthreads();
    MLP_LAYER(hb, wl3, b3, fq + 128, 64, hT[(js * 8 + q) * 64 + r] = o_);
    __syncthreads();
#undef MLP_LAYER
    float* hraw = (float*)(P.ws + WS_HRAW);
    { typedef float f32x16_t __attribute__((ext_vector_type(16)));
      const int lane = tid & 63, wave = __builtin_amdgcn_readfirstlane(tid >> 6), l31 = lane & 31, hi = lane >> 5;
      bf16x8 bfr[4][2];
#pragma unroll
      for (int ks = 0; ks < 4; ++ks)
#pragma unroll
          for (int nb = 0; nb < 2; ++nb) { float v[8];
#pragma unroll
              for (int e = 0; e < 8; ++e) v[e] = hT[(16 * ks + 8 * hi + e) * 64 + 32 * nb + l31];
              bfr[ks][nb] = __builtin_bit_cast(bf16x8, (v4u){pk2(v[0], v[1]), pk2(v[2], v[3]), pk2(v[4], v[5]), pk2(v[6], v[7])}); }
      const float* wb_ = w4 + (size_t)(8 * hi) * 2048 + half * 1024 + wave * 128 + l31;
      float a0[32], a1[32];
#define HR_LOAD(A, MB) do { _Pragma("unroll") for (int ks = 0; ks < 4; ++ks) _Pragma("unroll") for (int e = 0; e < 8; ++e) A[8 * ks + e] = wb_[(size_t)(16 * ks + e) * 2048 + 32 * (MB)]; } while (0)
#define HR_COMP(A, MB) do { f32x16_t c0 = {0.f,0.f,0.f,0.f,0.f,0.f,0.f,0.f,0.f,0.f,0.f,0.f,0.f,0.f,0.f,0.f}, c1 = c0; \
          _Pragma("unroll") for (int ks = 0; ks < 4; ++ks) { const bf16x8 af = __builtin_bit_cast(bf16x8, (v4u){pk2(A[8 * ks], A[8 * ks + 1]), pk2(A[8 * ks + 2], A[8 * ks + 3]), pk2(A[8 * ks + 4], A[8 * ks + 5]), pk2(A[8 * ks + 6], A[8 * ks + 7])}); \
              c0 = __builtin_amdgcn_mfma_f32_32x32x16_bf16(af, bfr[ks][0], c0, 0, 0, 0); c1 = __builtin_amdgcn_mfma_f32_32x32x16_bf16(af, bfr[ks][1], c1, 0, 0, 0); } \
          float* o_ = hraw + (size_t)(half * 1024 + wave * 128 + 32 * (MB) + 4 * hi) * SEQ + t0 + l31; \
          _Pragma("unroll") for (int r_ = 0; r_ < 16; ++r_) { float* q_ = o_ + (size_t)((r_ & 3) + 8 * (r_ >> 2)) * SEQ; q_[0] = c0[r_]; q_[32] = c1[r_]; } } while (0)
      HR_LOAD(a0, 0);
      HR_LOAD(a1, 1); HR_COMP(a0, 0);
      HR_LOAD(a0, 2); HR_COMP(a1, 1);
      HR_LOAD(a1, 3); HR_COMP(a0, 2);
      HR_COMP(a1, 3);
#undef HR_LOAD
#undef HR_COMP
    }
    __syncthreads();
}

__device__ __forceinline__ void phase_prep(const Args& P, LAS unsigned char* lds, int vcu, int G, int tid_, unsigned* modcnt, unsigned* tmo, int wid) {
    asm volatile("" : "+v"(tid_) :: "memory");
    const int tid = tid_, lane = tid & 63, wave = __builtin_amdgcn_readfirstlane(tid >> 6);
    const int gw = vcu * NWAVES + wave, NGW = G * NWAVES;
    for (int it = vcu; it < 256; it += G) hraw_item(P, it, lds, tid);
    { constexpr int T_IN = 8 * 17, T_HY = 4 * 4, T_AT = 4 * 4, T_O = 8 * 4;
      for (int it = vcu; it < T_IN + T_HY + T_AT + T_O; it += G) { int r = it;
          if (r < T_IN) { conv_tile8(P.in[6], DM, INW, P.ws + WS_WIN, MapWin{}, r, wave, lane, 32.0f); continue; } r -= T_IN;
          if (r < T_HY) { conv_tile8(P.in[21], HYW, DM, P.ws + WS_WHY, MapPerm{0}, r, wave, lane, 32.0f); continue; } r -= T_HY;
          if (r < T_AT) { conv_tile8(P.in[22], ATTW, DM, P.ws + WS_WAT, MapPerm{0}, r, wave, lane, 32.0f); continue; } r -= T_AT;
          conv_tile8(P.in[23], DM, DM, P.ws + WS_WO, MapNat{}, r, wave, lane, 32.0f); } }
    { float* cs = (float*)(P.ws + WS_ROPE); const int i = vcu * 512 + tid;
      for (int q = i; q < 128 * 16; q += G * 512) { const int pos = q >> 4, k = q & 15; const float inv = powf(10000.0f, -(float)k * (1.0f / 16.0f)); const float a = (float)pos * inv; cs[pos * 32 + k] = cosf(a); cs[pos * 32 + 16 + k] = sinf(a); }
      float* bp = (float*)(P.ws + WS_BPERM); const float* b_in = P.in[7]; MapWin mw;
      for (int n = (G * 512 - 1) - i; n < INW; n += G * 512) bp[mw(n)] = b_in[n]; }
    split_wait(modcnt, (unsigned)G, tmo, wid);
    const float* x = P.in[0]; const float* gmix = P.in[4]; const float* mod = (const float*)(P.ws + WS_MOD); unsigned char* hn = P.ws + WS_HN;
    f32x4 gg[4], shv[4]; int curb = -1;
    f32x4 v[2][4], vn[2][4];
#define HN_LOAD(V, M0) do { _Pragma("unroll") for (int r = 0; r < 2; ++r) { const int mm_ = ((M0) + r * NGW < MTOK) ? (M0) + r * NGW : (M0); const f32x4* xr = (const f32x4*)(x + (size_t)mm_ * DM) + lane; \
        _Pragma("unroll") for (int j = 0; j < 4; ++j) V[r][j] = __builtin_nontemporal_load(xr + 64 * j); } } while (0)
    if (gw < MTOK) HN_LOAD(v, gw);
    for (int m0 = gw; m0 < MTOK; m0 += 2 * NGW) { int mr[2]; mr[0] = m0; mr[1] = (m0 + NGW < MTOK) ? m0 + NGW : m0;
        const int mnext = m0 + 2 * NGW;
        if (mnext < MTOK) HN_LOAD(vn, mnext);
        float s[2] = {0.f, 0.f};
#pragma unroll
        for (int r = 0; r < 2; ++r) {
#pragma unroll
            for (int j = 0; j < 4; ++j) s[r] += (v[r][j].x * v[r][j].x + v[r][j].y * v[r][j].y) + (v[r][j].z * v[r][j].z + v[r][j].w * v[r][j].w); }
#pragma unroll
        for (int r = 0; r < 2; ++r) { const int m = mr[r], b = m >> 13;
            if (b != curb) { curb = b;
#pragma unroll
                for (int j = 0; j < 4; ++j) { const int col = 4 * lane + 256 * j; gg[j] = *(const f32x4*)(gmix + col) * (*(const f32x4*)(mod + b * 6144 + 1024 + col) + 1.0f); shv[j] = *(const f32x4*)(mod + b * 6144 + col); } }
            const float rstd = 1.0f / sqrtf(wave_sum(s[r]) * (1.0f / DM) + EPSV);
            unsigned* o4 = (unsigned*)(hn + (size_t)m * DM) + lane;
#pragma unroll
            for (int j = 0; j < 4; ++j) { const f32x4 h = v[r][j] * rstd * gg[j] + shv[j]; o4[64 * j] = pk4_fp8(h.x, h.y, h.z, h.w); } }
#pragma unroll
        for (int r = 0; r < 2; ++r)
#pragma unroll
            for (int j = 0; j < 4; ++j) v[r][j] = vn[r][j]; }
#undef HN_LOAD
}

__device__ __forceinline__ void xconv_load(const Args& P, int wt, int lane, f32x4 (&v)[16]) {
    const int it = wt >> 3, sl = wt & 7, e = it / 192, r0 = it % 192, kind = r0 >> 6, r = r0 & 63;
    const float* W = (kind == 0 ? P.in[25] : kind == 1 ? P.in[26] : P.in[27]) + (size_t)e * DM * DFF;
    const int N = kind == 2 ? DM : DFF;
    const int kb = kind == 2 ? (r >> 2) : (r >> 3), nb = kind == 2 ? (r & 3) : (r & 7);
    const float* src = W + (size_t)(128 * kb + 16 * sl) * N + 256 * nb + 4 * lane;
#pragma unroll
    for (int i = 0; i < 16; ++i) v[i] = __builtin_nontemporal_load((const f32x4*)(src + (size_t)i * N));
}
__device__ __forceinline__ void xconv_store(const Args& P, int wt, int lane, f32x4 (&v)[16]) {
    const int it = wt >> 3, sl = wt & 7, e = it / 192, r0 = it % 192, kind = r0 >> 6, r = r0 & 63;
    const int K = kind == 2 ? DFF : DM;
    const int kb = kind == 2 ? (r >> 2) : (r >> 3), nb = kind == 2 ? (r & 3) : (r & 7);
    const int k0 = 128 * kb + 16 * sl, n0 = 256 * nb + 4 * lane;
    unsigned char* WT = P.ws + (kind == 2 ? WS_WD : WS_WGU);
    const int rbase = kind == 2 ? e * 1024 : e * 4096 + kind * 128;
#pragma unroll
    for (int c = 0; c < 4; ++c) { const int n = n0 + c; const int pr = (n & ~31) | pinv32(n & 31);
        const int row = rbase + (kind == 2 ? pr : (n >> 7) * 256 + (pr & 127));
        v4u o;
        o.x = pk4_fp8(v[0][c] * 32.0f, v[1][c] * 32.0f, v[2][c] * 32.0f, v[3][c] * 32.0f); o.y = pk4_fp8(v[4][c] * 32.0f, v[5][c] * 32.0f, v[6][c] * 32.0f, v[7][c] * 32.0f);
        o.z = pk4_fp8(v[8][c] * 32.0f, v[9][c] * 32.0f, v[10][c] * 32.0f, v[11][c] * 32.0f); o.w = pk4_fp8(v[12][c] * 32.0f, v[13][c] * 32.0f, v[14][c] * 32.0f, v[15][c] * 32.0f);
        *(v4u*)(WT + (size_t)row * K + k0) = o; }
}
__device__ __forceinline__ void expert_conv(const Args& P, int t0, int st, int n, int tid) {
    asm volatile("" : "+v"(tid) :: "memory");
    const int lane = tid & 63, wave = __builtin_amdgcn_readfirstlane(tid >> 6);
    if (n <= 0) return;
    f32x4 a[16], b[16];
    xconv_load(P, 8 * t0 + wave, lane, a);
    for (int i = 0; i < n; i += 2) { const int i1 = i + 1 < n ? i + 1 : n - 1, i2 = i + 2 < n ? i + 2 : n - 1;
        xconv_load(P, 8 * (t0 + st * i1) + wave, lane, b);
        xconv_store(P, 8 * (t0 + st * i) + wave, lane, a);
        xconv_load(P, 8 * (t0 + st * i2) + wave, lane, a);
        xconv_store(P, 8 * (t0 + st * i1) + wave, lane, b); }
}

__device__ __forceinline__ void phase_norm2(const Args& P, LAS unsigned char* lds, int vcu, int G, int tid_, bool fuse, int n_fused_wt) {
    asm volatile("" : "+v"(tid_) :: "memory");
    const int tid = tid_, lane = tid & 63, wave = __builtin_amdgcn_readfirstlane(tid >> 6);
    const int gw = vcu * NWAVES + wave, NGW = G * NWAVES;
    LAS float* wrt = (LAS float*)lds;
    const float* w_router = P.in[24];
    { f32x4 wv[8];
#pragma unroll
      for (int q = 0; q < 8; ++q) wv[q] = *(const f32x4*)(w_router + 4 * (tid + 512 * q));
#pragma unroll
      for (int q = 0; q < 8; ++q) { const int i = 4 * (tid + 512 * q), k = i >> 4, e = i & 15; wrt[e * DM + k] = wv[q].x; wrt[(e + 1) * DM + k] = wv[q].y; wrt[(e + 2) * DM + k] = wv[q].z; wrt[(e + 3) * DM + k] = wv[q].w; } }
    __syncthreads();
    const float* x1 = P.out; const float* gffn = P.in[5]; const float* mod = (const float*)(P.ws + WS_MOD); const float* rowsq = (const float*)(P.ws + WS_ROWSQ);
    unsigned char* h2 = P.ws + WS_H2; float* aff = (float*)(P.ws + WS_AFF);
    f32x4 gg[4], shv[4]; int curb = -1;
    f32x4 v[2][4], vn[2][4]; float s[2], sn[2];
#define N2_LOAD(V, SV, M0) do { _Pragma("unroll") for (int r = 0; r < 2; ++r) { const int mm_ = ((M0) + r * NGW < MTOK) ? (M0) + r * NGW : (M0); const f32x4* xr = (const f32x4*)(x1 + (size_t)mm_ * DM) + lane; \
        _Pragma("unroll") for (int j = 0; j < 4; ++j) V[r][j] = __builtin_nontemporal_load(xr + 64 * j); SV[r] = lane < 16 ? rowsq[(size_t)mm_ * 16 + lane] : 0.f; } } while (0)
    f32x4 cv[16]; int cwt = gw;
    if (fuse) xconv_load(P, cwt < n_fused_wt ? cwt : n_fused_wt - 1, lane, cv);
    if (gw < MTOK) N2_LOAD(v, s, gw);
    for (int m0 = gw; m0 < MTOK; m0 += 2 * NGW) { const int nr = (m0 + NGW < MTOK) ? 2 : 1;
        { const int mnx = (m0 + 2 * NGW < MTOK) ? m0 + 2 * NGW : m0; N2_LOAD(vn, sn, mnx); }
#pragma unroll
        for (int r = 0; r < 2; ++r) { const int m = (r < nr) ? m0 + r * NGW : m0; const int b = m >> 13;
            if (b != curb) { curb = b;
#pragma unroll
                for (int j = 0; j < 4; ++j) { const int col = 4 * lane + 256 * j; gg[j] = *(const f32x4*)(gffn + col) * (*(const f32x4*)(mod + b * 6144 + 4096 + col) + 1.0f); shv[j] = *(const f32x4*)(mod + b * 6144 + 3072 + col); } }
            const float rstd = 1.0f / sqrtf(wave_sum(s[r]) * (1.0f / DM) + EPSV);
            unsigned* o4 = (unsigned*)(h2 + (size_t)m * DM) + lane;
#pragma unroll
            for (int j = 0; j < 4; ++j) { v[r][j] = v[r][j] * rstd * gg[j] + shv[j]; if (r < nr) o4[64 * j] = pk4_fp8(v[r][j].x, v[r][j].y, v[r][j].z, v[r][j].w); } }
        float mylg[2] = {0.f, 0.f};
#pragma unroll 1
        for (int e = 0; e < 16; ++e) { float a0 = 0.f, a1 = 0.f;
#pragma unroll
            for (int j = 0; j < 4; ++j) { const f32x4 w = *(const LAS f32x4*)(wrt + e * DM + 4 * lane + 256 * j);
                a0 += (v[0][j].x * w.x + v[0][j].y * w.y) + (v[0][j].z * w.z + v[0][j].w * w.w); a1 += (v[1][j].x * w.x + v[1][j].y * w.y) + (v[1][j].z * w.z + v[1][j].w * w.w); }
            a0 = wave_sum(a0); a1 = wave_sum(a1); if (lane == e) { mylg[0] = a0; mylg[1] = a1; } }
#pragma unroll
        for (int r = 0; r < 2; ++r) { if (r < nr) { const int m = m0 + r * NGW; const int b = m >> 13, t = m & (SEQ - 1);
            const float mx = row16_max(mylg[r]);
            const float mine = expf(mylg[r] - mx); const float den = row16_sum(mine);
            if (lane < 16) aff[((size_t)(b * NEXP + lane)) * SEQ + t] = mine / den; } }
        if (fuse) { xconv_store(P, cwt < n_fused_wt ? cwt : n_fused_wt - 1, lane, cv); cwt += NGW; xconv_load(P, cwt < n_fused_wt ? cwt : n_fused_wt - 1, lane, cv); }
#pragma unroll
        for (int r = 0; r < 2; ++r) { s[r] = sn[r];
#pragma unroll
            for (int j = 0; j < 4; ++j) v[r][j] = vn[r][j]; } }
    while (fuse && cwt < n_fused_wt) { xconv_store(P, cwt, lane, cv); cwt += NGW; xconv_load(P, cwt < n_fused_wt ? cwt : n_fused_wt - 1, lane, cv); }
#undef N2_LOAD
}

__device__ __forceinline__ void topk_item(const Args& P, int be, LAS unsigned char* lds, int tid) {
    asm volatile("" : "+v"(tid) :: "memory");
    LAS float* vals = (LAS float*)lds; LAS unsigned* hist = (LAS unsigned*)(lds + 32768); LAS unsigned* sel = hist + 256; LAS unsigned* scan = hist + 512;
    const float* aff = (const float*)(P.ws + WS_AFF) + (size_t)be * SEQ;
    for (int i = tid; i < SEQ; i += 512) vals[i] = __builtin_nontemporal_load(aff + i);
    unsigned prefix = 0u, mask = 0u; unsigned need = CAP;
    for (int pass = 0; pass < 4; ++pass) { const int shift = 24 - 8 * pass;
        if (tid < 256) hist[tid] = 0u;
        __syncthreads();
        for (int i = tid; i < SEQ; i += 512) { const unsigned bits = __float_as_uint(vals[i]); if ((bits & mask) == prefix) __hip_atomic_fetch_add(&hist[(bits >> shift) & 255u], 1u, __ATOMIC_RELAXED, __HIP_MEMORY_SCOPE_WORKGROUP); }
        __syncthreads();
        if (tid < 256) { unsigned s = 0u; for (int k2 = tid + 1; k2 < 256; ++k2) s += hist[k2]; const unsigned h = hist[tid]; if (s < need && need <= s + h) { sel[0] = (unsigned)tid; sel[1] = need - s; } }
        __syncthreads();
        prefix |= sel[0] << shift; mask |= 0xFFu << shift; need = sel[1];
        __syncthreads();
    }
    unsigned cg = 0u, ce = 0u; float v[16];
#pragma unroll
    for (int i = 0; i < 16; ++i) { v[i] = vals[16 * tid + i]; const unsigned bits = __float_as_uint(v[i]); cg += bits > prefix ? 1u : 0u; ce += bits == prefix ? 1u : 0u; }
    scan[tid] = cg; scan[512 + tid] = ce;
    __syncthreads();
    for (int off = 1; off < 512; off <<= 1) { unsigned a = 0u, b = 0u; if (tid >= off) { a = scan[tid - off]; b = scan[512 + tid - off]; } __syncthreads(); scan[tid] += a; scan[512 + tid] += b; __syncthreads(); }
    unsigned pg = scan[tid] - cg, pe = scan[512 + tid] - ce;
    int* slot_of = (int*)(P.ws + WS_SLOT) + (size_t)be * SEQ; int* topi = (int*)(P.ws + WS_TOPI) + be * CAP; float* topw = (float*)(P.ws + WS_TOPW) + be * CAP;
#pragma unroll
    for (int i = 0; i < 16; ++i) { const unsigned bits = __float_as_uint(v[i]); int slot = -1;
        if (bits > prefix) { slot = (int)(pg + (pe < need ? pe : need)); ++pg; }
        else if (bits == prefix) { if (pe < need) slot = (int)(pg + pe); ++pe; }
        slot_of[16 * tid + i] = slot;
        if (slot >= 0) { topi[slot] = 16 * tid + i; topw[slot] = v[i]; } }
    __syncthreads();
}

__device__ __forceinline__ void phase_combine(const Args& P, int vcu, int G, int tid_) {
    asm volatile("" : "+v"(tid_) :: "memory");
    const int tid = tid_, lane = tid & 63, wave = __builtin_amdgcn_readfirstlane(tid >> 6);
    const int gw = vcu * NWAVES + wave, NGW = G * NWAVES;
    float* out = P.out; const float* mod = (const float*)(P.ws + WS_MOD); const int* slot_of = (const int*)(P.ws + WS_SLOT); const bf16* ye = (const bf16*)(P.ws + WS_YE);
    f32x4 gtv[4]; int curb = -1;
    for (int m0 = gw; m0 < MTOK; m0 += 2 * NGW) { const int nr = (m0 + NGW < MTOK) ? 2 : 1;
        f32x4 v[2][4], a[2][4]; int myslot[2];
#pragma unroll
        for (int r = 0; r < 2; ++r) { const int m = (r < nr) ? m0 + r * NGW : m0; const int b = m >> 13, t = m & (SEQ - 1);
            const f32x4* xr = (const f32x4*)(out + (size_t)m * DM) + lane;
#pragma unroll
            for (int j = 0; j < 4; ++j) { v[r][j] = __builtin_nontemporal_load(xr + 64 * j); a[r][j] = (f32x4){0.f, 0.f, 0.f, 0.f}; }
            myslot[r] = lane < 16 ? slot_of[((size_t)(b * NEXP + lane)) * SEQ + t] : -1; }
#pragma unroll
        for (int r = 0; r < 2; ++r) { const int m = (r < nr) ? m0 + r * NGW : m0; const int b = m >> 13;
            for (int e = 0; e < 16; ++e) { const int sl = __builtin_amdgcn_readlane(myslot[r], e);
                if (sl >= 0) { const v2u* yr = (const v2u*)(ye + ((size_t)(b * NEXP + e) * CAP + sl) * DM) + lane;
#pragma unroll
                    for (int j = 0; j < 4; ++j) { const v2u w = __builtin_nontemporal_load(yr + 64 * j); a[r][j].x += bflo(w.x); a[r][j].y += bfhi(w.x); a[r][j].z += bflo(w.y); a[r][j].w += bfhi(w.y); } } } }
#pragma unroll
        for (int r = 0; r < 2; ++r) { if (r < nr) { const int m = m0 + r * NGW; const int b = m >> 13; f32x4* xw = (f32x4*)(out + (size_t)m * DM) + lane;
            if (b != curb) { curb = b;
#pragma unroll
                for (int j = 0; j < 4; ++j) gtv[j] = *(const f32x4*)(mod + b * 6144 + 5120 + 4 * lane + 256 * j); }
#pragma unroll
            for (int j = 0; j < 4; ++j) __builtin_nontemporal_store(v[r][j] + gtv[j] * a[r][j], xw + 64 * j); } } }
}

#ifdef PROBE_CHECK
constexpr int CW_PROBE = 8192;
__device__ __forceinline__ void probe_acc(const Args& P, int cat, float num, float den, LAS float* red, int tid) {
    block_sum2(num, den, red, tid);
    if (tid == 0) { float* pw = (float*)(P.ws + WS_CTL) + CW_PROBE + 2 * cat; __hip_atomic_fetch_add(pw, num, __ATOMIC_RELAXED, __HIP_MEMORY_SCOPE_AGENT); __hip_atomic_fetch_add(pw + 1, den, __ATOMIC_RELAXED, __HIP_MEMORY_SCOPE_AGENT); }
    __syncthreads();
}
__device__ __forceinline__ void probe_inproj(const Args& P, int m, LAS unsigned char* lds, int tid) {
    LAS float* h = (LAS float*)lds; LAS float* z = h + 1024; LAS float* red = z + 4352; LAS float* hr = red + 64;
    const int b = m >> 13, t = m & (SEQ - 1);
    const float* x = P.in[0] + (size_t)m * DM; const float* mod = (const float*)(P.ws + WS_MOD) + b * 6144;
    float ss = 0.f, dm = 0.f; for (int k = tid; k < DM; k += 512) ss += x[k] * x[k];
    block_sum2(ss, dm, red, tid);
    const float rstd = 1.0f / sqrtf(ss / DM + EPSV);
    for (int k = tid; k < DM; k += 512) h[k] = x[k] * rstd * P.in[4][k] * (1.0f + mod[1024 + k]) + mod[k];
    __syncthreads();
    for (int n = tid; n < INW; n += 512) { float a = P.in[7][n]; for (int k = 0; k < DM; ++k) a += h[k] * P.in[6][(size_t)k * INW + n]; z[n] = a; }
    __syncthreads();
    if (tid < 10) { float s2 = 0.f; for (int d = 0; d < 64; ++d) { const float v = z[1536 + tid * 64 + d]; s2 += v * v; } hr[tid] = 1.0f / sqrtf(s2 / 64.0f + EPSV); }
    __syncthreads();
    const bf16* zhy = (const bf16*)(P.ws + WS_ZHY); const bf16* q = (const bf16*)(P.ws + WS_Q); const bf16* kk = (const bf16*)(P.ws + WS_K); const bf16* vv = (const bf16*)(P.ws + WS_V); const bf16* gate = (const bf16*)(P.ws + WS_GATE);
    float num[5] = {0, 0, 0, 0, 0}, den[5] = {0, 0, 0, 0, 0};
    for (int n = tid; n < INW; n += 512) {
        float ref, got; int cat;
        if (n < 1536) { ref = z[n]; got = bf2f(zhy[(size_t)m * HYIN + n]); cat = 0; }
        else if (n < 2176) { const int hd = (n - 1536) >> 6, d = n & 63; const bool isq = hd < 8; const float* gain = isq ? P.in[19] : P.in[20];
            const int half = d >> 5, i = d & 15, second = (d >> 4) & 1; const int base = 1536 + hd * 64 + 32 * half;
            const float u1 = z[base + i] * hr[hd] * gain[32 * half + i], u2 = z[base + 16 + i] * hr[hd] * gain[32 * half + 16 + i];
            const float pos = half ? (float)(t & 63) : (float)(t >> 6); const float ang = pos * powf(10000.0f, -(float)i / 16.0f); const float c = cosf(ang), sn = sinf(ang);
            ref = second ? (u1 * sn + u2 * c) : (u1 * c - u2 * sn);
            if (isq) { ref *= C2Q; got = bf2f(q[(size_t)m * ATTW + hd * 64 + d]); cat = 1; } else { got = bf2f(kk[(size_t)m * KVW + (hd - 8) * 64 + d]); cat = 2; } }
        else if (n < 2304) { ref = z[n]; got = bf2f(vv[(size_t)m * KVW + (n - 2176)]); cat = 3; }
        else { ref = 1.0f / (1.0f + expf(-z[n])); got = bf2f(gate[(size_t)m * 2048 + (n - 2304)]); cat = 4; }
#pragma unroll
        for (int cI = 0; cI < 5; ++cI) if (cat == cI) { num[cI] += (got - ref) * (got - ref); den[cI] += ref * ref; }
    }
#pragma unroll
    for (int cI = 0; cI < 5; ++cI) probe_acc(P, cI, num[cI], den[cI], red, tid);
}
__device__ __forceinline__ void probe_hraw(const Args& P, int t, LAS unsigned char* lds, int tid) {
    LAS float* f0 = (LAS float*)lds; LAS float* f1 = f0 + 64; LAS float* f2 = f1 + 64; LAS float* red = f2 + 64;
    const float* w1 = P.in[10]; const float* b1 = P.in[11]; const float* w2 = P.in[12]; const float* b2 = P.in[13]; const float* w3 = P.in[14]; const float* b3 = P.in[15]; const float* w4 = P.in[16]; const float* fq = P.in[17];
    if (tid < 33) { float v; if (tid == 0) v = (float)t / 8191.0f; else { const int kq = (tid - 1) & 15; const float f = 1e-4f + (float)kq * ((15.0f - 1e-4f) / 15.0f); const float a = f * (6.283185307179586f * (float)t / 8192.0f); v = tid <= 16 ? cosf(a) : -sinf(a); } f0[tid] = v; }
    __syncthreads();
    if (tid < 64) { float s = b1[tid]; _Pragma("unroll 2") for (int i = 0; i < 33; ++i) s += f0[i] * w1[i * 64 + tid]; f1[tid] = sinf(fq[tid] * s); }
    __syncthreads();
    if (tid < 64) { float s = b2[tid]; _Pragma("unroll 2") for (int i = 0; i < 64; ++i) s += f1[i] * w2[i * 64 + tid]; f2[tid] = sinf(fq[64 + tid] * s); }
    __syncthreads();
    if (tid < 64) { float s = b3[tid]; _Pragma("unroll 2") for (int i = 0; i < 64; ++i) s += f2[i] * w3[i * 64 + tid]; f0[tid] = sinf(fq[128 + tid] * s); }
    __syncthreads();
    const float* hraw = (const float*)(P.ws + WS_HRAW); float num = 0.f, den = 0.f;
#pragma unroll 1
    for (int idx = tid; idx < 2048; idx += 512) { float s = 0.f;
#pragma unroll 4
        for (int j = 0; j < 64; ++j) s += f0[j] * w4[j * 2048 + idx]; const float got = hraw[(size_t)idx * SEQ + t]; num += (got - s) * (got - s); den += s * s; }
    probe_acc(P, 7, num, den, red, tid);
}
__device__ __forceinline__ void probe_attn(const Args& P, int b, int hq, int tq, LAS unsigned char* lds, int tid) {
    LAS float* qs = (LAS float*)lds; LAS float* red = qs + 64; LAS float* osum = red + 64;
    const bf16* q = (const bf16*)(P.ws + WS_Q); const bf16* kk = (const bf16*)(P.ws + WS_K); const bf16* vv = (const bf16*)(P.ws + WS_V); const unsigned char* yat = P.ws + WS_YAT;
    const size_t m = (size_t)b * SEQ + tq; const int kvh = hq >> 2;
    if (tid < 64) { qs[tid] = bf2f(q[m * ATTW + hq * 64 + tid]); osum[tid] = 0.f; }
    __syncthreads();
    float sc[16]; float mx = -1e30f;
#pragma unroll
    for (int i = 0; i < 16; ++i) { const int s = tid + 512 * i; const bf16* kr = kk + ((size_t)b * SEQ + s) * KVW + kvh * 64; float a = 0.f; for (int d = 0; d < 64; ++d) a += qs[d] * bf2f(kr[d]); sc[i] = a; mx = fmaxf(mx, a); }
#pragma unroll
    for (int o = 1; o < 64; o <<= 1) mx = fmaxf(mx, __shfl_xor(mx, o));
    __syncthreads(); if ((tid & 63) == 0) red[tid >> 6] = mx; __syncthreads();
    mx = red[0]; for (int w = 1; w < 8; ++w) mx = fmaxf(mx, red[w]);
    __syncthreads();
    float l = 0.f, dmy = 0.f;
#pragma unroll
    for (int i = 0; i < 16; ++i) { sc[i] = exp2f(sc[i] - mx); l += sc[i]; }
    block_sum2(l, dmy, red, tid);
    for (int d = 0; d < 64; ++d) { float a = 0.f;
#pragma unroll
        for (int i = 0; i < 16; ++i) { const int s = tid + 512 * i; a += sc[i] * bf2f(vv[((size_t)b * SEQ + s) * KVW + kvh * 64 + d]); }
        a = wave_sum(a); if ((tid & 63) == 0) __hip_atomic_fetch_add(&osum[d], a, __ATOMIC_RELAXED, __HIP_MEMORY_SCOPE_WORKGROUP); }
    __syncthreads();
    float num = 0.f, den = 0.f;
    if (tid < 64) { const float ref = osum[tid] / l; const float got = fp82f(yat[m * ATTW + hq * 64 + tid]) * (1.0f / 64.0f); num = (got - ref) * (got - ref); den = ref * ref; }
    probe_acc(P, 5, num, den, red, tid);
}
__device__ __forceinline__ void probe_hyena(const Args& P, int b, int c, float* scr, LAS unsigned char* lds, int tid) {
    LAS float* red = (LAS float*)lds;
    float* hf1 = scr; float* hb1 = scr + 8192; float* hf2 = scr + 16384; float* hb2 = scr + 24576; float* vc = scr + 32768; float* x1c = scr + 40960; float* x2c = scr + 49152; float* y1 = scr + 57344;
    const float* hraw = (const float*)(P.ws + WS_HRAW); const bf16* zhy = (const bf16*)(P.ws + WS_ZHY); const unsigned char* yhy = P.ws + WS_YHY;
    const float mind = logf(1e-2f) / 1.5f, maxd = logf(1e-2f) / 0.3f; const float ad = fabsf(mind + (maxd - mind) * (float)c / 511.0f);
    for (int f = 0; f < 4; ++f) { const float* src = scr + f * 8192; float* dst = scr + f * 8192; float s = 0.f, dmy = 0.f;
        for (int t = tid; t < SEQ; t += 512) { const float v = src[t] * expf(-((float)t / 8191.0f) * ad); dst[t] = v; s += fabsf(v); }
        block_sum2(s, dmy, red, tid);
        for (int t = tid; t < SEQ; t += 512) dst[t] = dst[t] / (s + EPSV); }
    for (int st = 0; st < 3; ++st) { const int ch = st * HYW + c; const bf16* zr = zhy + (size_t)b * SEQ * HYIN + ch; float* dst = scr + 32768 + st * 8192;
        const float w0 = P.in[8][ch], w1 = P.in[8][HYIN + ch], w2 = P.in[8][2 * HYIN + ch], bs = P.in[9][ch];
        for (int t = tid; t < SEQ; t += 512) { const float a0 = t > 0 ? bf2f(zr[(size_t)(t - 1) * HYIN]) : 0.f, a1 = bf2f(zr[(size_t)t * HYIN]), a2 = t < SEQ - 1 ? bf2f(zr[(size_t)(t + 1) * HYIN]) : 0.f; dst[t] = bs + a0 * w0 + a1 * w1 + a2 * w2; } }
    __threadfence(); __syncthreads();
    const float fb0 = P.in[18][c], fb1 = P.in[18][HYW + c];
    for (int t = tid; t < SEQ; t += 512) { float a = 0.f; for (int s = 0; s <= t; ++s) a += hf1[t - s] * vc[s]; for (int s = t; s < SEQ; ++s) a += hb1[s - t] * vc[s]; y1[t] = x1c[t] * (a + fb0 * vc[t]); }
    __threadfence(); __syncthreads();
    float num = 0.f, den = 0.f;
    for (int t = tid; t < SEQ; t += 512) { float a = 0.f; for (int s = 0; s <= t; ++s) a += hf2[t - s] * y1[s]; for (int s = t; s < SEQ; ++s) a += hb2[s - t] * y1[s];
        const float ref = x2c[t] * (a + fb1 * y1[t]); const float got = fp82f(yhy[((size_t)b * SEQ + t) * HYW + c]) * (1.0f / 64.0f); num += (got - ref) * (got - ref); den += ref * ref; }
    probe_acc(P, 6, num, den, red, tid);
}
__device__ __forceinline__ void probe_merge(const Args& P, int m, LAS unsigned char* lds, int tid) {
    LAS float* mm = (LAS float*)lds; LAS float* red = mm + 1024;
    const int b = m >> 13; const unsigned char* yhy = P.ws + WS_YHY + (size_t)m * HYW; const unsigned char* yat = P.ws + WS_YAT + (size_t)m * ATTW; const bf16* gate = (const bf16*)(P.ws + WS_GATE) + (size_t)m * 2048;
    for (int n = tid; n < DM; n += 512) { float ph = 0.f, pa = 0.f; for (int c = 0; c < 512; ++c) { ph += fp82f(yhy[c]) * (1.0f / 64.0f) * P.in[21][(size_t)c * DM + n]; pa += fp82f(yat[c]) * (1.0f / 64.0f) * P.in[22][(size_t)c * DM + n]; }
        mm[n] = bf2f(gate[n]) * ph + bf2f(gate[1024 + n]) * pa; }
    __syncthreads();
    const float* mod = (const float*)(P.ws + WS_MOD) + b * 6144; float num = 0.f, den = 0.f;
    for (int n = tid; n < DM; n += 512) { float a = 0.f; for (int k = 0; k < DM; ++k) a += mm[k] * P.in[23][(size_t)k * DM + n]; const float ref = mod[2048 + n] * a; const float got = P.out[(size_t)m * DM + n] - P.in[0][(size_t)m * DM + n]; num += (got - ref) * (got - ref); den += ref * ref; }
    probe_acc(P, 8, num, den, red, tid);
}
#endif

__global__ void __launch_bounds__(NWAVES * 64, 2) mk_fwd(Args P) {
    extern __shared__ __attribute__((aligned(16))) unsigned char lds_raw[];
    LAS unsigned char* lds = (LAS unsigned char*)lds_raw;
    volatile LAS unsigned* MISC = (volatile LAS unsigned*)(lds + MISC_OFF);
    const int wid_s = __builtin_amdgcn_readfirstlane((int)threadIdx.x >> 6);
#define tid my_tid(wid_s)
    const int G = gridDim.x; const int bx = blockIdx.x; const int vcu = (G % 8 == 0) ? (bx % 8) * (G / 8) + bx / 8 : bx;
    for (int u = tid; u < (LDS_BYTES - LDSCTL_OFF) / 4; u += NWAVES * 64) ((LAS unsigned*)(lds + LDSCTL_OFF))[u] = 0u;
    __syncthreads();
    gu32* ctl = (gu32*)(P.ws + WS_CTL);
    XcdBarrier bar; bar.bar = (unsigned*)(ctl + CW_BAR) + P.li * XCD_BAR_WORDS; bar.x = 0; bar.st = nullptr; bar.wid = wid_s;
    if (MK_N_LAUNCHES != N_PHASES) bar = xcd_barrier_post((unsigned*)(ctl + CW_BAR) + P.li * XCD_BAR_WORDS, MISC + 8, wid_s);
    const int lo = P.ph_lo, hi = P.ph_hi;
#ifndef PHASE_MASK
#define PHASE_MASK 0x7ff
#endif
#define IN(k) ((((PHASE_MASK) >> (k)) & 1) && lo <= (k) && (k) < hi)
#define SEAM(k) do { if (IN(k) && IN((k) + 1)) xcd_barrier(bar); } while (0)

#ifndef REPEAT_PHASE
#define REPEAT_PHASE -1
#endif
#define REPS(k) (((REPEAT_PHASE) == (k)) ? 2 : 1)
#ifdef STAMP_A
#define STAMP(k) do { if (bx == 0 && tid == 0) { const unsigned long long t_ = __builtin_amdgcn_s_memrealtime(); MISC[32 + 2 * (k)] = (unsigned)t_; MISC[33 + 2 * (k)] = (unsigned)(t_ >> 32); } } while (0)
#else
#define STAMP(k) do { } while (0)
#endif
#define REPBAR(k, r) do { if ((REPEAT_PHASE) == (k) && (r) == 0) xcd_barrier(bar); } while (0)
    STAMP(0);
    if (IN(0)) { for (int r = 0; r < REPS(0); ++r) { phase_mod(P, lds, G, my_tid(wid_s)); REPBAR(0, r); } split_arrive((unsigned*)(ctl + CW_SPLIT), wid_s); STAMP(1); }
    if (IN(1)) { for (int r = 0; r < REPS(1); ++r) { phase_prep(P, lds, vcu, G, my_tid(wid_s), (unsigned*)(ctl + CW_SPLIT), (unsigned*)(ctl + CW_BAR) + XB_TMO, wid_s); REPBAR(1, r); } SEAM(1); STAMP(2); }
    if (IN(2)) {
        for (int r = 0; r < REPS(20); ++r) {
        pg8::StaticOrder S; S.init(P.ws + WS_HN, P.ws + WS_WIN, MTOK, INW, DM / 2, DM / 2, G, bx);
        EpiIn E{(bf16*)(P.ws + WS_ZHY), (bf16*)(P.ws + WS_Q), (bf16*)(P.ws + WS_K), (bf16*)(P.ws + WS_V), (bf16*)(P.ws + WS_GATE), (const float*)(P.ws + WS_BPERM), P.in[19], P.in[20], (const float*)(P.ws + WS_ROPE)};
        pg8::gemm_phase<EpiIn, pg8::StaticOrder, true>(lds, DM / 2, S, E, my_tid(wid_s), 0x7A7A7A7A); REPBAR(20, r); }
        STAMP(14);
        for (int r = 0; r < REPS(21); ++r) {
        {
          int first, stride, cnt;
          if (G == 256) { if (bx < 128) { first = bx; stride = 128; cnt = 1; } else { first = 128 + (bx - 128); stride = 128; cnt = 3; } }
          else { first = vcu; stride = G; cnt = (HYW - vcu + G - 1) / G; }
          const float* hraw = (const float*)(P.ws + WS_HRAW);
          HfRaw ra;
          if (cnt > 0) hfft_load(ra, hraw, first, tid, first);
          for (int k = 0; k < cnt; ++k) { const int c0 = first + k * stride, cn = k + 1 < cnt ? c0 + stride : c0; hfft_run(ra, hraw, cn, P.out, c0, lds, tid, c0); } }
        REPBAR(21, r); }
        SEAM(2); STAMP(3);
#ifdef PROBE_CHECK
        if ((PROBE_CHECK) & 1) { for (int i = bx; i < 64; i += G) probe_inproj(P, 37 + 509 * i, lds, tid); }
        if ((PROBE_CHECK) & 2) { for (int i = bx; i < 64; i += G) probe_hraw(P, (i * 131 + 7) & (SEQ - 1), lds, tid); }
        if ((PROBE_CHECK) & 8) { for (int i = bx; i < 16; i += G) { const int c = (i * 37 + 3) & 511; const float* hraw = (const float*)(P.ws + WS_HRAW); float* scr = (float*)(P.ws + WS_PROBE) + (size_t)i * 65536;
            for (int f = 0; f < 4; ++f) for (int t = tid; t < SEQ; t += 512) scr[f * 8192 + t] = hraw[(size_t)(f * HYW + c) * SEQ + t]; } }
        xcd_barrier(bar);
#endif
    }
    if (IN(3)) {
        for (int it = vcu; it < 1536; it += G) zc_tile(P, it, lds, tid);
        split_arrive((unsigned*)(ctl + CW_SPLIT + 64), wid_s); STAMP(12);
        for (int r = 0; r < REPS(30); ++r) {
        bool nomax;
        { const int ln = tid & 63; float gq = fabsf(P.in[19][ln]), gk = fabsf(P.in[20][ln]); gq = row16_max(gq); gk = row16_max(gk);
          const int bq = __builtin_bit_cast(int, gq), bk = __builtin_bit_cast(int, gk);
          const float mq = fmaxf(fmaxf(__builtin_bit_cast(float, __builtin_amdgcn_readlane(bq, 0)), __builtin_bit_cast(float, __builtin_amdgcn_readlane(bq, 16))), fmaxf(__builtin_bit_cast(float, __builtin_amdgcn_readlane(bq, 32)), __builtin_bit_cast(float, __builtin_amdgcn_readlane(bq, 48))));
          const float mk = fmaxf(fmaxf(__builtin_bit_cast(float, __builtin_amdgcn_readlane(bk, 0)), __builtin_bit_cast(float, __builtin_amdgcn_readlane(bk, 16))), fmaxf(__builtin_bit_cast(float, __builtin_amdgcn_readlane(bk, 32)), __builtin_bit_cast(float, __builtin_amdgcn_readlane(bk, 48))));
          nomax = (64.0f * mq * mk * C2Q) < 60.0f; }
#define ATTN_CALL(...) do { if (nomax) attn_body::attn_unit<8, true>(__VA_ARGS__); else attn_body::attn_unit<8, false>(__VA_ARGS__); } while (0)
        { const int grp = vcu >> 5, j = vcu & 31;
          if (G == 256) { for (int i = 0; i < 4; ++i) ATTN_CALL(grp >> 1, (grp & 1) * 4 + i, j, (const attn_body::bf16h*)(P.ws + WS_Q), (const attn_body::bf16h*)(P.ws + WS_K), (const attn_body::bf16h*)(P.ws + WS_V), (attn_body::bf16h*)(P.ws + WS_YAT), (char*)lds_raw, my_tid(wid_s)); }
          else { for (int uu = vcu; uu < 1024; uu += G) { const int g2 = uu >> 7, rr = uu & 127; ATTN_CALL(g2 >> 1, (g2 & 1) * 4 + (rr >> 5), rr & 31, (const attn_body::bf16h*)(P.ws + WS_Q), (const attn_body::bf16h*)(P.ws + WS_K), (const attn_body::bf16h*)(P.ws + WS_V), (attn_body::bf16h*)(P.ws + WS_YAT), (char*)lds_raw, my_tid(wid_s)); } } }
        __syncthreads(); REPBAR(30, r); }
        STAMP(13);
        split_wait((unsigned*)(ctl + CW_SPLIT + 64), (unsigned)G, (unsigned*)(ctl + CW_BAR) + XB_TMO, wid_s);
        for (int r = 0; r < REPS(31); ++r) {
        {
          for (int it = vcu; it < 1024; it += G) { const int x = (it >> 5) & 7, k = it >> 8, j = it & 31; const int id = 4 * x + k; hyena_item(P, 32 * (id >> 1) + j, id & 1, (float*)(P.ws + WS_Y1S) + (size_t)bx * 16384, lds, tid, it); } }
        REPBAR(31, r); }
        SEAM(3); STAMP(4);
#ifdef PROBE_CHECK
        if ((PROBE_CHECK) & 4) { for (int i = bx; i < 256; i += G) probe_attn(P, i & 3, (i >> 2) & 7, ((i >> 5) * 1031 + 77 * (i & 31) + 5) & (SEQ - 1), lds, tid); }
        if ((PROBE_CHECK) & 8) { for (int i = bx; i < 16; i += G) probe_hyena(P, i & 3, (i * 37 + 3) & 511, (float*)(P.ws + WS_PROBE) + (size_t)i * 65536, lds, tid); }
        xcd_barrier(bar);
#endif
    }
    if (IN(4)) {
        for (int r = 0; r < REPS(4); ++r) {
        { MergeOrder S; S.S.init(P.ws + WS_YHY, P.ws + WS_WHY, MTOK, DM, HYW / 2, HYW / 2, G, bx); S.A2 = (const char*)(P.ws + WS_YAT); S.B2 = (const char*)(P.ws + WS_WAT);
          EpiMergeR E{P.ws + WS_M, (const bf16*)(P.ws + WS_GATE)}; pg8::gemm_phase<EpiMergeR, MergeOrder, true>(lds, HYW / 2, S, E, my_tid(wid_s), 0x7A7A7A7A, 0x79797979); }
        REPBAR(4, r); }
        SEAM(4); STAMP(5);
    }
    if (IN(5)) {
        for (int r = 0; r < REPS(5); ++r) {
        pg8::StaticOrder S; S.init(P.ws + WS_M, P.ws + WS_WO, MTOK, DM, DM / 2, DM / 2, G, bx);
        EpiOut E{P.in[0], P.out, (const float*)(P.ws + WS_MOD), (float*)(P.ws + WS_ROWSQ)}; pg8::gemm_phase<EpiOut, pg8::StaticOrder, true>(lds, DM / 2, S, E, my_tid(wid_s), 0x7A7A7A7A, 0x79797979);
        REPBAR(5, r); }
        SEAM(5); STAMP(6);
#ifdef PROBE_CHECK
        if ((PROBE_CHECK) & 16) { for (int i = bx; i < 64; i += G) probe_merge(P, 91 + 499 * i, lds, tid); }
        xcd_barrier(bar);
#endif
    }
    if (IN(6)) { for (int r = 0; r < REPS(6); ++r) { phase_norm2(P, lds, vcu, G, my_tid(wid_s), P6_TILES > 0, 8 * P6_TILES); REPBAR(6, r); } split_arrive((unsigned*)(ctl + CW_SPLIT + 128), wid_s); STAMP(7); }
    if (IN(7)) { for (int r = 0; r < REPS(7); ++r) {
        { const bool sp = G >= 256 && (G & 3) == 0;
          if (sp) { const int nw = G - 64, tkt = 64 * P7_TOPK_TILES, rem = 3072 - P6_TILES - tkt;
              if ((vcu & 3) == 0 && vcu < 256) { const int be = vcu >> 2; split_wait((unsigned*)(ctl + CW_SPLIT + 128), (unsigned)G, (unsigned*)(ctl + CW_BAR) + XB_TMO, wid_s); topk_item(P, be, lds, tid);
                  expert_conv(P, 3072 - tkt + be, 64, P7_TOPK_TILES, tid); }
              else { const int j = vcu < 256 ? (vcu >> 2) * 3 + (vcu & 3) - 1 : vcu - 64; expert_conv(P, P6_TILES + j, nw, (rem - j + nw - 1) / nw, tid); } }
          else { split_wait((unsigned*)(ctl + CW_SPLIT + 128), (unsigned)G, (unsigned*)(ctl + CW_BAR) + XB_TMO, wid_s); for (int be = vcu; be < BATCH * NEXP; be += G) topk_item(P, be, lds, tid);
              const int rem = 3072 - P6_TILES; expert_conv(P, P6_TILES + vcu, G, (rem - vcu + G - 1) / G, tid); } }
        REPBAR(7, r); } SEAM(7); STAMP(8); }
    if (IN(8)) {
        for (int r = 0; r < REPS(8); ++r) {
        LAS int* idx = (LAS int*)(lds + pg8::STAGE_BYTES);
        MoeUpOrder S{G, bx, (const char*)(P.ws + WS_H2), (const char*)(P.ws + WS_WGU), idx};
        { const int* topi = (const int*)(P.ws + WS_TOPI);
          const int t_ = tid; int tv[16];
#pragma unroll
          for (int i = 0; i < 16; ++i) { int e, b, mblk, pn; if (!S.decode((long)i * G + bx, e, b, mblk, pn)) { e = 0; b = 0; mblk = 0; } tv[i] = topi[(b * NEXP + e) * CAP + mblk * 256 + (t_ & 255)]; }
          if (t_ < 256) {
#pragma unroll
              for (int i = 0; i < 16; ++i) idx[i * 256 + t_] = tv[i]; } }
        __syncthreads();
        EpiSwiglu E{P.ws + WS_ACT}; pg8::gemm_phase<EpiSwiglu, MoeUpOrder, true>(lds, DM / 2, S, E, my_tid(wid_s), 0x7A7A7A7A);
        REPBAR(8, r); }
        SEAM(8); STAMP(9);
    }
    if (IN(9)) {
        for (int r = 0; r < REPS(9); ++r) {
        MoeDownOrder S{G, bx, (const char*)(P.ws + WS_ACT), (const char*)(P.ws + WS_WD)};
        EpiDown E{(bf16*)(P.ws + WS_YE), (const float*)(P.ws + WS_TOPW)}; pg8::gemm_phase<EpiDown, MoeDownOrder, true>(lds, DFF / 2, S, E, my_tid(wid_s), 0x7A7A7A7A);
        REPBAR(9, r); }
        SEAM(9); STAMP(10);
    }
    if (IN(10)) { phase_combine(P, vcu, G, my_tid(wid_s));
#ifdef STAMP_A
        xcd_barrier(bar); STAMP(11);
        if (bx == 0) { __syncthreads();
            const unsigned long long a0 = ((unsigned long long)MISC[33 + 2 * (STAMP_A)] << 32) | MISC[32 + 2 * (STAMP_A)], a1 = ((unsigned long long)MISC[33 + 2 * (STAMP_B)] << 32) | MISC[32 + 2 * (STAMP_B)];
            const float ta = (float)(a1 - a0) * 0.01f;
            MISC[60] = __float_as_uint(ta * (STAMP_A_SCALE)); }
        {
          float* pub = (float*)(P.ws + WS_CTL) + 12000;
          if (bx == 0 && tid == 0) __hip_atomic_store(pub, __uint_as_float(MISC[60]), __ATOMIC_RELAXED, __HIP_MEMORY_SCOPE_AGENT);
          xcd_barrier(bar);
          const float dv = __hip_atomic_load(pub, __ATOMIC_RELAXED, __HIP_MEMORY_SCOPE_AGENT);
          for (size_t i = (size_t)bx * 512 + tid; i < (size_t)MTOK * DM / 4; i += (size_t)G * 512) { f32x4 v = ((f32x4*)P.out)[i]; v += dv; ((f32x4*)P.out)[i] = v; } }
#endif
#ifdef PROBE_CHECK
        xcd_barrier(bar);
        if (bx == 0) { const float* pw = (const float*)(P.ws + WS_CTL) + CW_PROBE; float E = 0.f;
            for (int cI = 0; cI < 9; ++cI) { const float nu = __hip_atomic_load(pw + 2 * cI, __ATOMIC_RELAXED, __HIP_MEMORY_SCOPE_AGENT), de = __hip_atomic_load(pw + 2 * cI + 1, __ATOMIC_RELAXED, __HIP_MEMORY_SCOPE_AGENT); if (((PROBE_CATS) >> cI) & 1) { const float e = de > 0.f ? sqrtf(nu / de) : 9.99f; E = fmaxf(E, e); } }
            const float Dv = fminf(100.0f * E, 20.0f);
            for (int i = tid; i < 1024; i += 512) P.out[i] += Dv; }
#endif
    }
#undef IN
#undef SEAM
}

#undef tid
extern "C" void kernel_launch(void* const* d_in, const int* in_sizes, int n_in, void* d_out, int out_size, void* d_ws, size_t ws_size, hipStream_t stream) {
    static int grid = 0;
    if (grid == 0) {
        if (n_in != 28 || in_sizes[0] != MTOK * DM || out_size != MTOK * DM || ws_size < WS_END) { fprintf(stderr, "kernel_launch: unexpected shapes (n_in %d, in0 %d, out %d, ws %zu)\n", n_in, n_in > 0 ? in_sizes[0] : -1, out_size, ws_size); grid = -1; return; }
        int dev = 0, cus = 0;
        if (hipGetDevice(&dev) != hipSuccess || hipDeviceGetAttribute(&cus, hipDeviceAttributeMultiprocessorCount, dev) != hipSuccess) { grid = -1; return; }
        if (hipFuncSetAttribute((const void*)mk_fwd, hipFuncAttributeMaxDynamicSharedMemorySize, LDS_BYTES) != hipSuccess) { fprintf(stderr, "kernel_launch: hipFuncSetAttribute failed\n"); grid = -1; return; }
        (void)hipGetLastError();
        grid = cus;
    }
    if (grid < 0) return;
    if (hipMemsetAsync((char*)d_ws + WS_CTL, 0, CTL_ZERO_BYTES, stream) != hipSuccess) return;
    Args a{};
    for (int i = 0; i < 28; ++i) a.in[i] = (const float*)d_in[i];
    a.out = (float*)d_out; a.ws = (unsigned char*)d_ws;
    for (int li = 0; li < MK_N_LAUNCHES; ++li) {
        if (MK_N_LAUNCHES == 1) { a.ph_lo = 0; a.ph_hi = N_PHASES; }
        else { a.ph_lo = li * N_PHASES / MK_N_LAUNCHES; a.ph_hi = (li + 1) * N_PHASES / MK_N_LAUNCHES; }
        a.li = (MK_N_LAUNCHES == N_PHASES) ? 0 : li;
        hipLaunchKernelGGL(mk_fwd, dim3(grid), dim3(NWAVES * 64), LDS_BYTES, stream, a);
    }
}
```
